# Optimizing an MI355X kernel written in HIP

```python
import jax, jax.numpy as jnp
from jax import lax
import numpy as np

D_MODEL = 1024
BATCH = 8
SEQ = 2048
DEPTH = 4
DEC_BATCH = 32
DEC_SEQ = 8
PAST_LEN = 16384
PAGE_SIZE = 128

N_EVEN = (DEPTH + 1) // 2
N_ODD = DEPTH // 2
HG_HEADS = 4
HG_KDIM = 128
HG_VDIM = D_MODEL // 2 // HG_HEADS
HG_QDIM = HG_HEADS * HG_KDIM
HG_WIDTH = HG_HEADS * HG_VDIM
MLA_HEADS = 4
QK_NOPE = 128
QK_ROPE = 64
V_HEAD = 128
Q_LORA = 384
KV_LORA = 256
LAT_DIM = KV_LORA + QK_ROPE
MLA_WIDTH = MLA_HEADS * V_HEAD
MLA_SCALE = (QK_NOPE + QK_ROPE) ** -0.5
ROPE_THETA = 10000.0
Q_BLOCK = 128
NEG_BIG = -1e30
TINY = 1e-30
GLA_HEADS = 4
GLA_KEY = D_MODEL // 2
GLA_VAL = D_MODEL
GLA_HK = GLA_KEY // GLA_HEADS
GLA_HV = GLA_VAL // GLA_HEADS
GATE_RANK = 16
GATE_TAU = 16.0
D_FF = 4 * D_MODEL
CHUNK = 64
EPS = 1e-6

EVEN_SPLIT = [HG_QDIM, HG_QDIM, HG_WIDTH, HG_WIDTH, Q_LORA, KV_LORA, QK_ROPE]
EVEN_COLS = sum(EVEN_SPLIT)
ODD_SPLIT = [GLA_KEY, GLA_KEY, GLA_VAL, GLA_VAL, GATE_RANK]
ODD_COLS = sum(ODD_SPLIT)

kernel_name = 'hybrid_hgrn2_mla_gla_decode_step'


def _split(x, sizes):
    idx = np.cumsum(sizes)[:-1].tolist()
    return jnp.split(x, idx, axis=-1)


def rmsnorm(x, w):
    xf = x.astype(jnp.float32)
    y = xf * lax.rsqrt(jnp.mean(xf * xf, axis=-1, keepdims=True) + EPS)
    return (y * w.astype(jnp.float32)).astype(x.dtype)


def rope(x, pos):
    half = x.shape[-1] // 2
    inv = ROPE_THETA ** (-jnp.arange(half, dtype=jnp.float32) / half)
    ang = pos.astype(jnp.float32)[:, None] * inv[None, :]
    cos = jnp.cos(ang)[:, None, :]
    sin = jnp.sin(ang)[:, None, :]
    x1 = x[..., :half].astype(jnp.float32)
    x2 = x[..., half:].astype(jnp.float32)
    return jnp.concatenate([x1 * cos - x2 * sin, x1 * sin + x2 * cos], axis=-1).astype(x.dtype)


def gated_linear_scan(q, k, v, log_f, s0):
    B, T, H, K = q.shape
    V = v.shape[-1]
    L = min(CHUNK, T)
    n = -(-T // L)
    pad = n * L - T

    def blocks(a):
        a = jnp.pad(a.astype(jnp.float32), ((0, 0), (0, pad), (0, 0), (0, 0)))
        return a.reshape(B, n, L, H, a.shape[-1]).transpose(1, 0, 3, 2, 4)

    qc, kc, vc, gc = blocks(q), blocks(k), blocks(v), blocks(log_f)
    causal = jnp.tril(jnp.ones((L, L), dtype=bool))[:, :, None]

    def step(S, inp):
        qb, kb, vb, gb = inp
        b = jnp.cumsum(gb, axis=2)
        o_inter = jnp.einsum('bhtk,bhkv->bhtv', qb * jnp.exp(b), S)
        diff = b[:, :, :, None, :] - b[:, :, None, :, :]
        decay = jnp.where(causal, jnp.exp(jnp.minimum(diff, 0.0)), 0.0)
        scores = jnp.sum(qb[:, :, :, None, :] * decay * kb[:, :, None, :, :], axis=-1)
        o = o_inter + jnp.einsum('bhts,bhsv->bhtv', scores, vb)
        b_last = b[:, :, -1, :]
        k_dec = kb * jnp.exp(b_last[:, :, None, :] - b)
        S_new = jnp.exp(b_last)[..., None] * S + jnp.einsum('bhsk,bhsv->bhkv', k_dec, vb)
        return S_new, o

    S, o = lax.scan(step, s0.astype(jnp.float32), (qc, kc, vc, gc))
    o = o.transpose(1, 0, 3, 2, 4).reshape(B, n * L, H, V)[:, :T]
    return o.astype(v.dtype), S.astype(s0.dtype)


def hgrn2_mixer(q_raw, f_raw, i_raw, g_raw, lb, norm_w, s0):
    B, T, _ = q_raw.shape
    shp_k = (B, T, HG_HEADS, HG_KDIM)
    z = f_raw.reshape(shp_k).astype(jnp.float32)
    lbh = lb.reshape(HG_HEADS, HG_KDIM).astype(jnp.float32)
    f = lbh + (1.0 - lbh) * jax.nn.sigmoid(z)
    log_f = jnp.log(jnp.maximum(f, TINY))
    k = (1.0 - lbh) * jax.nn.sigmoid(-z)
    q = jax.nn.silu(q_raw.reshape(shp_k)) * (HG_KDIM ** -0.5)
    v = i_raw.reshape(B, T, HG_HEADS, HG_VDIM)
    o, s_new = gated_linear_scan(q, k, v, log_f, s0)
    o = rmsnorm(o, norm_w) * jax.nn.silu(g_raw.reshape(B, T, HG_HEADS, HG_VDIM))
    return o.reshape(B, T, HG_WIDTH), s_new


def mla_attend(q_lat, q_pe, lat, q_pos, k_pos):
    c_kv = lat[..., :KV_LORA]
    k_pe = lat[..., KV_LORA:]
    s = (jnp.einsum('bqhc,bkc->bhqk', q_lat, c_kv, preferred_element_type=jnp.float32)
         + jnp.einsum('bqhr,bkr->bhqk', q_pe, k_pe, preferred_element_type=jnp.float32)) * MLA_SCALE
    s = jnp.where(k_pos[None, :] <= q_pos[:, None], s, NEG_BIG)
    p = jax.nn.softmax(s, axis=-1)
    return jnp.einsum('bhqk,bkc->bqhc', p.astype(lat.dtype), c_kv)


def mla_mixer(c_q, c_kv_raw, k_r, pos, past_lat, q_norm_w, w_uq, kv_norm_w, w_uk, w_uv):
    B, T, _ = c_q.shape
    q = (rmsnorm(c_q, q_norm_w) @ w_uq).reshape(B, T, MLA_HEADS, QK_NOPE + QK_ROPE)
    q_nope = q[..., :QK_NOPE]
    q_pe = rope(q[..., QK_NOPE:], pos)
    c_kv = rmsnorm(c_kv_raw, kv_norm_w)
    k_pe = rope(k_r[:, :, None, :], pos)[:, :, 0, :]
    rows = jnp.concatenate([c_kv, k_pe], axis=-1)
    q_lat = jnp.einsum('bthn,hcn->bthc', q_nope, w_uk)
    if past_lat is None:
        blk = min(Q_BLOCK, T)
        nb = T // blk

        def blockwise(a):
            return a.reshape(B, nb, blk, *a.shape[2:]).swapaxes(0, 1)

        out = lax.map(lambda qs: mla_attend(qs[0], qs[1], rows, qs[2], pos),
                      (blockwise(q_lat), blockwise(q_pe), pos.reshape(nb, blk)))
        out = out.swapaxes(0, 1).reshape(B, T, MLA_HEADS, KV_LORA)
    else:
        lat = jnp.concatenate([past_lat, rows], axis=1)
        k_pos = jnp.arange(lat.shape[1])
        out = mla_attend(q_lat, q_pe, lat, pos, k_pos)
    o = jnp.einsum('bthc,hcv->bthv', out, w_uv)
    return o.reshape(B, T, MLA_WIDTH), rows


def even_mixer(h, pos, past_lat, s0, lb, w_in, hg_norm_w, q_norm_w, w_uq, kv_norm_w, w_uk, w_uv, w_out):
    hq, hf, hi, hg, cq, ckv, kr = _split(h @ w_in, EVEN_SPLIT)
    o_a, s_new = hgrn2_mixer(hq, hf, hi, hg, lb, hg_norm_w, s0)
    o_b, rows = mla_mixer(cq, ckv, kr, pos, past_lat, q_norm_w, w_uq, kv_norm_w, w_uk, w_uv)
    return jnp.concatenate([o_a, o_b], axis=-1) @ w_out, rows, s_new


def gla_mixer(h, s0, w_in, w_a2, b_a, norm_w, w_out):
    B, T, _ = h.shape
    q, k, v, r, a1 = _split(h @ w_in, ODD_SPLIT)
    log_a = jax.nn.log_sigmoid((a1 @ w_a2 + b_a).astype(jnp.float32)) / GATE_TAU
    shp_k = (B, T, GLA_HEADS, GLA_HK)
    o, s_new = gated_linear_scan(q.reshape(shp_k) * (GLA_HK ** -0.5), k.reshape(shp_k),
                                 v.reshape(B, T, GLA_HEADS, GLA_HV), log_a.reshape(shp_k), s0)
    o = rmsnorm(o, norm_w) * jax.nn.silu(r.reshape(B, T, GLA_HEADS, GLA_HV))
    return o.reshape(B, T, GLA_VAL) @ w_out, s_new


def sq_relu_mlp(h, w_up, w_down):
    a = jax.nn.relu(h @ w_up)
    return (a * a) @ w_down


def setup_inputs(seed: int = 0) -> dict:
    key = jax.random.key(seed)
    ks = jax.random.split(key, 25)
    f32 = jnp.float32

    def nrm(k, shape, scale):
        return jax.random.normal(k, shape, f32) * scale

    def gain(k, shape):
        return 1.0 + 0.02 * jax.random.normal(k, shape, f32)

    n_pages = PAST_LEN // PAGE_SIZE
    n_used = DEC_BATCH * n_pages
    n_phys = -(-n_used * 5 // 4)
    page_table = jax.random.permutation(ks[5], n_phys)[:n_used].reshape(DEC_BATCH, n_pages).astype(jnp.int32)
    return {
        'x_prompt': nrm(ks[0], (BATCH, SEQ, D_MODEL), 1.0),
        'x_sample': nrm(ks[1], (DEC_BATCH, DEC_SEQ, D_MODEL), 1.0),
        'cache_mla': nrm(ks[2], (N_EVEN, n_phys, PAGE_SIZE, LAT_DIM), 1.0),
        'state_hgrn': nrm(ks[3], (N_EVEN, DEC_BATCH, HG_HEADS, HG_KDIM, HG_VDIM), 0.5),
        'state_gla': nrm(ks[4], (N_ODD, DEC_BATCH, GLA_HEADS, GLA_HK, GLA_HV), 0.5),
        'page_table': page_table,
        'norm_mix': gain(ks[6], (DEPTH, D_MODEL)),
        'norm_mlp': gain(ks[7], (DEPTH, D_MODEL)),
        'norm_final': gain(ks[8], (D_MODEL,)),
        'w_in_even': nrm(ks[9], (N_EVEN, D_MODEL, EVEN_COLS), D_MODEL ** -0.5),
        'lower_bounds': nrm(ks[10], (N_EVEN, HG_QDIM), 0.5),
        'hgrn_norm': gain(ks[11], (N_EVEN, HG_VDIM)),
        'q_norm': gain(ks[12], (N_EVEN, Q_LORA)),
        'w_uq': nrm(ks[13], (N_EVEN, Q_LORA, MLA_HEADS * (QK_NOPE + QK_ROPE)), Q_LORA ** -0.5),
        'kv_norm': gain(ks[14], (N_EVEN, KV_LORA)),
        'w_uk': nrm(ks[15], (N_EVEN, MLA_HEADS, KV_LORA, QK_NOPE), QK_NOPE ** -0.5),
        'w_uv': nrm(ks[16], (N_EVEN, MLA_HEADS, KV_LORA, V_HEAD), KV_LORA ** -0.5),
        'w_out_even': nrm(ks[17], (N_EVEN, HG_WIDTH + MLA_WIDTH, D_MODEL), (HG_WIDTH + MLA_WIDTH) ** -0.5),
        'w_in_odd': nrm(ks[18], (N_ODD, D_MODEL, ODD_COLS), D_MODEL ** -0.5),
        'w_alpha2': nrm(ks[19], (N_ODD, GATE_RANK, GLA_KEY), GATE_RANK ** -0.5),
        'b_alpha': nrm(ks[20], (N_ODD, GLA_KEY), 0.01),
        'gla_norm': gain(ks[21], (N_ODD, GLA_HV)),
        'w_out_odd': nrm(ks[22], (N_ODD, GLA_VAL, D_MODEL), GLA_VAL ** -0.5),
        'w_up': nrm(ks[23], (DEPTH, D_MODEL, D_FF), D_MODEL ** -0.5),
        'w_down': nrm(ks[24], (DEPTH, D_FF, D_MODEL), D_FF ** -0.5),
    }


def reference(x_prompt, x_sample, cache_mla, state_hgrn, state_gla, page_table, norm_mix, norm_mlp,
              norm_final, w_in_even, lower_bounds, hgrn_norm, q_norm, w_uq, kv_norm, w_uk, w_uv,
              w_out_even, w_in_odd, w_alpha2, b_alpha, gla_norm, w_out_odd, w_up, w_down):
    B, T, _ = x_prompt.shape
    Bd, Td, _ = x_sample.shape
    n_pages = page_table.shape[1]
    past_len = n_pages * PAGE_SIZE
    pos_p = jnp.arange(T)
    pos_s = past_len + jnp.arange(Td)
    p_lb = jax.nn.softmax(lower_bounds.astype(jnp.float32), axis=0)
    lbs = jnp.cumsum(p_lb, axis=0) - p_lb[0]
    zero_hg = jnp.zeros((B, HG_HEADS, HG_KDIM, HG_VDIM), x_prompt.dtype)
    zero_gla = jnp.zeros((B, GLA_HEADS, GLA_HK, GLA_HV), x_prompt.dtype)

    xp, xs = x_prompt, x_sample
    mla_p, mla_s, hg_p, hg_s, gla_p, gla_s = [], [], [], [], [], []
    for layer in range(DEPTH):
        hp = rmsnorm(xp, norm_mix[layer])
        hs = rmsnorm(xs, norm_mix[layer])
        if layer % 2 == 0:
            e = layer // 2
            past = cache_mla[e][page_table].reshape(Bd, past_len, LAT_DIM)
            wts = (lbs[e], w_in_even[e], hgrn_norm[e], q_norm[e], w_uq[e], kv_norm[e],
                   w_uk[e], w_uv[e], w_out_even[e])
            dp, rows_p, sp = even_mixer(hp, pos_p, None, zero_hg, *wts)
            ds, rows_s, ss = even_mixer(hs, pos_s, past, state_hgrn[e], *wts)
            mla_p.append(rows_p)
            mla_s.append(rows_s)
            hg_p.append(sp)
            hg_s.append(ss)
        else:
            o = layer // 2
            wts = (w_in_odd[o], w_alpha2[o], b_alpha[o], gla_norm[o], w_out_odd[o])
            dp, sp = gla_mixer(hp, zero_gla, *wts)
            ds, ss = gla_mixer(hs, state_gla[o], *wts)
            gla_p.append(sp)
            gla_s.append(ss)
        xp = xp + dp
        xs = xs + ds
        xp = xp + sq_relu_mlp(rmsnorm(xp, norm_mlp[layer]), w_up[layer], w_down[layer])
        xs = xs + sq_relu_mlp(rmsnorm(xs, norm_mlp[layer]), w_up[layer], w_down[layer])

    y_prompt = rmsnorm(xp, norm_final)
    y_sample = rmsnorm(xs, norm_final)
    return (y_prompt, y_sample, jnp.stack(mla_p), jnp.stack(mla_s), jnp.stack(hg_p),
            jnp.stack(hg_s), jnp.stack(gla_p), jnp.stack(gla_s))
```

```cpp
#include <hip/hip_runtime.h>
#include <cstdio>
namespace nv {
constexpr int D = 1024, NP = 16384, NS = 256, NTOK = NP + NS, SEQ = 2048, DSEQ = 8, PAST = 16384, PAGE = 128, NPAGES = 128;
constexpr int ECOLS = 2752, OCOLS = 3088, LAT = 320, KVL = 256, QL = 384, FF = 4096;

__device__ __forceinline__ float sigmoidf_(float x) { return 1.f / (1.f + __expf(-x)); }
__device__ __forceinline__ float siluf_(float x) { return x / (1.f + __expf(-x)); }
__device__ __forceinline__ int row_pos(int r) { return r < NP ? (r & (SEQ - 1)) : PAST + ((r - NP) & (DSEQ - 1)); }

__global__ void k_copy_x(const float* xp, const float* xs, float* x) {
    size_t n = (size_t)NTOK * D;
    for (size_t i = (size_t)blockIdx.x * blockDim.x + threadIdx.x; i < n; i += (size_t)gridDim.x * blockDim.x)
        x[i] = i < (size_t)NP * D ? xp[i] : xs[i - (size_t)NP * D];
}
__global__ void k_rmsnorm(const float* in, int ldi, const float* w, float* out, int ldo, int n, int rows) {
    int wave = (blockIdx.x * blockDim.x + threadIdx.x) >> 6, lane = threadIdx.x & 63;
    if (wave >= rows) return;
    const float* p = in + (size_t)wave * ldi; float s = 0.f;
    for (int i = lane; i < n; i += 64) s += p[i] * p[i];
    for (int o = 32; o >= 1; o >>= 1) s += __shfl_xor(s, o);
    float r = rsqrtf(s / n + 1e-6f);
    for (int i = lane; i < n; i += 64) out[(size_t)wave * ldo + i] = p[i] * r * w[i];
}
struct GemmP { const float* A; const float* B; float* C; long long sA1, sA2, sB1, sB2, sC1, sC2; int M, N, K, lda, ldb, ldc, transB, accum, nb2; float alpha; };
__global__ void __launch_bounds__(256) k_gemm(GemmP p) {
    __shared__ float As[16][65], Bs[16][65];
    int bz = blockIdx.z, b1 = bz / p.nb2, b2 = bz % p.nb2;
    const float* A = p.A + b1 * p.sA1 + b2 * p.sA2; const float* B = p.B + b1 * p.sB1 + b2 * p.sB2; float* C = p.C + b1 * p.sC1 + b2 * p.sC2;
    int m0 = blockIdx.y * 64, n0 = blockIdx.x * 64, tx = threadIdx.x & 15, ty = threadIdx.x >> 4;
    float acc[4][4] = {};
    for (int k0 = 0; k0 < p.K; k0 += 16) {
        for (int i = threadIdx.x; i < 1024; i += 256) {
            int kk = i & 15, mm = i >> 4; int gm = m0 + mm, gk = k0 + kk;
            As[kk][mm] = (gm < p.M && gk < p.K) ? A[(size_t)gm * p.lda + gk] : 0.f;
        }
        if (p.transB) {
            for (int i = threadIdx.x; i < 1024; i += 256) { int kk = i & 15, nn = i >> 4; int gn = n0 + nn, gk = k0 + kk;
                Bs[kk][nn] = (gn < p.N && gk < p.K) ? B[(size_t)gn * p.ldb + gk] : 0.f; }
        } else {
            for (int i = threadIdx.x; i < 1024; i += 256) { int nn = i & 63, kk = i >> 6; int gn = n0 + nn, gk = k0 + kk;
                Bs[kk][nn] = (gn < p.N && gk < p.K) ? B[(size_t)gk * p.ldb + gn] : 0.f; }
        }
        __syncthreads();
#pragma unroll
        for (int kk = 0; kk < 16; ++kk) {
            float a[4], b[4];
#pragma unroll
            for (int i = 0; i < 4; ++i) { a[i] = As[kk][ty * 4 + i]; b[i] = Bs[kk][tx * 4 + i]; }
#pragma unroll
            for (int i = 0; i < 4; ++i)
#pragma unroll
                for (int j = 0; j < 4; ++j) acc[i][j] += a[i] * b[j];
        }
        __syncthreads();
    }
    for (int i = 0; i < 4; ++i) for (int j = 0; j < 4; ++j) { int gm = m0 + ty * 4 + i, gn = n0 + tx * 4 + j;
        if (gm < p.M && gn < p.N) { size_t o = (size_t)gm * p.ldc + gn; float v = acc[i][j] * p.alpha; C[o] = p.accum ? C[o] + v : v; } }
}
static void gemm(hipStream_t st, const float* A, int lda, const float* B, int ldb, float* C, int ldc, int M, int N, int K, int transB, int accum = 0, float alpha = 1.f,
                 int nb1 = 1, int nb2 = 1, long long sA1 = 0, long long sA2 = 0, long long sB1 = 0, long long sB2 = 0, long long sC1 = 0, long long sC2 = 0) {
    GemmP p{}; p.A = A; p.B = B; p.C = C; p.M = M; p.N = N; p.K = K; p.lda = lda; p.ldb = ldb; p.ldc = ldc; p.transB = transB; p.accum = accum; p.alpha = alpha;
    p.sA1 = sA1; p.sA2 = sA2; p.sB1 = sB1; p.sB2 = sB2; p.sC1 = sC1; p.sC2 = sC2; p.nb2 = nb2;
    hipLaunchKernelGGL(k_gemm, dim3((N + 63) / 64, (M + 63) / 64, nb1 * nb2), dim3(256), 0, st, p);
}
__global__ void k_lbs(const float* lb, float* lbs) { int j = blockIdx.x * blockDim.x + threadIdx.x; if (j >= 512) return;
    float a = lb[j], b = lb[512 + j], m = fmaxf(a, b), ea = __expf(a - m), eb = __expf(b - m); lbs[j] = 0.f; lbs[512 + j] = eb / (ea + eb); }
__global__ void k_even_prep(const float* proj, const float* lbs, float* Q, float* Kk, float* F, float* V) {
    size_t n = (size_t)NTOK * 512;
    for (size_t i = (size_t)blockIdx.x * blockDim.x + threadIdx.x; i < n; i += (size_t)gridDim.x * blockDim.x) {
        size_t r = i >> 9; int c = (int)(i & 511); const float* pr = proj + r * ECOLS;
        float hq = pr[c], z = pr[512 + c], hi = pr[1024 + c], lb = lbs[c];
        Q[i] = siluf_(hq) * 0.08838834764831845f; float f = lb + (1.f - lb) * sigmoidf_(z); F[i] = fmaxf(f, 1e-30f); Kk[i] = (1.f - lb) * sigmoidf_(-z); V[i] = hi;
    }
}
__global__ void __launch_bounds__(128) k_scan(const float* Q, const float* Kk, const float* F, const float* V, float* O, const float* s0, float* sout, int row0, int rows_per_seq, int T, int H, int VD) {
    int seq = blockIdx.z, h = blockIdx.y, v = blockIdx.x * blockDim.x + threadIdx.x;
    float S[128];
    const float* s0p = s0 ? s0 + ((size_t)(seq * H + h) * 128) * VD + v : nullptr;
#pragma unroll
    for (int k = 0; k < 128; ++k) S[k] = s0p ? s0p[(size_t)k * VD] : 0.f;
    for (int t = 0; t < T; ++t) {
        size_t r = (size_t)row0 + (size_t)seq * rows_per_seq + t;
        const float* q = Q + r * (H * 128) + h * 128; const float* kk = Kk + r * (H * 128) + h * 128; const float* f = F + r * (H * 128) + h * 128;
        float vv = V[r * ((size_t)H * VD) + h * VD + v], o = 0.f;
#pragma unroll
        for (int k = 0; k < 128; ++k) { S[k] = f[k] * S[k] + kk[k] * vv; o += q[k] * S[k]; }
        O[r * ((size_t)H * VD) + h * VD + v] = o;
    }
    float* so = sout + ((size_t)(seq * H + h) * 128) * VD + v;
#pragma unroll
    for (int k = 0; k < 128; ++k) so[(size_t)k * VD] = S[k];
}
__global__ void k_headnorm_gate(const float* o, const float* w, const float* gate, int ldg, float* out, int ldo, int H, int VD, int rows) {
    int wave = (blockIdx.x * blockDim.x + threadIdx.x) >> 6, lane = threadIdx.x & 63;
    if (wave >= rows * H) return; int r = wave / H, h = wave % H;
    const float* p = o + (size_t)r * H * VD + h * VD; float s = 0.f;
    for (int i = lane; i < VD; i += 64) s += p[i] * p[i];
    for (int x = 32; x >= 1; x >>= 1) s += __shfl_xor(s, x);
    float rs = rsqrtf(s / VD + 1e-6f);
    for (int i = lane; i < VD; i += 64) out[(size_t)r * ldo + h * VD + i] = p[i] * rs * w[i] * siluf_(gate[(size_t)r * ldg + h * VD + i]);
}
__global__ void k_mla_rows(const float* proj, const float* kvw, float* rows, float* outp, float* outs) {
    int wave = (blockIdx.x * blockDim.x + threadIdx.x) >> 6, lane = threadIdx.x & 63;
    if (wave >= NTOK) return; int r = wave;
    const float* p = proj + (size_t)r * ECOLS + 2432; float s = 0.f;
    for (int i = lane; i < 256; i += 64) s += p[i] * p[i];
    for (int x = 32; x >= 1; x >>= 1) s += __shfl_xor(s, x);
    float rs = rsqrtf(s / 256.f + 1e-6f);
    float* dst = rows + (size_t)r * LAT; float* od = r < NP ? outp + (size_t)r * LAT : outs + (size_t)(r - NP) * LAT;
    for (int i = lane; i < 256; i += 64) { float v = p[i] * rs * kvw[i]; dst[i] = v; od[i] = v; }
    if (lane < 32) { const float* kr = proj + (size_t)r * ECOLS + 2688; float pos = (float)row_pos(r);
        float inv = powf(10000.f, -(float)lane / 32.f), ang = pos * inv, c = cosf(ang), sn = sinf(ang), x1 = kr[lane], x2 = kr[32 + lane];
        float a = x1 * c - x2 * sn, b = x1 * sn + x2 * c; dst[256 + lane] = a; dst[288 + lane] = b; od[256 + lane] = a; od[288 + lane] = b; }
}
__global__ void k_qpe(const float* q, float* Qcat) {
    int i = blockIdx.x * blockDim.x + threadIdx.x; if (i >= NTOK * 4 * 32) return;
    int j = i & 31, h = (i >> 5) & 3, r = i >> 7; float pos = (float)row_pos(r);
    const float* qp = q + (size_t)r * 768 + h * 192 + 128; float inv = powf(10000.f, -(float)j / 32.f), ang = pos * inv, c = cosf(ang), sn = sinf(ang), x1 = qp[j], x2 = qp[32 + j];
    float* d = Qcat + ((size_t)r * 4 + h) * LAT + 256; d[j] = x1 * c - x2 * sn; d[32 + j] = x1 * sn + x2 * c;
}
__global__ void __launch_bounds__(256) k_softmax(float* S, int ld, int nk, int qper, int kmax0, float scale) {
    __shared__ float red[256];
    size_t row = blockIdx.x; float* p = S + row * ld; int lim = kmax0 + (int)(row % qper); if (lim > nk - 1) lim = nk - 1;
    float m = -3.0e38f; for (int j = threadIdx.x; j <= lim; j += 256) m = fmaxf(m, p[j] * scale);
    red[threadIdx.x] = m; __syncthreads(); for (int s = 128; s >= 1; s >>= 1) { if (threadIdx.x < s) red[threadIdx.x] = fmaxf(red[threadIdx.x], red[threadIdx.x + s]); __syncthreads(); } m = red[0]; __syncthreads();
    float sum = 0.f; for (int j = threadIdx.x; j < nk; j += 256) { float e = j <= lim ? __expf(p[j] * scale - m) : 0.f; p[j] = e; sum += e; }
    red[threadIdx.x] = sum; __syncthreads(); for (int s = 128; s >= 1; s >>= 1) { if (threadIdx.x < s) red[threadIdx.x] += red[threadIdx.x + s]; __syncthreads(); } sum = red[0];
    float inv = 1.f / sum; for (int j = threadIdx.x; j < nk; j += 256) p[j] *= inv;
}
__global__ void k_gather_lat(const float* cache, const int* pt, const float* rows, float* lat) {
    size_t n = (size_t)32 * 16392 * 80;
    for (size_t i = (size_t)blockIdx.x * blockDim.x + threadIdx.x; i < n; i += (size_t)gridDim.x * blockDim.x) {
        int c4 = (int)(i % 80); size_t rk = i / 80; int key = (int)(rk % 16392), bd = (int)(rk / 16392);
        const float4* src;
        if (key < PAST) { int pg = pt[bd * NPAGES + (key >> 7)]; src = (const float4*)(cache + ((size_t)pg * PAGE + (key & 127)) * LAT) + c4; }
        else src = (const float4*)(rows + (size_t)(NP + bd * 8 + (key - PAST)) * LAT) + c4;
        ((float4*)lat)[i] = *src;
    }
}
__global__ void k_odd_gate(const float* g, const float* ba, float* F) {
    size_t n = (size_t)NTOK * 512;
    for (size_t i = (size_t)blockIdx.x * blockDim.x + threadIdx.x; i < n; i += (size_t)gridDim.x * blockDim.x) {
        float x = g[i] + ba[i & 511]; float ls = fminf(x, 0.f) - log1pf(__expf(-fabsf(x))); F[i] = __expf(ls * 0.0625f); }
}
__global__ void k_copy_cols(const float* src, int lds_, int c0, int nc, float* dst, int ldd, float scale, size_t rows) {
    size_t n = rows * nc;
    for (size_t i = (size_t)blockIdx.x * blockDim.x + threadIdx.x; i < n; i += (size_t)gridDim.x * blockDim.x) { size_t r = i / nc; int c = (int)(i % nc); dst[r * ldd + c] = src[r * lds_ + c0 + c] * scale; }
}
__global__ void k_relu2(float* a, size_t n) { for (size_t i = (size_t)blockIdx.x * blockDim.x + threadIdx.x; i < n; i += (size_t)gridDim.x * blockDim.x) { float v = fmaxf(a[i], 0.f); a[i] = v * v; } }

struct In { const float *xp, *xs, *cache, *shg, *sgla; const int* pt; const float *nmix, *nmlp, *nfin, *wine, *lb, *hgn, *qn, *wuq, *kvn, *wuk, *wuv, *woute, *wino, *wa2, *ba, *glan, *wouto, *wup, *wdown; };
struct Out { float *yp, *ys, *mrp, *mrs, *hsp, *hss, *gsp, *gss; };
static void forward(hipStream_t st, const In& I, const Out& O, float* ws) {
    size_t off = 0; auto alloc = [&](size_t n) { float* p = ws + off; off += (n + 63) & ~(size_t)63; return p; };
    float* x = alloc((size_t)NTOK * D); float* h = alloc((size_t)NTOK * D); float* proj = alloc((size_t)NTOK * 3088);
    float* Q = alloc((size_t)NTOK * 512); float* Kk = alloc((size_t)NTOK * 512); float* F = alloc((size_t)NTOK * 512); float* V = alloc((size_t)NTOK * 1024); float* Osc = alloc((size_t)NTOK * 1024);
    float* cat = alloc((size_t)NTOK * 1024); float* rows = alloc((size_t)NTOK * LAT); float* cqn = alloc((size_t)NTOK * QL); float* q = alloc((size_t)NTOK * 768);
    float* Qcat = alloc((size_t)NTOK * 4 * LAT); float* aout = alloc((size_t)NTOK * 4 * KVL); float* lbs = alloc(1024); float* gate = alloc((size_t)NTOK * 512);
    float* a1 = alloc((size_t)NTOK * 16); float* ff = alloc((size_t)NTOK * FF); float* lat = alloc((size_t)32 * 16392 * LAT); float* S = alloc((size_t)8 * 4 * 2048 * 2048);
    const int EB = 2048;
    hipLaunchKernelGGL(k_copy_x, dim3(EB), dim3(256), 0, st, I.xp, I.xs, x);
    hipLaunchKernelGGL(k_lbs, dim3(2), dim3(256), 0, st, I.lb, lbs);
    for (int l = 0; l < 4; ++l) {
        hipLaunchKernelGGL(k_rmsnorm, dim3(NTOK / 4), dim3(256), 0, st, x, D, I.nmix + l * D, h, D, D, NTOK);
        if (l % 2 == 0) {
            int e = l / 2;
            gemm(st, h, D, I.wine + (size_t)e * D * ECOLS, ECOLS, proj, ECOLS, NTOK, ECOLS, D, 0);
            hipLaunchKernelGGL(k_even_prep, dim3(EB), dim3(256), 0, st, proj, lbs + e * 512, Q, Kk, F, V);
            float* hsp = O.hsp + (size_t)e * 8 * 4 * 128 * 128; float* hss = O.hss + (size_t)e * 32 * 4 * 128 * 128;
            hipLaunchKernelGGL(k_scan, dim3(1, 4, 8), dim3(128), 0, st, Q, Kk, F, V, Osc, (const float*)nullptr, hsp, 0, SEQ, SEQ, 4, 128);
            hipLaunchKernelGGL(k_scan, dim3(1, 4, 32), dim3(128), 0, st, Q, Kk, F, V, Osc, I.shg + (size_t)e * 32 * 4 * 128 * 128, hss, NP, DSEQ, DSEQ, 4, 128);
            hipLaunchKernelGGL(k_headnorm_gate, dim3(NTOK * 4 / 4), dim3(256), 0, st, Osc, I.hgn + e * 128, proj + 1536, ECOLS, cat, 1024, 4, 128, NTOK);
            hipLaunchKernelGGL(k_mla_rows, dim3(NTOK / 4), dim3(256), 0, st, proj, I.kvn + e * 256, rows, O.mrp + (size_t)e * NP * LAT, O.mrs + (size_t)e * NS * LAT);
            hipLaunchKernelGGL(k_rmsnorm, dim3(NTOK / 4), dim3(256), 0, st, proj + 2048, ECOLS, I.qn + e * QL, cqn, QL, QL, NTOK);
            gemm(st, cqn, QL, I.wuq + (size_t)e * QL * 768, 768, q, 768, NTOK, 768, QL, 0);
            hipLaunchKernelGGL(k_qpe, dim3(NTOK * 128 / 256), dim3(256), 0, st, q, Qcat);
            gemm(st, q, 768, I.wuk + (size_t)e * 4 * 256 * 128, 128, Qcat, 4 * LAT, NTOK, 256, 128, 1, 0, 1.f, 1, 4, 0, 192, 0, 256 * 128, 0, LAT);
            const float scale = 0.07216878364870322f;
            gemm(st, Qcat, 4 * LAT, rows, LAT, S, 2048, 2048, 2048, LAT, 1, 0, 1.f, 8, 4, (long long)SEQ * 4 * LAT, LAT, (long long)SEQ * LAT, 0, (long long)4 * 2048 * 2048, (long long)2048 * 2048);
            hipLaunchKernelGGL(k_softmax, dim3(8 * 4 * 2048), dim3(256), 0, st, S, 2048, 2048, 2048, 0, scale);
            gemm(st, S, 2048, rows, LAT, aout, 4 * KVL, 2048, KVL, 2048, 0, 0, 1.f, 8, 4, (long long)4 * 2048 * 2048, (long long)2048 * 2048, (long long)SEQ * LAT, 0, (long long)SEQ * 4 * KVL, KVL);
            hipLaunchKernelGGL(k_gather_lat, dim3(8192), dim3(256), 0, st, I.cache + (size_t)e * 5120 * PAGE * LAT, I.pt, rows, lat);
            gemm(st, Qcat + (size_t)NP * 4 * LAT, 4 * LAT, lat, LAT, S, 16392, 8, 16392, LAT, 1, 0, 1.f, 32, 4, (long long)8 * 4 * LAT, LAT, (long long)16392 * LAT, 0, (long long)4 * 8 * 16392, (long long)8 * 16392);
            hipLaunchKernelGGL(k_softmax, dim3(32 * 4 * 8), dim3(256), 0, st, S, 16392, 16392, 8, PAST, scale);
            gemm(st, S, 16392, lat, LAT, aout + (size_t)NP * 4 * KVL, 4 * KVL, 8, KVL, 16392, 0, 0, 1.f, 32, 4, (long long)4 * 8 * 16392, (long long)8 * 16392, (long long)16392 * LAT, 0, (long long)8 * 4 * KVL, KVL);
            gemm(st, aout, 4 * KVL, I.wuv + (size_t)e * 4 * 256 * 128, 128, cat + 512, 1024, NTOK, 128, KVL, 0, 0, 1.f, 1, 4, 0, KVL, 0, 256 * 128, 0, 128);
            gemm(st, cat, 1024, I.woute + (size_t)e * 1024 * D, D, x, D, NTOK, D, 1024, 0, 1);
        } else {
            int o = l / 2;
            gemm(st, h, D, I.wino + (size_t)o * D * OCOLS, OCOLS, proj, OCOLS, NTOK, OCOLS, D, 0);
            hipLaunchKernelGGL(k_copy_cols, dim3(EB), dim3(256), 0, st, proj, OCOLS, 3072, 16, a1, 16, 1.f, (size_t)NTOK);
            gemm(st, a1, 16, I.wa2 + (size_t)o * 16 * 512, 512, gate, 512, NTOK, 512, 16, 0);
            hipLaunchKernelGGL(k_odd_gate, dim3(EB), dim3(256), 0, st, gate, I.ba + o * 512, F);
            hipLaunchKernelGGL(k_copy_cols, dim3(EB), dim3(256), 0, st, proj, OCOLS, 0, 512, Q, 512, 0.08838834764831845f, (size_t)NTOK);
            hipLaunchKernelGGL(k_copy_cols, dim3(EB), dim3(256), 0, st, proj, OCOLS, 512, 512, Kk, 512, 1.f, (size_t)NTOK);
            hipLaunchKernelGGL(k_copy_cols, dim3(EB), dim3(256), 0, st, proj, OCOLS, 1024, 1024, V, 1024, 1.f, (size_t)NTOK);
            float* gsp = O.gsp + (size_t)o * 8 * 4 * 128 * 256; float* gss = O.gss + (size_t)o * 32 * 4 * 128 * 256;
            hipLaunchKernelGGL(k_scan, dim3(2, 4, 8), dim3(128), 0, st, Q, Kk, F, V, Osc, (const float*)nullptr, gsp, 0, SEQ, SEQ, 4, 256);
            hipLaunchKernelGGL(k_scan, dim3(2, 4, 32), dim3(128), 0, st, Q, Kk, F, V, Osc, I.sgla + (size_t)o * 32 * 4 * 128 * 256, gss, NP, DSEQ, DSEQ, 4, 256);
            hipLaunchKernelGGL(k_headnorm_gate, dim3(NTOK * 4 / 4), dim3(256), 0, st, Osc, I.glan + o * 256, proj + 2048, OCOLS, cat, 1024, 4, 256, NTOK);
            gemm(st, cat, 1024, I.wouto + (size_t)o * 1024 * D, D, x, D, NTOK, D, 1024, 0, 1);
        }
        hipLaunchKernelGGL(k_rmsnorm, dim3(NTOK / 4), dim3(256), 0, st, x, D, I.nmlp + l * D, h, D, D, NTOK);
        gemm(st, h, D, I.wup + (size_t)l * D * FF, FF, ff, FF, NTOK, FF, D, 0);
        hipLaunchKernelGGL(k_relu2, dim3(EB), dim3(256), 0, st, ff, (size_t)NTOK * FF);
        gemm(st, ff, FF, I.wdown + (size_t)l * FF * D, D, x, D, NTOK, D, FF, 0, 1);
    }
    hipLaunchKernelGGL(k_rmsnorm, dim3(NP / 4), dim3(256), 0, st, x, D, I.nfin, O.yp, D, D, NP);
    hipLaunchKernelGGL(k_rmsnorm, dim3(NS / 4), dim3(256), 0, st, x + (size_t)NP * D, D, I.nfin, O.ys, D, D, NS);
}
}

extern "C" void kernel_launch(void* const* d_in, const int* in_sizes, int n_in, void* d_out, int out_size, void* d_ws, size_t ws_size, hipStream_t stream) {
    if (n_in != 25 || ws_size < (size_t)3 << 30) { fprintf(stderr, "kernel_launch: unexpected n_in %d or ws_size %zu\n", n_in, ws_size); return; }
    nv::In I{};
    I.xp = (const float*)d_in[0]; I.xs = (const float*)d_in[1]; I.cache = (const float*)d_in[2]; I.shg = (const float*)d_in[3]; I.sgla = (const float*)d_in[4]; I.pt = (const int*)d_in[5];
    I.nmix = (const float*)d_in[6]; I.nmlp = (const float*)d_in[7]; I.nfin = (const float*)d_in[8]; I.wine = (const float*)d_in[9]; I.lb = (const float*)d_in[10]; I.hgn = (const float*)d_in[11];
    I.qn = (const float*)d_in[12]; I.wuq = (const float*)d_in[13]; I.kvn = (const float*)d_in[14]; I.wuk = (const float*)d_in[15]; I.wuv = (const float*)d_in[16]; I.woute = (const float*)d_in[17];
    I.wino = (const float*)d_in[18]; I.wa2 = (const float*)d_in[19]; I.ba = (const float*)d_in[20]; I.glan = (const float*)d_in[21]; I.wouto = (const float*)d_in[22]; I.wup = (const float*)d_in[23]; I.wdown = (const float*)d_in[24];
    float* o = (float*)d_out; nv::Out O{};
    O.yp = o; o += (size_t)8 * 2048 * 1024; O.ys = o; o += (size_t)32 * 8 * 1024; O.mrp = o; o += (size_t)2 * 8 * 2048 * 320; O.mrs = o; o += (size_t)2 * 32 * 8 * 320;
    O.hsp = o; o += (size_t)2 * 8 * 4 * 128 * 128; O.hss = o; o += (size_t)2 * 32 * 4 * 128 * 128; O.gsp = o; o += (size_t)2 * 8 * 4 * 128 * 256; O.gss = o; o += (size_t)2 * 32 * 4 * 128 * 256;
    nv::forward(stream, I, O, (float*)d_ws);
}
```

```cpp
#include <hip/hip_runtime.h>
#include <cstdio>
#include <cstdint>
#define MK_ONE_LAUNCH 0
namespace mk {
#define LAS __attribute__((address_space(3)))
typedef unsigned short bf16_t;
typedef short bf16x8 __attribute__((ext_vector_type(8)));
typedef short s16x4 __attribute__((ext_vector_type(4)));
typedef float f32x4 __attribute__((ext_vector_type(4)));
typedef unsigned u32x4 __attribute__((ext_vector_type(4)));
typedef unsigned u32x2 __attribute__((ext_vector_type(2)));

constexpr int D = 1024, NP = 16384, NS = 256, NTOK = NP + NS, SEQ = 2048, DSEQ = 8, PAST = 16384, PAGE = 128, NPAGES = 128, NPHYS = 5120;
constexpr int FF = 4096, LAT = 320, QL_LD = 1280, NE1 = 2816, NQ2 = 1280, KOE = 1536, NO1 = 3584;
constexpr int NSPLIT = 16, NSE = 2 * NSPLIT;
constexpr float EPS = 1e-6f;
constexpr float QSCALE = 0.07216878364870322f * 1.4426950408889634f;

constexpr size_t MiB = 1u << 20;
constexpr size_t WS_CTL = 0, CTL_BYTES = 2 * MiB;
constexpr size_t WS_WINE = 2 * MiB;
constexpr size_t WS_WQ2 = WS_WINE + 2ull * NE1 * 1024 * 2;
constexpr size_t WS_WOUTE = WS_WQ2 + 2ull * NQ2 * 384 * 2;
constexpr size_t WS_WINO = WS_WOUTE + 2ull * 1024 * KOE * 2;
constexpr size_t WS_WOUTO = WS_WINO + 2ull * NO1 * 1024 * 2;
constexpr size_t WS_WUP = WS_WOUTO + 2ull * 1024 * 1024 * 2;
constexpr size_t WS_WDOWN = WS_WUP + 4ull * FF * 1024 * 2;
constexpr size_t WS_LBS = WS_WDOWN + 4ull * FF * 1024 * 2;
constexpr size_t WS_ROPE = WS_LBS + 4096;
constexpr size_t WS_X = (WS_ROPE + 2056ull * 64 * 4 + 4095) & ~(size_t)4095;
constexpr size_t WS_XB = WS_X + (size_t)NTOK * D * 4;
constexpr size_t WS_SSQ = WS_XB + (size_t)NTOK * D * 2;
constexpr size_t WS_QH = WS_SSQ + (size_t)NTOK * 16 * 4;
constexpr size_t WS_KK = WS_QH + (size_t)NTOK * 512 * 2;
constexpr size_t WS_LOGF = WS_KK + (size_t)NTOK * 512 * 2;
constexpr size_t WS_V = WS_LOGF + (size_t)NTOK * 512 * 4;
constexpr size_t WS_G = WS_V + (size_t)NTOK * 1024 * 2;
constexpr size_t WS_CKV = WS_G + (size_t)NTOK * 1024 * 2;
constexpr size_t WS_KR = WS_CKV + (size_t)NTOK * 256 * 4;
constexpr size_t WS_CQ = WS_KR + (size_t)NTOK * 64 * 4;
constexpr size_t WS_SSQCQ = WS_CQ + (size_t)NTOK * 384 * 2;
constexpr size_t WS_KVL = WS_SSQCQ + (size_t)NTOK * 16 * 4;
constexpr size_t WS_QL = WS_KVL + (size_t)NTOK * LAT * 2;
constexpr size_t WS_OA = WS_QL + (size_t)NTOK * QL_LD * 2;
constexpr size_t WS_FFB = WS_OA + (size_t)NTOK * KOE * 2;
constexpr size_t WS_PO = WS_FFB + (size_t)NTOK * FF * 2;
constexpr size_t WS_PML = WS_PO + 32ull * NSE * 32 * 256 * 4;
constexpr size_t WS_END = WS_PML + 32ull * NSE * 32 * 2 * 4;
constexpr int CW_BAR = 4096;
constexpr int CW_QUEUE = 16384;

constexpr int RING_BYTES = 131072, SCL_OFF = RING_BYTES  , MISC_OFF = SCL_OFF + 2048, LDS_BYTES = MISC_OFF + 2048;

__device__ __forceinline__ unsigned cvt_pk_bf16(float lo, float hi) { unsigned r; asm volatile("v_cvt_pk_bf16_f32 %0, %1, %2" : "=v"(r) : "v"(lo), "v"(hi)); return r; }
__device__ __forceinline__ float bf2f(bf16_t b) { return __uint_as_float(((unsigned)b) << 16); }
__device__ __forceinline__ float bflo(unsigned w) { return __uint_as_float(w << 16); }
__device__ __forceinline__ float bfhi(unsigned w) { return __uint_as_float(w & 0xffff0000u); }
__device__ __forceinline__ float fexp2(float x) { return __builtin_amdgcn_exp2f(x); }
__device__ __forceinline__ float fexp(float x) { return __builtin_amdgcn_exp2f(x * 1.4426950408889634f); }
__device__ __forceinline__ float frcp(float x) { return __builtin_amdgcn_rcpf(x); }
__device__ __forceinline__ float sigm(float x) { return frcp(1.f + fexp(-x)); }
__device__ __forceinline__ float wave_sum(float v) {
#pragma unroll
    for (int o = 1; o < 64; o <<= 1) v += __shfl_xor(v, o);
    return v;
}
__device__ __forceinline__ int rope_idx(int row) { return row < NP ? (row & (SEQ - 1)) : SEQ + ((row - NP) & (DSEQ - 1)); }

#define XB_TMO      128
#define XB_XCNT(j)  (256  + 64 * (j))
#define XB_XSUB(j)  (1280 + 64 * (j))
#define XB_XGEN(j)  (2304 + 64 * (j))
#define XB_TOP      3328
#define XB_TOPGEN   3392
#define XCD_BAR_WORDS 3456
#define XB_SPIN_CAP (1u << 18)
__device__ __forceinline__ unsigned xb_ld(unsigned* p)              { return __hip_atomic_load(p, __ATOMIC_RELAXED, __HIP_MEMORY_SCOPE_AGENT); }
__device__ __forceinline__ unsigned xb_add(unsigned* p, unsigned v) { return __hip_atomic_fetch_add(p, v, __ATOMIC_RELAXED, __HIP_MEMORY_SCOPE_AGENT); }
__device__ __forceinline__ unsigned xb_xcc_id() { return (unsigned)__builtin_amdgcn_s_getreg((3 << 11) | 20) & 0xFu; }
#define XB_SPIN(cond, bar) do { unsigned _sp = 0; while (cond) { __builtin_amdgcn_s_sleep(1); \
    if ((++_sp & 255u) == 0u) { if (xb_ld(&(bar)[XB_TMO])) break; if (_sp > XB_SPIN_CAP) { atomicAdd(&(bar)[XB_TMO], 1u); break; } } } } while (0)
struct XcdBarrier { unsigned* bar; unsigned x; volatile LAS unsigned* st; };
__device__ __forceinline__ XcdBarrier xcd_barrier_post(unsigned* bar, volatile LAS unsigned* st) {
    XcdBarrier b; b.bar = bar; b.x = xb_xcc_id(); b.st = st;
    if (threadIdx.x == 0) (void)xb_add(&bar[XB_XCNT(b.x)], 1u);
    return b;
}
__device__ __forceinline__ void xcd_barrier_complete(unsigned* bar, unsigned x, unsigned& nloc, unsigned& nx) {
    const unsigned G = gridDim.x * gridDim.y * gridDim.z;
    unsigned sum, cnt, mine, sp = 0u;
    for (;;) {
        sum = 0u; cnt = 0u; mine = 0u;
#pragma unroll
        for (unsigned j = 0; j < 16; ++j) { const unsigned c = xb_ld(&bar[XB_XCNT(j)]); sum += c; cnt += (c > 0u) ? 1u : 0u; mine = (j == x) ? c : mine; }
        if (sum == G) break;
        __builtin_amdgcn_s_sleep(1);
        if ((++sp & 255u) == 0u) { if (xb_ld(&bar[XB_TMO])) break; if (sp > XB_SPIN_CAP) { atomicAdd(&bar[XB_TMO], 1u); break; } }
    }
    nloc = mine > 0u ? mine : 1u; nx = cnt > 0u ? cnt : 1u;
}
__device__ __forceinline__ void xcd_barrier(const XcdBarrier& b) {
    asm volatile("s_waitcnt vmcnt(0)" ::: "memory");
    __syncthreads();
    if (threadIdx.x == 0) {
        unsigned* bar = b.bar;
        __builtin_amdgcn_s_waitcnt(0);
        unsigned nloc = b.st[0], nx = b.st[1];
        if (nloc == 0u) { xcd_barrier_complete(bar, b.x, nloc, nx); b.st[0] = nloc; b.st[1] = nx; }
        const unsigned old = xb_add(&bar[XB_XSUB(b.x)], 1u);
        const unsigned gen = old / nloc;
        if (old + 1u == (gen + 1u) * nloc) {
            __builtin_amdgcn_fence(__ATOMIC_RELEASE, "agent");
            asm volatile("s_waitcnt vmcnt(0)" ::: "memory");
            const unsigned og = xb_add(&bar[XB_TOP], 1u);
            const unsigned tg = og / nx;
            if (og + 1u == (tg + 1u) * nx) xb_add(&bar[XB_TOPGEN], 1u);
            else XB_SPIN(xb_ld(&bar[XB_TOPGEN]) == tg, bar);
            __builtin_amdgcn_fence(__ATOMIC_ACQUIRE, "agent");
            xb_add(&bar[XB_XGEN(b.x)], 1u);
            asm volatile("s_waitcnt vmcnt(0)" ::: "memory");
        } else {
            XB_SPIN(xb_ld(&bar[XB_XGEN(b.x)]) == gen, bar);
            __builtin_amdgcn_fence(__ATOMIC_ACQUIRE, "agent");
            asm volatile("s_waitcnt vmcnt(0)" ::: "memory");
        }
    }
    __syncthreads();
}

constexpr int BM = 256, BK = 64, HALF = 128, HTB = HALF * BK * 2, NXCD = 8, WGM = 8;
__host__ __device__ __forceinline__ int lds_byte(int r, int c) { const int st = (r >> 4) * 2 + (c >> 5), rr = r & 15, cc = c & 31, ob = rr * 64 + cc * 2; return st * 1024 + (ob ^ (((ob >> 9) & 1) << 5)); }
__host__ __device__ __forceinline__ void stage_rc(int b, int& R, int& C) { const int st = b / 1024, sb = b % 1024, swz = sb ^ (((sb >> 9) & 1) << 5); R = (st >> 1) * 16 + swz / 64; C = (st & 1) * 32 + (swz % 64) / 2; }
__host__ __device__ __forceinline__ int perm32(int rho) { const int n = rho >> 4, i = rho & 15; return 8 * (i >> 2) + 4 * n + (i & 3); }
struct Unit { int pm, pn, idx; };
struct Gemm { const bf16_t* A; const bf16_t* Bt; int lda, ldb, M, N, K; };
struct RowScale { const float* part; int stride, np4; float inv_n; };
struct StaticOrder {
    int nM, nN, nwg, G, c;
    __device__ void init(int M, int N, int G_, int c_) { nM = M / BM; nN = N / BM; nwg = nM * nN; G = G_; c = c_; }
    __device__ bool next(int i, Unit& u) const {
        const long L = (long)i * G + c; if (L >= nwg) return false;
        int wgid = (int)L; { const int q = nwg / NXCD, r = nwg % NXCD, xcd = wgid % NXCD, off = wgid / NXCD; wgid = (xcd < r ? xcd * (q + 1) : r * (q + 1) + (xcd - r) * q) + off; }
        const int nig = WGM * nN, gid = wgid / nig, fm = gid * WGM, gsz = (nM - fm) < WGM ? (nM - fm) : WGM;
        u.pm = fm + ((wgid % nig) % gsz); u.pn = (wgid % nig) / gsz; u.idx = i; return true;
    }
};
template <bool SCALE>
__device__ __forceinline__ void rs_fill(LAS unsigned char* ldsbase, const RowScale& rs, const Unit& u, int tid) {
    if constexpr (SCALE) {
        if (tid < 256) {
            const f32x4* p = (const f32x4*)(rs.part + (size_t)(u.pm * BM + tid) * rs.stride); float s = 0.f;
            for (int j = 0; j < rs.np4; ++j) { const f32x4 v = p[j]; s += (v[0] + v[1]) + (v[2] + v[3]); }
            ((LAS float*)(ldsbase + SCL_OFF))[(u.idx & 1) * 256 + tid] = rsqrtf(s * rs.inv_n + EPS);
        }
    }
}
template <class Epi, bool SCALE>
__device__ __forceinline__ void gemm_phase(LAS unsigned char* lds, const Gemm g, const StaticOrder& S, const Epi& E, const RowScale rs) {
    int tid = threadIdx.x; asm volatile("" : "+v"(tid));
    const int wid = __builtin_amdgcn_readfirstlane(tid >> 6), lane = tid & 63, wr = wid >> 2, wc = wid & 3, fr = lane & 15, fq = lane >> 4;
    const int K = g.K, nt = K / BK;
    unsigned voffA[2], voffB[2];
#pragma unroll
    for (int i = 0; i < 2; ++i) { int R, C; stage_rc(tid * 16 + i * 8192, R, C); const int Rb = (R & ~31) + perm32(R & 31);
        voffA[i] = (unsigned)(R * g.lda + C) * 2u; voffB[i] = (unsigned)(Rb * g.ldb + C) * 2u; }
    const size_t kstep = (size_t)(BK * 2);
    const size_t hstepA = (size_t)HALF * g.lda * 2, hstepB = (size_t)HALF * g.ldb * 2;
    const size_t tstepA = 2 * hstepA, tstepB = 2 * hstepB;
    const unsigned ldsw = (unsigned)wid * 1024u;
    const int aoff = lds_byte(wr * 64 + fr, fq * 8), boff = lds_byte(wc * 32 + fr, fq * 8);
#define PG8_SA(b, h) (((b) * 2 + (h)) * HTB)
#define PG8_SB(b, h) ((4 + (b) * 2 + (h)) * HTB)
#define PG8_STAGE(bufoff, gbase, voff) do { _Pragma("unroll") for (int _i = 0; _i < 2; ++_i) \
        __builtin_amdgcn_global_load_lds((const unsigned*)((const char*)(gbase) + (voff)[_i]), (LAS unsigned*)(lds + (bufoff) + ldsw + _i * 8192), 16, 0, 0); } while (0)
#define PG8_LDA(dst, b, h) do { _Pragma("unroll") for (int m = 0; m < 4; ++m) _Pragma("unroll") for (int k = 0; k < 2; ++k) dst[m][k] = *(const LAS bf16x8*)(lds + PG8_SA(b, h) + aoff + m * 2048 + k * 1024); } while (0)
#define PG8_LDB(dst, b, h) do { _Pragma("unroll") for (int n = 0; n < 2; ++n) _Pragma("unroll") for (int k = 0; k < 2; ++k) dst[n][k] = *(const LAS bf16x8*)(lds + PG8_SB(b, h) + boff + n * 2048 + k * 1024); } while (0)
#define PG8_MMA(ai, bj, At, Bt) do { __builtin_amdgcn_s_setprio(1); _Pragma("unroll") for (int m = 0; m < 4; ++m) _Pragma("unroll") for (int n = 0; n < 2; ++n) _Pragma("unroll") for (int k = 0; k < 2; ++k) \
        acc[ai][bj][m][n] = __builtin_amdgcn_mfma_f32_16x16x32_bf16(Bt[n][k], At[m][k], acc[ai][bj][m][n], 0, 0, 0); __builtin_amdgcn_s_setprio(0); } while (0)
#define PG8_WAIT_V(n) asm volatile("s_waitcnt vmcnt(" #n ")" ::: "memory")
#define PG8_WAIT_L(n) asm volatile("s_waitcnt lgkmcnt(" #n ")" ::: "memory")
#define PG8_BAR __builtin_amdgcn_s_barrier()
#define PG8_SCHED __builtin_amdgcn_sched_barrier(0)
    Unit cur, nxt; int ui = 0;
    if (!S.next(0, cur)) return;
    f32x4 acc[2][2][4][2];
#pragma unroll
    for (int a = 0; a < 2; ++a)
#pragma unroll
        for (int b = 0; b < 2; ++b)
#pragma unroll
            for (int m = 0; m < 4; ++m)
#pragma unroll
                for (int n = 0; n < 2; ++n) acc[a][b][m][n] = (f32x4){0.f, 0.f, 0.f, 0.f};
    bf16x8 At[4][2], B0[2][2], B1[2][2];
    const char* cA = (const char*)g.A + (size_t)cur.pm * tstepA; const char* cB = (const char*)g.Bt + (size_t)cur.pn * tstepB;
    rs_fill<SCALE>(lds, rs, cur, tid);
    PG8_STAGE(PG8_SB(0, 0), cB, voffB); PG8_STAGE(PG8_SB(0, 1), cB + hstepB, voffB); PG8_STAGE(PG8_SA(0, 0), cA, voffA); PG8_STAGE(PG8_SA(0, 1), cA + hstepA, voffA);
    if (wr == 1) PG8_BAR;
    PG8_WAIT_V(2); PG8_BAR;
    PG8_STAGE(PG8_SB(1, 0), cB + kstep, voffB); PG8_STAGE(PG8_SA(1, 0), cA + kstep, voffA); PG8_STAGE(PG8_SB(1, 1), cB + hstepB + kstep, voffB);
    PG8_WAIT_V(6); PG8_BAR;
    for (;;) {
        const bool has_next = S.next(ui + 1, nxt);
        const char* nA = has_next ? (const char*)g.A + (size_t)nxt.pm * tstepA : cA; const char* nB = has_next ? (const char*)g.Bt + (size_t)nxt.pn * tstepB : cB;
#pragma unroll 1
        for (int t = 0; t < nt; t += 2) {
            const bool last = (t == nt - 2);
            const char* a1 = cA + (size_t)(t + 1) * kstep;
            const char* a2 = last ? nA : cA + (size_t)(t + 2) * kstep; const char* b2 = last ? nB : cB + (size_t)(t + 2) * kstep;
            const char* a3 = a2 + kstep; const char* b3 = b2 + kstep;
            if (last && has_next) rs_fill<SCALE>(lds, rs, nxt, tid);
            PG8_LDB(B0, 0, 0); PG8_LDB(B1, 0, 1); PG8_SCHED; PG8_LDA(At, 0, 0); PG8_STAGE(PG8_SA(1, 1), a1 + hstepA, voffA);
            PG8_WAIT_V(8); PG8_WAIT_L(0); PG8_BAR; PG8_MMA(0, 0, At, B0); PG8_MMA(0, 1, At, B1); PG8_BAR; PG8_SCHED;
            PG8_LDA(At, 0, 1); PG8_STAGE(PG8_SB(0, 0), b2, voffB); PG8_STAGE(PG8_SB(0, 1), b2 + hstepB, voffB); PG8_STAGE(PG8_SA(0, 0), a2, voffA);
            PG8_WAIT_V(8); PG8_WAIT_L(0); PG8_BAR; PG8_MMA(1, 0, At, B0); PG8_MMA(1, 1, At, B1); PG8_BAR; PG8_SCHED;
            PG8_LDB(B0, 1, 0); PG8_LDB(B1, 1, 1); PG8_SCHED; PG8_LDA(At, 1, 0); PG8_STAGE(PG8_SA(0, 1), a2 + hstepA, voffA);
            PG8_WAIT_V(8); PG8_WAIT_L(0); PG8_BAR; PG8_MMA(0, 0, At, B0); PG8_MMA(0, 1, At, B1); PG8_BAR; PG8_SCHED;
            PG8_LDA(At, 1, 1); PG8_STAGE(PG8_SB(1, 0), b3, voffB); PG8_STAGE(PG8_SB(1, 1), b3 + hstepB, voffB); PG8_STAGE(PG8_SA(1, 0), a3, voffA);
            PG8_WAIT_V(8); PG8_WAIT_L(0); PG8_BAR; PG8_MMA(1, 0, At, B0); PG8_MMA(1, 1, At, B1); PG8_BAR; PG8_SCHED;
        }
        if (wr == 0) PG8_BAR;
        { int fr_ = fr, fq_ = fq; asm volatile("" : "+v"(fr_), "+v"(fq_));
          E(acc, cur, wr, wc, fr_, fq_, (const LAS float*)(lds + SCL_OFF) + (cur.idx & 1) * 256); }
        if (!has_next) break;
#pragma unroll
        for (int a = 0; a < 2; ++a)
#pragma unroll
            for (int b = 0; b < 2; ++b)
#pragma unroll
                for (int m = 0; m < 4; ++m)
#pragma unroll
                    for (int n = 0; n < 2; ++n) acc[a][b][m][n] = (f32x4){0.f, 0.f, 0.f, 0.f};
        cur = nxt; cA = nA; cB = nB; ++ui;
        if (wr == 1) PG8_BAR;
    }
    PG8_WAIT_V(0);
    PG8_BAR;
#undef PG8_SA
#undef PG8_SB
#undef PG8_STAGE
#undef PG8_LDA
#undef PG8_LDB
#undef PG8_MMA
#undef PG8_WAIT_V
#undef PG8_WAIT_L
#undef PG8_BAR
#undef PG8_SCHED
}

#define EPI_ROWS_BEGIN  _Pragma("unroll") for (int ai = 0; ai < 2; ++ai) _Pragma("unroll") for (int m = 0; m < 4; ++m) { \
        const int rl = ai * HALF + wr * 64 + m * 16 + fr; const int row = u.pm * BM + rl; (void)row;
#define EPI_ROWS_END asm volatile("" ::: "memory"); }
__device__ __forceinline__ void st_bf8(bf16_t* p, const f32x4 a, const f32x4 b) { u32x4 w; w.x = cvt_pk_bf16(a[0], a[1]); w.y = cvt_pk_bf16(a[2], a[3]); w.z = cvt_pk_bf16(b[0], b[1]); w.w = cvt_pk_bf16(b[2], b[3]); *(u32x4*)p = w; }
__device__ __forceinline__ float sq8(const f32x4 a, const f32x4 b) { return (a[0] * a[0] + a[1] * a[1]) + (a[2] * a[2] + a[3] * a[3]) + (b[0] * b[0] + b[1] * b[1]) + (b[2] * b[2] + b[3] * b[3]); }
__device__ __forceinline__ float silu1(float x) { return x * frcp(1.f + fexp(-x)); }

struct EpiInEven {
    bf16_t* Qh; bf16_t* KK; float* LOGF; bf16_t* V; bf16_t* G; float* CKV; float* KR; bf16_t* CQ; float* SSQCQ; const float* lbs;
    __device__ __forceinline__ void operator()(const f32x4 (&acc)[2][2][4][2], const Unit& u, int wr, int wc, int fr, int fq, const LAS float* scl) const {
        const int pn = u.pn;
        EPI_ROWS_BEGIN
            const float s = scl[rl];
#pragma unroll
            for (int bj = 0; bj < 2; ++bj) {
                const int cl = bj * HALF + wc * 32 + 8 * fq;
                f32x4 a = acc[ai][bj][m][0] * s, b = acc[ai][bj][m][1] * s;
                if (pn < 2) {
#pragma unroll
                    for (int j = 0; j < 4; ++j) { a[j] = silu1(a[j]) * 0.08838834764831845f; b[j] = silu1(b[j]) * 0.08838834764831845f; }
                    st_bf8(Qh + (size_t)row * 512 + pn * 256 + cl, a, b);
                } else if (pn < 4) {
                    const int c = (pn - 2) * 256 + cl; const f32x4 l0 = *(const f32x4*)(lbs + c), l1 = *(const f32x4*)(lbs + c + 4);
                    f32x4 lf0, lf1, k0, k1;
#pragma unroll
                    for (int j = 0; j < 4; ++j) {
                        { const float z = a[j], lb = l0[j], sp = sigm(z), sn = sigm(-z); lf0[j] = __logf(fmaxf(lb + (1.f - lb) * sp, 1e-30f)); k0[j] = (1.f - lb) * sn; }
                        { const float z = b[j], lb = l1[j], sp = sigm(z), sn = sigm(-z); lf1[j] = __logf(fmaxf(lb + (1.f - lb) * sp, 1e-30f)); k1[j] = (1.f - lb) * sn; }
                    }
                    *(f32x4*)(LOGF + (size_t)row * 512 + c) = lf0; *(f32x4*)(LOGF + (size_t)row * 512 + c + 4) = lf1;
                    st_bf8(KK + (size_t)row * 512 + c, k0, k1);
                } else if (pn < 6) {
                    st_bf8(V + (size_t)row * 512 + (pn - 4) * 256 + cl, a, b);
                } else if (pn < 8) {
#pragma unroll
                    for (int j = 0; j < 4; ++j) { a[j] = silu1(a[j]); b[j] = silu1(b[j]); }
                    st_bf8(G + (size_t)row * 512 + (pn - 6) * 256 + cl, a, b);
                } else if (pn == 8) {
                    *(f32x4*)(CKV + (size_t)row * 256 + cl) = a; *(f32x4*)(CKV + (size_t)row * 256 + cl + 4) = b;
                } else if (pn == 9 || bj == 0) {
                    const int c = (pn - 9) * 256 + cl;
                    st_bf8(CQ + (size_t)row * 384 + c, a, b);
                    float ss = sq8(a, b); ss += __shfl_xor(ss, 16); ss += __shfl_xor(ss, 32);
                    if (fq == 0) SSQCQ[(size_t)row * 16 + (pn == 9 ? bj * 4 + wc : 8 + wc)] = ss;
                } else if (wc < 2) {
                    const int c = wc * 32 + 8 * fq;
                    *(f32x4*)(KR + (size_t)row * 64 + c) = a; *(f32x4*)(KR + (size_t)row * 64 + c + 4) = b;
                }
            }
        EPI_ROWS_END
    }
};
struct EpiQ2 {
    bf16_t* QL; const float* rope;
    __device__ __forceinline__ void operator()(const f32x4 (&acc)[2][2][4][2], const Unit& u, int wr, int wc, int fr, int fq, const LAS float* scl) const {
        const int pn = u.pn;
        if (pn < 4) {
            EPI_ROWS_BEGIN
                const float s = scl[rl]; bf16_t* dst = QL + (size_t)row * QL_LD + pn * LAT + wc * 32 + 8 * fq;
                st_bf8(dst, acc[ai][0][m][0] * s, acc[ai][0][m][1] * s); st_bf8(dst + HALF, acc[ai][1][m][0] * s, acc[ai][1][m][1] * s);
            EPI_ROWS_END
        } else {
            const int g = (wc & 1) * 4 + fq;
            EPI_ROWS_BEGIN
                const float s = scl[rl]; const float* rp = rope + rope_idx(row) * 64 + 4 * g;
                const f32x4 c = *(const f32x4*)rp, sn = *(const f32x4*)(rp + 32);
#pragma unroll
                for (int bj = 0; bj < 2; ++bj) {
                    const f32x4 a = acc[ai][bj][m][0] * s, b = acc[ai][bj][m][1] * s, o1 = a * c - b * sn, o2 = a * sn + b * c;
                    bf16_t* dst = QL + (size_t)row * QL_LD + (bj * 2 + (wc >> 1)) * LAT + 256 + 4 * g;
                    u32x2 w1, w2; w1.x = cvt_pk_bf16(o1[0], o1[1]); w1.y = cvt_pk_bf16(o1[2], o1[3]); w2.x = cvt_pk_bf16(o2[0], o2[1]); w2.y = cvt_pk_bf16(o2[2], o2[3]);
                    *(u32x2*)dst = w1; *(u32x2*)(dst + 32) = w2;
                }
            EPI_ROWS_END
        }
    }
};
struct EpiOutRes {
    const float* resP; const float* resS; float* X; bf16_t* XB; float* SSQ;
    __device__ __forceinline__ void operator()(const f32x4 (&acc)[2][2][4][2], const Unit& u, int wr, int wc, int fr, int fq, const LAS float* scl) const {
        EPI_ROWS_BEGIN
            const float* rr = row < NP ? resP + (size_t)row * D : resS + (size_t)(row - NP) * D;
            float ss = 0.f;
#pragma unroll
            for (int bj = 0; bj < 2; ++bj) {
                const int c = u.pn * BM + bj * HALF + wc * 32 + 8 * fq;
                const f32x4 a = acc[ai][bj][m][0] + *(const f32x4*)(rr + c), b = acc[ai][bj][m][1] + *(const f32x4*)(rr + c + 4);
                *(f32x4*)(X + (size_t)row * D + c) = a; *(f32x4*)(X + (size_t)row * D + c + 4) = b;
                st_bf8(XB + (size_t)row * D + c, a, b);
                ss += sq8(a, b);
            }
            ss += __shfl_xor(ss, 16); ss += __shfl_xor(ss, 32);
            if (fq == 0) SSQ[(size_t)row * 16 + u.pn * 4 + wc] = ss;
        EPI_ROWS_END
    }
};
struct EpiUp {
    bf16_t* FFB;
    __device__ __forceinline__ void operator()(const f32x4 (&acc)[2][2][4][2], const Unit& u, int wr, int wc, int fr, int fq, const LAS float* scl) const {
        EPI_ROWS_BEGIN
            const float s = scl[rl];
#pragma unroll
            for (int bj = 0; bj < 2; ++bj) {
                f32x4 a = acc[ai][bj][m][0] * s, b = acc[ai][bj][m][1] * s;
#pragma unroll
                for (int j = 0; j < 4; ++j) { const float x = fmaxf(a[j], 0.f), y = fmaxf(b[j], 0.f); a[j] = x * x; b[j] = y * y; }
                st_bf8(FFB + (size_t)row * FF + u.pn * BM + bj * HALF + wc * 32 + 8 * fq, a, b);
            }
        EPI_ROWS_END
    }
};
struct EpiInOdd {
    bf16_t* Qh; bf16_t* KK; bf16_t* V; bf16_t* G; float* LOGF; const float* ba;
    __device__ __forceinline__ void operator()(const f32x4 (&acc)[2][2][4][2], const Unit& u, int wr, int wc, int fr, int fq, const LAS float* scl) const {
        const int pn = u.pn;
        EPI_ROWS_BEGIN
            const float s = scl[rl];
#pragma unroll
            for (int bj = 0; bj < 2; ++bj) {
                const int cl = bj * HALF + wc * 32 + 8 * fq;
                f32x4 a = acc[ai][bj][m][0] * s, b = acc[ai][bj][m][1] * s;
                if (pn < 2) { a = a * 0.08838834764831845f; b = b * 0.08838834764831845f; st_bf8(Qh + (size_t)row * 512 + pn * 256 + cl, a, b); }
                else if (pn < 4) st_bf8(KK + (size_t)row * 512 + (pn - 2) * 256 + cl, a, b);
                else if (pn < 8) st_bf8(V + (size_t)row * 1024 + (pn - 4) * 256 + cl, a, b);
                else if (pn < 12) {
#pragma unroll
                    for (int j = 0; j < 4; ++j) { a[j] = silu1(a[j]); b[j] = silu1(b[j]); }
                    st_bf8(G + (size_t)row * 1024 + (pn - 8) * 256 + cl, a, b);
                } else {
                    const int c = (pn - 12) * 256 + cl; const f32x4 b0 = *(const f32x4*)(ba + c), b1 = *(const f32x4*)(ba + c + 4);
                    f32x4 l0, l1;
#pragma unroll
                    for (int j = 0; j < 4; ++j) {
                        { const float x = a[j] + b0[j]; l0[j] = (fminf(x, 0.f) - __logf(1.f + fexp(-fabsf(x)))) * 0.0625f; }
                        { const float x = b[j] + b1[j]; l1[j] = (fminf(x, 0.f) - __logf(1.f + fexp(-fabsf(x)))) * 0.0625f; }
                    }
                    *(f32x4*)(LOGF + (size_t)row * 512 + c) = l0; *(f32x4*)(LOGF + (size_t)row * 512 + c + 4) = l1;
                }
            }
        EPI_ROWS_END
    }
};
struct Args { const void* in[25]; float* out; unsigned char* ws; int ph_lo, ph_hi; };
struct Frame {
    LAS unsigned char* lds; volatile LAS unsigned* MISC; unsigned* ctl; unsigned char* ws;
    int tid, lane, wave, G, gw, NGW;
};
#define IN_F(i) ((const float*)args.in[i])
constexpr size_t OUT_YP = 0, OUT_YS = OUT_YP + (size_t)NP * D, OUT_MRP = OUT_YS + (size_t)NS * D, OUT_MRS = OUT_MRP + (size_t)2 * NP * LAT, OUT_HSP = OUT_MRS + (size_t)2 * NS * LAT,
                 OUT_HSS = OUT_HSP + (size_t)2 * 8 * 4 * 128 * 128, OUT_GSP = OUT_HSS + (size_t)2 * 32 * 4 * 128 * 128, OUT_GSS = OUT_GSP + (size_t)2 * 8 * 4 * 128 * 256;
#define WSP(T, off) ((T*)(F.ws + (off)))

struct TJob { const float* W; const float* gain; bf16_t* WT; int ldw, scol, K, ncols, ldt, drow, dk0; };
__device__ __forceinline__ void transpose_item(const TJob& J, int item, LAS float* scr, int lane) {
    const int nblk = J.ncols / 32, kb = item / nblk, nb = item % nblk, k0 = 64 * kb, n0 = 32 * nb;
#pragma unroll 8
    for (int i = 0; i < 32; ++i) { const int kk = 2 * i + (lane >> 5); float v = J.W[(size_t)(k0 + kk) * J.ldw + J.scol + n0 + (lane & 31)]; if (J.gain) v *= J.gain[k0 + kk]; scr[kk * 33 + (lane & 31)] = v; }
    asm volatile("s_waitcnt lgkmcnt(0)" ::: "memory");
    const int c = lane & 7;
#pragma unroll
    for (int j = 0; j < 4; ++j) { const int n = (lane >> 3) + 8 * j; const LAS float* s = scr + (8 * c) * 33 + n;
        u32x4 o; o.x = cvt_pk_bf16(s[0 * 33], s[1 * 33]); o.y = cvt_pk_bf16(s[2 * 33], s[3 * 33]); o.z = cvt_pk_bf16(s[4 * 33], s[5 * 33]); o.w = cvt_pk_bf16(s[6 * 33], s[7 * 33]);
        *(u32x4*)(J.WT + (size_t)(J.drow + n0 + n) * J.ldt + J.dk0 + k0 + 8 * c) = o; }
    asm volatile("s_waitcnt lgkmcnt(0)" ::: "memory");
}
__device__ __forceinline__ TJob get_job(const Frame& F, const Args& args, int j) {
    TJob J;
    if (j < 10) { const int e = j / 5, s = j % 5; const float* W = IN_F(9) + (size_t)e * 1024 * 2752; bf16_t* WT = WSP(bf16_t, WS_WINE) + (size_t)e * NE1 * 1024;
        const float* gn = IN_F(6) + (2 * e) * 1024;
        if (s == 0) J = TJob{W, gn, WT, 2752, 0, 1024, 2048, 1024, 0, 0};
        else if (s == 1) J = TJob{W, gn, WT, 2752, 2432, 1024, 256, 1024, 2048, 0};
        else if (s == 2) J = TJob{W, gn, WT, 2752, 2048, 1024, 384, 1024, 2304, 0};
        else if (s == 3) J = TJob{W, gn, WT, 2752, 2688, 1024, 64, 1024, 2688, 0};
        else J = TJob{IN_F(17) + (size_t)e * 1024 * 1024, nullptr, WSP(bf16_t, WS_WOUTE) + (size_t)e * 1024 * KOE, 1024, 0, 512, 1024, KOE, 0, 0};
    } else if (j < 14) { const int o = (j - 10) >> 1;
        if (((j - 10) & 1) == 0) J = TJob{IN_F(18) + (size_t)o * 1024 * 3088, IN_F(6) + (2 * o + 1) * 1024, WSP(bf16_t, WS_WINO) + (size_t)o * NO1 * 1024, 3088, 0, 1024, 3072, 1024, 0, 0};
        else J = TJob{IN_F(22) + (size_t)o * 1024 * 1024, nullptr, WSP(bf16_t, WS_WOUTO) + (size_t)o * 1024 * 1024, 1024, 0, 1024, 1024, 1024, 0, 0};
    } else { const int l = (j - 14) >> 1;
        if (((j - 14) & 1) == 0) J = TJob{IN_F(23) + (size_t)l * 1024 * FF, IN_F(7) + l * 1024, WSP(bf16_t, WS_WUP) + (size_t)l * FF * 1024, FF, 0, 1024, FF, 1024, 0, 0};
        else J = TJob{IN_F(24) + (size_t)l * FF * 1024, nullptr, WSP(bf16_t, WS_WDOWN) + (size_t)l * 1024 * FF, 1024, 0, FF, 1024, FF, 0, 0};
    }
    return J;
}
__device__ __forceinline__ void p0_prologue(Frame& F, const Args& args) {
    LAS float* scr = (LAS float*)(F.lds + F.wave * 16384);
    for (int j = 0; j < 22; ++j) { const TJob J = get_job(F, args, j); const int nit = (J.K / 64) * (J.ncols / 32);
        for (int it = F.gw; it < nit; it += F.NGW) transpose_item(J, it, scr, F.lane); }
    __syncthreads();
    LAS float* sm = (LAS float*)(F.lds);
    for (int it = blockIdx.x; it < 512; it += F.G) {
        const int kind = it >> 8, r = it & 255, e = r >> 7, h = (r >> 5) & 3, c8 = r & 31;
        __syncthreads();
        if (kind == 0) {
            for (int i = F.tid; i < 1024; i += 512) sm[i] = IN_F(15)[((size_t)((e * 4 + h) * 256 + c8 * 8 + (i >> 7))) * 128 + (i & 127)];
            __syncthreads();
            if (F.tid < 384) { const int k = F.tid; const f32x4* a = (const f32x4*)(IN_F(13) + (size_t)(e * 384 + k) * 768 + h * 192); float acc[8] = {};
                for (int n4 = 0; n4 < 32; ++n4) { const f32x4 av = a[n4];
#pragma unroll
                    for (int c = 0; c < 8; ++c) { const f32x4 bv = *(const LAS f32x4*)(sm + c * 128 + n4 * 4); acc[c] += (av[0] * bv[0] + av[1] * bv[1]) + (av[2] * bv[2] + av[3] * bv[3]); } }
                const float gq = IN_F(12)[e * 384 + k] * QSCALE; bf16_t* dst = WSP(bf16_t, WS_WQ2) + ((size_t)e * NQ2 + h * 256 + c8 * 8) * 384 + k;
#pragma unroll
                for (int c = 0; c < 8; ++c) dst[(size_t)c * 384] = (bf16_t)(cvt_pk_bf16(acc[c] * gq, 0.f) & 0xffffu); }
        } else {
            for (int i = F.tid; i < 1024; i += 512) sm[i] = IN_F(16)[((size_t)((e * 4 + h) * 256 + c8 * 8 + (i >> 7))) * 128 + (i & 127)];
            __syncthreads();
            for (int n = F.tid; n < 1024; n += 512) { const float* wo = IN_F(17) + ((size_t)e * 1024 + 512 + h * 128) * 1024 + n; float acc[8] = {};
                for (int v = 0; v < 128; ++v) { const float x = wo[(size_t)v * 1024];
#pragma unroll
                    for (int c = 0; c < 8; ++c) acc[c] += sm[c * 128 + v] * x; }
                u32x4 o; o.x = cvt_pk_bf16(acc[0], acc[1]); o.y = cvt_pk_bf16(acc[2], acc[3]); o.z = cvt_pk_bf16(acc[4], acc[5]); o.w = cvt_pk_bf16(acc[6], acc[7]);
                *(u32x4*)(WSP(bf16_t, WS_WOUTE) + ((size_t)e * 1024 + n) * KOE + 512 + h * 256 + c8 * 8) = o; }
        }
    }
    const int gt = blockIdx.x * 512 + F.tid, NT = F.G * 512;
    for (int idx = gt; idx < 2 * 256 * 384; idx += NT) {
        const int k = idx % 384, cc = (idx / 384) & 255, e = idx / (384 * 256), hh = cc >> 6, w6 = cc & 63, g = w6 >> 3, i = w6 & 7, sj = i < 4 ? 4 * g + i : 32 + 4 * g + (i - 4);
        const float v = IN_F(13)[(size_t)(e * 384 + k) * 768 + hh * 192 + 128 + sj] * IN_F(12)[e * 384 + k] * QSCALE;
        WSP(bf16_t, WS_WQ2)[((size_t)e * NQ2 + 1024 + cc) * 384 + k] = (bf16_t)(cvt_pk_bf16(v, 0.f) & 0xffffu); }
    for (int idx = gt; idx < 2 * 8 * 1024; idx += NT) {
        const int k = idx & 1023, jp = (idx >> 10) & 7, o = idx >> 13; const f32x4* ar = (const f32x4*)(IN_F(18) + (size_t)(o * 1024 + k) * 3088 + 3072);
        const f32x4 a0 = ar[0], a1 = ar[1], a2 = ar[2], a3 = ar[3]; const float gn = IN_F(6)[(2 * o + 1) * 1024 + k];
        const float av[16] = {a0[0], a0[1], a0[2], a0[3], a1[0], a1[1], a1[2], a1[3], a2[0], a2[1], a2[2], a2[3], a3[0], a3[1], a3[2], a3[3]};
        for (int j = jp * 64; j < jp * 64 + 64; ++j) { float s = 0.f;
#pragma unroll
            for (int r = 0; r < 16; ++r) s += av[r] * IN_F(19)[(size_t)(o * 16 + r) * 512 + j];
            WSP(bf16_t, WS_WINO)[((size_t)o * NO1 + 3072 + j) * 1024 + k] = (bf16_t)(cvt_pk_bf16(s * gn, 0.f) & 0xffffu); } }
    for (int idx = gt; idx < 2 * 64 * 128; idx += NT) {
        const int e = idx >> 13, r = idx & 8191; *(u32x4*)(WSP(bf16_t, WS_WINE) + ((size_t)e * NE1 + 2752) * 1024 + (size_t)r * 8) = (u32x4){0u, 0u, 0u, 0u}; }
    for (int idx = gt; idx < 512; idx += NT) {
        const float a = IN_F(10)[idx], b = IN_F(10)[512 + idx], mx = fmaxf(a, b), ea = __expf(a - mx), eb = __expf(b - mx);
        WSP(float, WS_LBS)[idx] = 0.f; WSP(float, WS_LBS)[512 + idx] = eb / (ea + eb); }
    for (int idx = gt; idx < 2056 * 32; idx += NT) {
        const int j = idx & 31, pi = idx >> 5; const double pos = (double)(pi < SEQ ? pi : PAST + (pi - SEQ));
        const double inv = exp2(-(double)j * (13.287712379549449 / 32.0)), ang = pos * inv, n = rint(ang * 0.15915494309189535), r = ang - n * 6.283185307179586;
        WSP(float, WS_ROPE)[(size_t)pi * 64 + j] = cosf((float)r); WSP(float, WS_ROPE)[(size_t)pi * 64 + 32 + j] = sinf((float)r); }
    for (int m = F.gw; m < NTOK; m += F.NGW) {
        const float* xr = m < NP ? IN_F(0) + (size_t)m * D : IN_F(1) + (size_t)(m - NP) * D; float s = 0.f;
#pragma unroll
        for (int j = 0; j < 4; ++j) { const f32x4 v = *(const f32x4*)(xr + j * 256 + F.lane * 4); s += (v[0] * v[0] + v[1] * v[1]) + (v[2] * v[2] + v[3] * v[3]);
            u32x2 w; w.x = cvt_pk_bf16(v[0], v[1]); w.y = cvt_pk_bf16(v[2], v[3]); *(u32x2*)(WSP(bf16_t, WS_XB) + (size_t)m * D + j * 256 + F.lane * 4) = w; }
        s = wave_sum(s);
        if (F.lane < 16) WSP(float, WS_SSQ)[(size_t)m * 16 + F.lane] = F.lane == 0 ? s : 0.f;
    }
}

__device__ __forceinline__ void finalize_rows(Frame& F, const Args& args, int e) {
    const float* CKV = WSP(float, WS_CKV); const float* KR = WSP(float, WS_KR); bf16_t* KVL = WSP(bf16_t, WS_KVL); const float* rope = WSP(float, WS_ROPE);
    int lane_ = F.lane; asm volatile("" : "+v"(lane_));
    const f32x4 w4 = *(const f32x4*)(IN_F(14) + e * 256 + lane_ * 4);
    for (int r = F.gw; r < NTOK; r += F.NGW) {
        const f32x4 v = *(const f32x4*)(CKV + (size_t)r * 256 + lane_ * 4);
        const float ss = wave_sum((v[0] * v[0] + v[1] * v[1]) + (v[2] * v[2] + v[3] * v[3])), rs = rsqrtf(ss * (1.f / 256.f) + EPS);
        const f32x4 o = v * rs * w4;
        float* od = r < NP ? (args.out + OUT_MRP) + ((size_t)e * NP + r) * LAT : (args.out + OUT_MRS) + ((size_t)e * NS + (r - NP)) * LAT;
        *(f32x4*)(od + lane_ * 4) = o;
        u32x2 w; w.x = cvt_pk_bf16(o[0], o[1]); w.y = cvt_pk_bf16(o[2], o[3]); *(u32x2*)(KVL + (size_t)r * LAT + lane_ * 4) = w;
        if (lane_ < 32) { const float x1 = KR[(size_t)r * 64 + lane_], x2 = KR[(size_t)r * 64 + 32 + lane_]; const float* rp = rope + (size_t)rope_idx(r) * 64;
            const float c = rp[lane_], sn = rp[32 + lane_], a = x1 * c - x2 * sn, b = x1 * sn + x2 * c;
            od[256 + lane_] = a; od[288 + lane_] = b;
            KVL[(size_t)r * LAT + 256 + lane_] = (bf16_t)(cvt_pk_bf16(a, 0.f) & 0xffffu); KVL[(size_t)r * LAT + 288 + lane_] = (bf16_t)(cvt_pk_bf16(b, 0.f) & 0xffffu); }
    }
}

constexpr int KP = 656, KT_BYTES = 64 * KP;
#define NEG_INF (-__builtin_inff())
__device__ __forceinline__ s16x4 tr_read(const LAS unsigned char* p) { return __builtin_amdgcn_ds_read_tr16_b64_v4i16((LAS s16x4*)p); }
__device__ __forceinline__ bf16x8 pack_frag(const f32x4 a, const f32x4 b) { u32x4 w; w.x = cvt_pk_bf16(a[0], a[1]); w.y = cvt_pk_bf16(a[2], a[3]); w.z = cvt_pk_bf16(b[0], b[1]); w.w = cvt_pk_bf16(b[2], b[3]); return __builtin_bit_cast(bf16x8, w); }
__device__ __forceinline__ bf16x8 join_frag(const s16x4 a, const s16x4 b) { return (bf16x8){a[0], a[1], a[2], a[3], b[0], b[1], b[2], b[3]}; }
template <int NKB, int NCB, bool MASK>
__device__ __forceinline__ void attn_tile(const LAS unsigned char* kt, int key0, int cbase, const bf16x8 (&qf)[10], f32x4 (&O)[NCB], float& m, float& l, int lane, int keyabs0, int limit) {
    const int fr = lane & 15, g = lane >> 4;
    f32x4 S[NKB];
#pragma unroll
    for (int kb = 0; kb < NKB; ++kb) { S[kb] = (f32x4){0.f, 0.f, 0.f, 0.f};
        const LAS unsigned char* kr = kt + (key0 + kb * 16 + fr) * KP + g * 16;
#pragma unroll
        for (int ds = 0; ds < 10; ++ds) S[kb] = __builtin_amdgcn_mfma_f32_16x16x32_bf16(*(const LAS bf16x8*)(kr + ds * 64), qf[ds], S[kb], 0, 0, 0);
        asm volatile("" ::: "memory"); }
    if constexpr (MASK) {
#pragma unroll
        for (int kb = 0; kb < NKB; ++kb)
#pragma unroll
            for (int i = 0; i < 4; ++i) if (keyabs0 + key0 + kb * 16 + 4 * g + i > limit) S[kb][i] = NEG_INF;
    }
    float mx = NEG_INF;
#pragma unroll
    for (int kb = 0; kb < NKB; ++kb) mx = fmaxf(fmaxf(mx, fmaxf(S[kb][0], S[kb][1])), fmaxf(S[kb][2], S[kb][3]));
    mx = fmaxf(mx, __shfl_xor(mx, 16)); mx = fmaxf(mx, __shfl_xor(mx, 32));
    const float mn = fmaxf(m, mx), mu = (mn == NEG_INF) ? 0.f : mn, alpha = fexp2(m - mu);
    float ls = 0.f;
#pragma unroll
    for (int kb = 0; kb < NKB; ++kb)
#pragma unroll
        for (int i = 0; i < 4; ++i) { const float p = fexp2(S[kb][i] - mu); S[kb][i] = p; ls += p; }
    l = l * alpha + ls; m = mn;
#pragma unroll
    for (int cb = 0; cb < NCB; ++cb) O[cb] = O[cb] * alpha;
#pragma unroll
    for (int p2 = 0; p2 < NKB / 2; ++p2) {
        const bf16x8 pf = pack_frag(S[2 * p2], S[2 * p2 + 1]);
        const LAS unsigned char* vr = kt + (key0 + 32 * p2 + 4 * g + (fr >> 2)) * KP + (cbase + 4 * (fr & 3)) * 2;
#pragma unroll
        for (int cb = 0; cb < NCB; ++cb) { const bf16x8 a = join_frag(tr_read(vr + cb * 32), tr_read(vr + cb * 32 + 16 * KP)); O[cb] = __builtin_amdgcn_mfma_f32_16x16x32_bf16(a, pf, O[cb], 0, 0, 0);
            if ((cb & 3) == 3) asm volatile("" ::: "memory"); }
    }
}
__device__ __forceinline__ void attn_prompt_unit(Frame& F, int b, int qb) {
    const bf16_t* KVL = WSP(bf16_t, WS_KVL); const bf16_t* QL = WSP(bf16_t, WS_QL); bf16_t* OA = WSP(bf16_t, WS_OA);
    int tid_ = F.tid; asm volatile("" : "+v"(tid_));
    const int w = F.wave, lane = tid_ & 63, fr = lane & 15, g = lane >> 4, h = w & 3, half = w >> 2;
    const int pos = 32 * qb + 16 * half + fr, row = b * SEQ + pos;
    bf16x8 qf[10];
#pragma unroll
    for (int ds = 0; ds < 10; ++ds) qf[ds] = *(const bf16x8*)(QL + (size_t)row * QL_LD + h * LAT + ds * 32 + g * 8);
    f32x4 O[16];
#pragma unroll
    for (int cb = 0; cb < 16; ++cb) O[cb] = (f32x4){0.f, 0.f, 0.f, 0.f};
    float m = NEG_INF, l = 0.f;
    const int ntiles = (qb >> 1) + 1;
    const u32x4* src = (const u32x4*)(KVL + (size_t)b * SEQ * LAT);
    u32x4 st[5];
#define PA_LOAD(kt) do { _Pragma("unroll") for (int i = 0; i < 5; ++i) st[i] = src[(size_t)(kt) * 2560 + tid_ + 512 * i]; } while (0)
#define PA_WRITE(buf) do { _Pragma("unroll") for (int i = 0; i < 5; ++i) { const int ch = tid_ + 512 * i, key = ch / 40, c16 = ch % 40; *(LAS u32x4*)(F.lds + (buf) * KT_BYTES + key * KP + c16 * 16) = st[i]; } } while (0)
    PA_LOAD(0); PA_WRITE(0); __syncthreads();
    for (int kt = 0; kt < ntiles; ++kt) {
        if (kt + 1 < ntiles) PA_LOAD(kt + 1);
        const LAS unsigned char* kb = F.lds + (kt & 1) * KT_BYTES;
        attn_tile<4, 16, true>(kb, 0, 0, qf, O, m, l, lane, 64 * kt, pos);
        if (kt + 1 < ntiles) PA_WRITE((kt + 1) & 1);
        __syncthreads();
    }
#undef PA_LOAD
#undef PA_WRITE
    l += __shfl_xor(l, 16); l += __shfl_xor(l, 32);
    const float inv = 1.f / l;
    bf16_t* dst = OA + (size_t)row * KOE + 512 + h * 256 + 4 * g;
#pragma unroll
    for (int cb = 0; cb < 16; ++cb) { const f32x4 o = O[cb] * inv; u32x2 wv; wv.x = cvt_pk_bf16(o[0], o[1]); wv.y = cvt_pk_bf16(o[2], o[3]); *(u32x2*)(dst + cb * 16) = wv; }
}
__device__ __forceinline__ void attn_decode_unit(Frame& F, const Args& args, int e, int bd, int sp) {
    const bf16_t* KVL = WSP(bf16_t, WS_KVL); const bf16_t* QL = WSP(bf16_t, WS_QL); float* PO = WSP(float, WS_PO); float* PML = WSP(float, WS_PML);
    const float* cache = IN_F(2) + (size_t)e * NPHYS * PAGE * LAT;
    int tid_ = F.tid; asm volatile("" : "+v"(tid_));
    const int w = F.wave, lane = tid_ & 63, fr = lane & 15, g = lane >> 4, rg = w & 1, kh = (w >> 1) & 1, ch = w >> 2;
    const int rr = 16 * rg + fr, td = rr >> 2, h = rr & 3, row = NP + bd * DSEQ + td;
    bf16x8 qf[10];
#pragma unroll
    for (int ds = 0; ds < 10; ++ds) qf[ds] = *(const bf16x8*)(QL + (size_t)row * QL_LD + h * LAT + ds * 32 + g * 8);
    f32x4 O[8];
#pragma unroll
    for (int cb = 0; cb < 8; ++cb) O[cb] = (f32x4){0.f, 0.f, 0.f, 0.f};
    float m = NEG_INF, l = 0.f;
    constexpr int PPS = NPAGES / NSPLIT, NT = 2 * PPS;
    f32x4 st[10];
#define DA_LOAD(t) do { const int pg = ((const int*)args.in[5])[bd * NPAGES + sp * PPS + ((t) >> 1)]; const f32x4* bp = (const f32x4*)(cache + ((size_t)pg * PAGE + ((t) & 1) * 64) * LAT); \
        _Pragma("unroll") for (int i = 0; i < 10; ++i) st[i] = __builtin_nontemporal_load(bp + tid_ + 512 * i); } while (0)
#define DA_WRITE(buf) do { _Pragma("unroll") for (int i = 0; i < 10; ++i) { const int idx = tid_ + 512 * i, key = idx / 80, d4 = idx % 80; u32x2 wv; wv.x = cvt_pk_bf16(st[i][0], st[i][1]); wv.y = cvt_pk_bf16(st[i][2], st[i][3]); \
        *(LAS u32x2*)(F.lds + (buf) * KT_BYTES + key * KP + d4 * 8) = wv; } } while (0)
    DA_LOAD(0); DA_WRITE(0); __syncthreads();
    for (int t = 0; t < NT; ++t) {
        if (t + 1 < NT) DA_LOAD(t + 1);
        attn_tile<2, 8, false>(F.lds + (t & 1) * KT_BYTES, 32 * kh, 128 * ch, qf, O, m, l, lane, 0, 0);
        if (t + 1 < NT) DA_WRITE((t + 1) & 1);
        __syncthreads();
    }
#undef DA_LOAD
#undef DA_WRITE
    if (sp == NSPLIT - 1) {
        for (int i = tid_; i < 320 + 24 * 41; i += 512) {
            if (i < 320) { const int key = i / 40, c16 = i % 40; *(LAS u32x4*)(F.lds + key * KP + c16 * 16) = *(const u32x4*)(KVL + (size_t)(NP + bd * DSEQ + key) * LAT + c16 * 8); }
            else { const int j = i - 320; *(LAS u32x4*)(F.lds + 8 * KP + j * 16) = (u32x4){0u, 0u, 0u, 0u}; }
        }
        __syncthreads();
        if (kh == 0) attn_tile<2, 8, true>(F.lds, 0, 128 * ch, qf, O, m, l, lane, PAST, PAST + td);
        __syncthreads();
    }
    l += __shfl_xor(l, 16); l += __shfl_xor(l, 32);
    const int se = sp * 2 + kh; const size_t pr = ((size_t)(bd * NSE + se) * 32 + rr);
#pragma unroll
    for (int cb = 0; cb < 8; ++cb) *(f32x4*)(PO + pr * 256 + 128 * ch + 16 * cb + 4 * g) = O[cb];
    if (ch == 0 && g == 0) { PML[pr * 2] = m; PML[pr * 2 + 1] = l; }
}
__device__ __forceinline__ void attn_decode_combine(Frame& F) {
    const float* PO = WSP(float, WS_PO); const float* PML = WSP(float, WS_PML); bf16_t* OA = WSP(bf16_t, WS_OA);
    for (int r = F.gw; r < 32 * 32; r += F.NGW) {
        const int bd = r >> 5, rr = r & 31, td = rr >> 2, h = rr & 3;
        float mm = NEG_INF, ll = 0.f;
        if (F.lane < NSE) { const size_t pr = ((size_t)(bd * NSE + F.lane) * 32 + rr); mm = PML[pr * 2]; ll = PML[pr * 2 + 1]; }
        float M = mm;
#pragma unroll
        for (int o = 1; o < 64; o <<= 1) M = fmaxf(M, __shfl_xor(M, o));
        const float wgt = (F.lane < NSE) ? fexp2(mm - M) : 0.f; const float L = wave_sum(wgt * ll);
        f32x4 acc = (f32x4){0.f, 0.f, 0.f, 0.f};
        for (int se = 0; se < NSE; ++se) { const float ws_ = __shfl(wgt, se); acc = acc + *(const f32x4*)(PO + ((size_t)(bd * NSE + se) * 32 + rr) * 256 + F.lane * 4) * ws_; }
        const float inv = 1.f / L; u32x2 wv; wv.x = cvt_pk_bf16(acc[0] * inv, acc[1] * inv); wv.y = cvt_pk_bf16(acc[2] * inv, acc[3] * inv);
        *(u32x2*)(OA + (size_t)(NP + bd * DSEQ + td) * KOE + 512 + h * 256 + F.lane * 4) = wv;
    }
}

template <int NV, bool HAS_S0>
__device__ __forceinline__ void scan_unit(Frame& F, const float* nw, const float* s0, float* sout, int ldo, int coff, int row0, int T, int h) {
    constexpr int VD = 128 * NV, LDV = 4 * VD, PV = 2 * VD + 16, PQ = 272, PK = 144;
    constexpr int O_QT0 = 0, O_QH = 64 * PQ, O_KH = 2 * 64 * PQ, O_KLT = 3 * 64 * PQ, O_VT = O_KLT + 128 * PK, O_DEC = O_VT + 64 * PV, O_XS = O_DEC + 512, O_NRM = O_XS + 8192;
    static_assert(O_NRM + 2048 <= RING_BYTES, "scan LDS");
    const bf16_t* Qh = WSP(bf16_t, WS_QH); const bf16_t* KK = WSP(bf16_t, WS_KK); const float* LOGF = WSP(float, WS_LOGF); const bf16_t* V = WSP(bf16_t, WS_V); const bf16_t* G = WSP(bf16_t, WS_G); bf16_t* OA = WSP(bf16_t, WS_OA);
    LAS unsigned char* lds = F.lds;
    int tid = F.tid; asm volatile("" : "+v"(tid));
    const int w = F.wave, lane = tid & 63, fr = lane & 15, g = lane >> 4;
    f32x4 S[8][NV];
#pragma unroll
    for (int kb = 0; kb < 8; ++kb)
#pragma unroll
        for (int nv = 0; nv < NV; ++nv) {
            if constexpr (HAS_S0) { const float* sp = s0 + (size_t)(16 * kb + 4 * g) * VD + (w * NV + nv) * 16 + fr;
                const float a0 = sp[0], a1 = sp[VD], a2 = sp[2 * VD], a3 = sp[3 * VD]; S[kb][nv] = (f32x4){a0, a1, a2, a3}; }
            else S[kb][nv] = (f32x4){0.f, 0.f, 0.f, 0.f};
        }
    for (int c0 = 0; c0 < T; c0 += 64) {
        {
            const int k4 = (tid & 31) * 4, ts = tid >> 5, t0 = 4 * ts;
            const size_t rbase = (size_t)(row0 + c0 + t0) * 512 + h * 128 + k4;
            f32x4 bl[4]; u32x2 qw[4], kw[4]; f32x4 run = (f32x4){0.f, 0.f, 0.f, 0.f};
#pragma unroll
            for (int i = 0; i < 4; ++i) { const bool ok = c0 + t0 + i < T; f32x4 lf = (f32x4){0.f, 0.f, 0.f, 0.f}; qw[i] = (u32x2){0u, 0u}; kw[i] = (u32x2){0u, 0u};
                if (ok) { lf = *(const f32x4*)(LOGF + rbase + (size_t)i * 512); qw[i] = *(const u32x2*)(Qh + rbase + (size_t)i * 512); kw[i] = *(const u32x2*)(KK + rbase + (size_t)i * 512); }
                run = run + lf; bl[i] = run; }
            *(LAS f32x4*)(lds + O_XS + (ts * 128 + k4) * 4) = run;
#pragma unroll
            for (int j = 0; j < 2 * NV; ++j) { const int chn = tid + 512 * j, s = chn / (VD / 8), cc = chn % (VD / 8); u32x4 val = (u32x4){0u, 0u, 0u, 0u};
                if (c0 + s < T) val = *(const u32x4*)(V + (size_t)(row0 + c0 + s) * LDV + h * VD + cc * 8);
                *(LAS u32x4*)(lds + O_VT + s * PV + cc * 16) = val; }
            __syncthreads();
            f32x4 pre = (f32x4){0.f, 0.f, 0.f, 0.f}, b31 = pre, bL = pre;
#pragma unroll
            for (int s = 0; s < 16; ++s) { const f32x4 x = *(const LAS f32x4*)(lds + O_XS + (s * 128 + k4) * 4); if (s < ts) pre = pre + x; if (s < 8) b31 = b31 + x; bL = bL + x; }
            f32x4 klv[4];
#pragma unroll
            for (int i = 0; i < 4; ++i) {
                const f32x4 b = pre + bl[i]; f32x4 q, k, e0, em, ek, eL;
                q[0] = bflo(qw[i].x); q[1] = bfhi(qw[i].x); q[2] = bflo(qw[i].y); q[3] = bfhi(qw[i].y);
                k[0] = bflo(kw[i].x); k[1] = bfhi(kw[i].x); k[2] = bflo(kw[i].y); k[3] = bfhi(kw[i].y);
#pragma unroll
                for (int c = 0; c < 4; ++c) { e0[c] = fexp(b[c]); em[c] = fexp(b[c] - b31[c]); ek[c] = fexp(b31[c] - b[c]); eL[c] = fexp(bL[c] - b[c]); }
                const f32x4 a0 = q * e0, a1 = q * em, a2 = k * ek; klv[i] = k * eL;
                const int ro = (t0 + i) * PQ + k4 * 2;
                *(LAS u32x2*)(lds + O_QT0 + ro) = (u32x2){cvt_pk_bf16(a0[0], a0[1]), cvt_pk_bf16(a0[2], a0[3])};
                *(LAS u32x2*)(lds + O_QH + ro) = (u32x2){cvt_pk_bf16(a1[0], a1[1]), cvt_pk_bf16(a1[2], a1[3])};
                *(LAS u32x2*)(lds + O_KH + ro) = (u32x2){cvt_pk_bf16(a2[0], a2[1]), cvt_pk_bf16(a2[2], a2[3])};
            }
#pragma unroll
            for (int c = 0; c < 4; ++c) *(LAS u32x2*)(lds + O_KLT + (k4 + c) * PK + t0 * 2) = (u32x2){cvt_pk_bf16(klv[0][c], klv[1][c]), cvt_pk_bf16(klv[2][c], klv[3][c])};
            if (ts == 0) { f32x4 d; d[0] = fexp(bL[0]); d[1] = fexp(bL[1]); d[2] = fexp(bL[2]); d[3] = fexp(bL[3]); *(LAS f32x4*)(lds + O_DEC + k4 * 4) = d; }
            __syncthreads();
        }
        bf16x8 sB[4][NV];
#pragma unroll
        for (int ks = 0; ks < 4; ++ks)
#pragma unroll
            for (int nv = 0; nv < NV; ++nv) sB[ks][nv] = pack_frag(S[2 * ks][nv], S[2 * ks + 1][nv]);
        f32x4 Oo[4][NV];
        {
            bf16x8 vP[2][NV];
#pragma unroll
            for (int p = 0; p < 2; ++p)
#pragma unroll
                for (int nv = 0; nv < NV; ++nv) { const LAS unsigned char* a1 = lds + O_VT + (32 * p + 4 * g + (fr >> 2)) * PV + ((w * NV + nv) * 16 + 4 * (fr & 3)) * 2; vP[p][nv] = join_frag(tr_read(a1), tr_read(a1 + 16 * PV)); }
#pragma unroll
            for (int tb = 0; tb < 4; ++tb) {
                f32x4 X[4];
                {
                    bf16x8 bq[4];
#pragma unroll
                    for (int ks = 0; ks < 4; ++ks) bq[ks] = *(const LAS bf16x8*)(lds + O_QH + (16 * tb + fr) * PQ + ks * 64 + g * 16);
#pragma unroll
                    for (int sb = 0; sb < 4; ++sb) { X[sb] = (f32x4){0.f, 0.f, 0.f, 0.f};
                        if (sb <= tb) {
#pragma unroll
                            for (int ks = 0; ks < 4; ++ks) X[sb] = __builtin_amdgcn_mfma_f32_16x16x32_bf16(*(const LAS bf16x8*)(lds + O_KH + (16 * sb + fr) * PQ + ks * 64 + g * 16), bq[ks], X[sb], 0, 0, 0);
                            if (sb == tb) {
#pragma unroll
                                for (int i = 0; i < 4; ++i) if (4 * g + i > fr) X[sb][i] = 0.f; } } }
                }
#pragma unroll
                for (int nv = 0; nv < NV; ++nv) Oo[tb][nv] = (f32x4){0.f, 0.f, 0.f, 0.f};
#pragma unroll
                for (int p = 0; p < 2; ++p) if (p <= (tb >> 1)) {
                    const bf16x8 pf = pack_frag(X[2 * p], X[2 * p + 1]);
#pragma unroll
                    for (int nv = 0; nv < NV; ++nv) Oo[tb][nv] = __builtin_amdgcn_mfma_f32_16x16x32_bf16(pf, vP[p][nv], Oo[tb][nv], 0, 0, 0);
                }
#pragma unroll
                for (int ks = 0; ks < 4; ++ks) {
                    const LAS unsigned char* qa = lds + O_QT0 + (16 * tb + fr) * PQ + (32 * ks + 4 * g) * 2;
                    const u32x2 q0 = *(const LAS u32x2*)qa, q1 = *(const LAS u32x2*)(qa + 32);
                    const bf16x8 aq = __builtin_bit_cast(bf16x8, (u32x4){q0.x, q0.y, q1.x, q1.y});
#pragma unroll
                    for (int nv = 0; nv < NV; ++nv) Oo[tb][nv] = __builtin_amdgcn_mfma_f32_16x16x32_bf16(aq, sB[ks][nv], Oo[tb][nv], 0, 0, 0);
                }
                asm volatile("" ::: "memory");
            }
        }
        bf16x8 vN[2][NV];
#pragma unroll
        for (int p = 0; p < 2; ++p)
#pragma unroll
            for (int nv = 0; nv < NV; ++nv) { const LAS unsigned char* a2 = lds + O_VT + (32 * p + 8 * g + (fr >> 2)) * PV + ((w * NV + nv) * 16 + 4 * (fr & 3)) * 2; vN[p][nv] = join_frag(tr_read(a2), tr_read(a2 + 4 * PV)); }
#pragma unroll
        for (int kb = 0; kb < 8; ++kb) {
            const f32x4 d4 = *(const LAS f32x4*)(lds + O_DEC + (16 * kb + 4 * g) * 4);
#pragma unroll
            for (int nv = 0; nv < NV; ++nv) S[kb][nv] = S[kb][nv] * d4;
#pragma unroll
            for (int p = 0; p < 2; ++p) { const bf16x8 a = *(const LAS bf16x8*)(lds + O_KLT + (16 * kb + fr) * PK + p * 64 + g * 16);
#pragma unroll
                for (int nv = 0; nv < NV; ++nv) S[kb][nv] = __builtin_amdgcn_mfma_f32_16x16x32_bf16(a, vN[p][nv], S[kb][nv], 0, 0, 0); }
        }
#pragma unroll
        for (int tb = 0; tb < 4; ++tb)
#pragma unroll
            for (int i = 0; i < 4; ++i) { float ss = 0.f;
#pragma unroll
                for (int nv = 0; nv < NV; ++nv) ss += Oo[tb][nv][i] * Oo[tb][nv][i];
                ss += __shfl_xor(ss, 1); ss += __shfl_xor(ss, 2); ss += __shfl_xor(ss, 4); ss += __shfl_xor(ss, 8);
                if (fr == 0) ((LAS float*)(lds + O_NRM))[(16 * tb + 4 * g + i) * 8 + w] = ss; }
        __syncthreads();
#pragma unroll
        for (int tb = 0; tb < 4; ++tb)
#pragma unroll
            for (int i = 0; i < 4; ++i) { const int tl = 16 * tb + 4 * g + i; const LAS f32x4* np = (const LAS f32x4*)(lds + O_NRM + tl * 32); const f32x4 n0 = np[0], n1 = np[1];
                const float rs = rsqrtf(((n0[0] + n0[1]) + (n0[2] + n0[3]) + (n1[0] + n1[1]) + (n1[2] + n1[3])) * (1.f / VD) + EPS);
                if (c0 + tl < T) { int ri = row0 + c0 + tl; asm volatile("" : "+v"(ri)); const size_t r = (size_t)ri;
#pragma unroll
                    for (int nv = 0; nv < NV; ++nv) { const int v = (w * NV + nv) * 16 + fr; const float gt = bf2f(G[r * LDV + h * VD + v]);
                        OA[r * ldo + coff + h * VD + v] = (bf16_t)(cvt_pk_bf16(Oo[tb][nv][i] * rs * nw[v] * gt, 0.f) & 0xffffu); } } }
    }
#pragma unroll
    for (int kb = 0; kb < 8; ++kb) {
        float* so = sout + (size_t)(16 * kb + 4 * g) * VD + w * NV * 16 + fr; asm volatile("" : "+v"(so));
#pragma unroll
        for (int nv = 0; nv < NV; ++nv)
#pragma unroll
            for (int i = 0; i < 4; ++i) so[i * VD + nv * 16] = S[kb][nv][i];
    }
    __syncthreads();
}
constexpr int N_PHASES = 30;
__device__ __forceinline__ int queue_claim(Frame& F, unsigned* head) {
    __syncthreads();
    if (F.tid == 0) F.MISC[16] = __hip_atomic_fetch_add(head, 1u, __ATOMIC_RELAXED, __HIP_MEMORY_SCOPE_AGENT);
    __syncthreads();
    return (int)F.MISC[16];
}
__global__ void __launch_bounds__(512, 2) mega_fwd(Args args) {
    extern __shared__ __attribute__((aligned(16))) unsigned char lds_raw[];
    Frame F;
    F.lds = (LAS unsigned char*)lds_raw; F.MISC = (volatile LAS unsigned*)(F.lds + MISC_OFF);
    F.tid = threadIdx.x; F.lane = F.tid & 63; F.wave = __builtin_amdgcn_readfirstlane(F.tid >> 6); F.G = gridDim.x; F.gw = blockIdx.x * 8 + F.wave; F.NGW = F.G * 8;
    F.ws = args.ws; F.ctl = (unsigned*)(args.ws + WS_CTL);
    for (int u = F.tid; u < (LDS_BYTES - MISC_OFF) / 4; u += 512) ((LAS unsigned*)(F.lds + MISC_OFF))[u] = 0u;
    __syncthreads();
    const int lo = args.ph_lo, hi = args.ph_hi;
    XcdBarrier bar; bar.bar = F.ctl + CW_BAR; bar.x = 0; bar.st = nullptr;
    if (hi - lo > 1) bar = xcd_barrier_post(F.ctl + CW_BAR, F.MISC + 8);
#ifdef MK_ONLY
#define INC(k, c) ((c) == MK_ONLY && lo <= (k) && (k) < hi)
#else
#define INC(k, c) (lo <= (k) && (k) < hi)
#endif
#define SEAM(k) do { if (hi > (k) + 1) xcd_barrier(bar); } while (0)
    const RowScale rsX{WSP(float, WS_SSQ), 16, 4, 1.f / 1024.f};
    const RowScale rsQ{WSP(float, WS_SSQCQ), 16, 3, 1.f / 384.f};
    const RowScale rsNone{nullptr, 0, 0, 0.f};

    if (INC(0, 0)) { asm volatile("" : "+s"(F.ws)); p0_prologue(F, args); SEAM(0); }

    for (int l = 0; l < 4; ++l) {
        const int pb = 1 + 7 * l, eo = l >> 1;
        const float* resP = l == 0 ? IN_F(0) : WSP(float, WS_X); const float* resS = l == 0 ? IN_F(1) : WSP(float, WS_X) + (size_t)NP * D;
        if ((l & 1) == 0) {
            if (INC(pb, 1)) { asm volatile("" : "+s"(F.ws));
                Gemm g{WSP(bf16_t, WS_XB), WSP(bf16_t, WS_WINE) + (size_t)eo * NE1 * 1024, 1024, 1024, NTOK, NE1, 1024}; StaticOrder S; S.init(NTOK, NE1, F.G, (int)blockIdx.x);
                EpiInEven E{WSP(bf16_t, WS_QH), WSP(bf16_t, WS_KK), WSP(float, WS_LOGF), WSP(bf16_t, WS_V), WSP(bf16_t, WS_G), WSP(float, WS_CKV), WSP(float, WS_KR), WSP(bf16_t, WS_CQ), WSP(float, WS_SSQCQ), WSP(float, WS_LBS) + eo * 512};
                gemm_phase<EpiInEven, true>(F.lds, g, S, E, rsX);
                SEAM(pb);
            }
            if (INC(pb + 1, 2)) { asm volatile("" : "+s"(F.ws));
#ifndef MK_NOFIN
                finalize_rows(F, args, eo);
#endif
                Gemm g{WSP(bf16_t, WS_CQ), WSP(bf16_t, WS_WQ2) + (size_t)eo * NQ2 * 384, 384, 384, NTOK, NQ2, 384}; StaticOrder S; S.init(NTOK, NQ2, F.G, (int)blockIdx.x);
                EpiQ2 E{WSP(bf16_t, WS_QL), WSP(float, WS_ROPE)};
                gemm_phase<EpiQ2, true>(F.lds, g, S, E, rsQ);
                SEAM(pb + 1);
            }
            if (INC(pb + 2, 3)) { asm volatile("" : "+s"(F.ws));
                unsigned* head = F.ctl + CW_QUEUE + 64 * l;
                for (;;) {
                    const int u = queue_claim(F, head);
                    if (u >= 32 + 1024 + 128) break;
#ifndef MK_SUB
#define MK_SUB 7
#endif
                    if (u < 32) { if (MK_SUB & 1) { const int b = u >> 2, h = u & 3; scan_unit<1, false>(F, IN_F(11) + eo * 128, nullptr, (args.out + OUT_HSP) + ((size_t)(eo * 8 + b) * 4 + h) * 128 * 128, KOE, 0, b * SEQ, SEQ, h); } }
                    else if (u < 32 + 1024) { const int j = u - 32, i = j >> 1;
                        if ((j & 1) == 0) { if (MK_SUB & 2) attn_decode_unit(F, args, eo, i & 31, i >> 5); }
                        else { if (MK_SUB & 4) attn_prompt_unit(F, i & 7, 63 - (i >> 3)); } }
                    else { if (MK_SUB & 1) { const int j = u - 1056, bd = j >> 2, h = j & 3;
                        scan_unit<1, true>(F, IN_F(11) + eo * 128, IN_F(3) + ((size_t)(eo * 32 + bd) * 4 + h) * 128 * 128, (args.out + OUT_HSS) + ((size_t)(eo * 32 + bd) * 4 + h) * 128 * 128, KOE, 0, NP + bd * DSEQ, DSEQ, h); } }
                }
                SEAM(pb + 2);
            }
            if (INC(pb + 3, 4)) { asm volatile("" : "+s"(F.ws)); attn_decode_combine(F); SEAM(pb + 3); }
            if (INC(pb + 4, 5)) { asm volatile("" : "+s"(F.ws));
                Gemm g{WSP(bf16_t, WS_OA), WSP(bf16_t, WS_WOUTE) + (size_t)eo * 1024 * KOE, KOE, KOE, NTOK, 1024, KOE}; StaticOrder S; S.init(NTOK, 1024, F.G, (int)blockIdx.x);
                EpiOutRes E{resP, resS, WSP(float, WS_X), WSP(bf16_t, WS_XB), WSP(float, WS_SSQ)};
                gemm_phase<EpiOutRes, false>(F.lds, g, S, E, rsNone);
                SEAM(pb + 4);
            }
        } else {
            if (INC(pb, 6)) { asm volatile("" : "+s"(F.ws));
                Gemm g{WSP(bf16_t, WS_XB), WSP(bf16_t, WS_WINO) + (size_t)eo * NO1 * 1024, 1024, 1024, NTOK, NO1, 1024}; StaticOrder S; S.init(NTOK, NO1, F.G, (int)blockIdx.x);
                EpiInOdd E{WSP(bf16_t, WS_QH), WSP(bf16_t, WS_KK), WSP(bf16_t, WS_V), WSP(bf16_t, WS_G), WSP(float, WS_LOGF), IN_F(20) + eo * 512};
                gemm_phase<EpiInOdd, true>(F.lds, g, S, E, rsX);
                SEAM(pb);
            }
            if (INC(pb + 2, 7)) { asm volatile("" : "+s"(F.ws));
                unsigned* head = F.ctl + CW_QUEUE + 64 * l;
                for (;;) {
                    const int u = queue_claim(F, head);
                    if (u >= 32 + 128) break;
                    if (u < 32) { const int b = u >> 2, h = u & 3; scan_unit<2, false>(F, IN_F(21) + eo * 256, nullptr, (args.out + OUT_GSP) + ((size_t)(eo * 8 + b) * 4 + h) * 128 * 256, 1024, 0, b * SEQ, SEQ, h); }
                    else { const int j = u - 32, bd = j >> 2, h = j & 3;
                        scan_unit<2, true>(F, IN_F(21) + eo * 256, IN_F(4) + ((size_t)(eo * 32 + bd) * 4 + h) * 128 * 256, (args.out + OUT_GSS) + ((size_t)(eo * 32 + bd) * 4 + h) * 128 * 256, 1024, 0, NP + bd * DSEQ, DSEQ, h); }
                }
                SEAM(pb + 2);
            }
            if (INC(pb + 4, 8)) { asm volatile("" : "+s"(F.ws));
                Gemm g{WSP(bf16_t, WS_OA), WSP(bf16_t, WS_WOUTO) + (size_t)eo * 1024 * 1024, 1024, 1024, NTOK, 1024, 1024}; StaticOrder S; S.init(NTOK, 1024, F.G, (int)blockIdx.x);
                EpiOutRes E{resP, resS, WSP(float, WS_X), WSP(bf16_t, WS_XB), WSP(float, WS_SSQ)};
                gemm_phase<EpiOutRes, false>(F.lds, g, S, E, rsNone);
                SEAM(pb + 4);
            }
        }
        if (INC(pb + 5, 9)) { asm volatile("" : "+s"(F.ws));
            Gemm g{WSP(bf16_t, WS_XB), WSP(bf16_t, WS_WUP) + (size_t)l * FF * 1024, 1024, 1024, NTOK, FF, 1024}; StaticOrder S; S.init(NTOK, FF, F.G, (int)blockIdx.x);
            EpiUp E{WSP(bf16_t, WS_FFB)};
            gemm_phase<EpiUp, true>(F.lds, g, S, E, rsX);
            SEAM(pb + 5);
        }
        if (INC(pb + 6, 10)) { asm volatile("" : "+s"(F.ws));
            Gemm g{WSP(bf16_t, WS_FFB), WSP(bf16_t, WS_WDOWN) + (size_t)l * 1024 * FF, FF, FF, NTOK, 1024, FF}; StaticOrder S; S.init(NTOK, 1024, F.G, (int)blockIdx.x);
            EpiOutRes E{WSP(float, WS_X), WSP(float, WS_X) + (size_t)NP * D, WSP(float, WS_X), WSP(bf16_t, WS_XB), WSP(float, WS_SSQ)};
            gemm_phase<EpiOutRes, false>(F.lds, g, S, E, rsNone);
            SEAM(pb + 6);
        }
    }
    if (INC(29, 11)) { asm volatile("" : "+s"(F.ws));
        const float* X = WSP(float, WS_X); const float* SSQ = WSP(float, WS_SSQ);
        for (int m = F.gw; m < NTOK; m += F.NGW) {
            const f32x4* sp = (const f32x4*)(SSQ + (size_t)m * 16); const f32x4 s0 = sp[0], s1 = sp[1], s2 = sp[2], s3 = sp[3];
            const float ss = ((s0[0] + s0[1]) + (s0[2] + s0[3])) + ((s1[0] + s1[1]) + (s1[2] + s1[3])) + ((s2[0] + s2[1]) + (s2[2] + s2[3])) + ((s3[0] + s3[1]) + (s3[2] + s3[3]));
            const float rs = rsqrtf(ss * (1.f / 1024.f) + EPS);
            float* od = m < NP ? (args.out + OUT_YP) + (size_t)m * D : (args.out + OUT_YS) + (size_t)(m - NP) * D;
#pragma unroll
            for (int j = 0; j < 4; ++j) { const int c = j * 256 + F.lane * 4; *(f32x4*)(od + c) = *(const f32x4*)(X + (size_t)m * D + c) * rs * *(const f32x4*)(IN_F(8) + c); }
        }
    }
#undef INC
#undef SEAM
}
#undef WSP
#undef IN_F
}

#ifndef MK_ONE_LAUNCH
#define MK_ONE_LAUNCH 0
#endif
static void mk_launch(void* const* d_in, void* d_out, void* d_ws, size_t ws_size, hipStream_t stream) {
    static int grid = 0;
    if (grid == 0) {
        int dev = 0, cus = 0, per_cu = 0;
        if (ws_size < mk::WS_END) { fprintf(stderr, "kernel_launch: workspace too small (%zu < %zu)\n", ws_size, (size_t)mk::WS_END); grid = -1; return; }
        if (hipGetDevice(&dev) != hipSuccess || hipDeviceGetAttribute(&cus, hipDeviceAttributeMultiprocessorCount, dev) != hipSuccess) { grid = -1; return; }
        if (hipFuncSetAttribute((const void*)mk::mega_fwd, hipFuncAttributeMaxDynamicSharedMemorySize, mk::LDS_BYTES) != hipSuccess) { fprintf(stderr, "kernel_launch: hipFuncSetAttribute failed\n"); grid = -1; return; }
        if (hipOccupancyMaxActiveBlocksPerMultiprocessor(&per_cu, (const void*)mk::mega_fwd, 512, mk::LDS_BYTES) != hipSuccess || per_cu < 1) { fprintf(stderr, "kernel_launch: occupancy query says %d blocks per CU\n", per_cu); }
        (void)hipGetLastError();
        grid = cus;
    }
    if (grid < 0) return;
    (void)hipMemsetAsync((char*)d_ws + mk::WS_CTL, 0, mk::CTL_BYTES, stream);
    mk::Args a{};
    for (int i = 0; i < 25; ++i) a.in[i] = d_in[i];
    a.out = (float*)d_out; a.ws = (unsigned char*)d_ws;
#if MK_ONE_LAUNCH
    a.ph_lo = 0; a.ph_hi = mk::N_PHASES;
    hipLaunchKernelGGL(mk::mega_fwd, dim3(grid), dim3(512), mk::LDS_BYTES, stream, a);
#else
    for (int p = 0; p < mk::N_PHASES; ++p) {
        if (p >= 1 && p < 29) { const int l = (p - 1) / 7, k = (p - 1) % 7; if ((l & 1) && (k == 1 || k == 3)) continue; }
        a.ph_lo = p; a.ph_hi = p + 1;
        hipLaunchKernelGGL(mk::mega_fwd, dim3(grid), dim3(512), mk::LDS_BYTES, stream, a);
    }
#endif
}

extern "C" void kernel_launch(void* const* d_in, const int* in_sizes, int n_in, void* d_out, int out_size, void* d_ws, size_t ws_size, hipStream_t stream) {
    if (n_in != 25) { fprintf(stderr, "kernel_launch: unexpected n_in %d\n", n_in); return; }
    mk_launch(d_in, d_out, d_ws, ws_size, stream);
}
```

```cpp
#include <hip/hip_runtime.h>
#include <cstdio>
#include <cstdint>
#define MK_ONE_LAUNCH 1
namespace mk {
#define LAS __attribute__((address_space(3)))
typedef unsigned short bf16_t;
typedef short bf16x8 __attribute__((ext_vector_type(8)));
typedef short s16x4 __attribute__((ext_vector_type(4)));
typedef float f32x4 __attribute__((ext_vector_type(4)));
typedef unsigned u32x4 __attribute__((ext_vector_type(4)));
typedef unsigned u32x2 __attribute__((ext_vector_type(2)));

constexpr int D = 1024, NP = 16384, NS = 256, NTOK = NP + NS, SEQ = 2048, DSEQ = 8, PAST = 16384, PAGE = 128, NPAGES = 128, NPHYS = 5120;
constexpr int FF = 4096, LAT = 320, QL_LD = 1280, NE1 = 2816, NQ2 = 1280, KOE = 1536, NO1 = 3584;
constexpr int NSPLIT = 16, NSE = 2 * NSPLIT;
constexpr float EPS = 1e-6f;
constexpr float QSCALE = 0.07216878364870322f * 1.4426950408889634f;

constexpr size_t MiB = 1u << 20;
constexpr size_t WS_CTL = 0, CTL_BYTES = 2 * MiB;
constexpr size_t WS_WINE = 2 * MiB;
constexpr size_t WS_WQ2 = WS_WINE + 2ull * NE1 * 1024 * 2;
constexpr size_t WS_WOUTE = WS_WQ2 + 2ull * NQ2 * 384 * 2;
constexpr size_t WS_WINO = WS_WOUTE + 2ull * 1024 * KOE * 2;
constexpr size_t WS_WOUTO = WS_WINO + 2ull * NO1 * 1024 * 2;
constexpr size_t WS_WUP = WS_WOUTO + 2ull * 1024 * 1024 * 2;
constexpr size_t WS_WDOWN = WS_WUP + 4ull * FF * 1024 * 2;
constexpr size_t WS_LBS = WS_WDOWN + 4ull * FF * 1024 * 2;
constexpr size_t WS_ROPE = WS_LBS + 4096;
constexpr size_t WS_X = (WS_ROPE + 2056ull * 64 * 4 + 4095) & ~(size_t)4095;
constexpr size_t WS_XB = WS_X + (size_t)NTOK * D * 4;
constexpr size_t WS_SSQ = WS_XB + (size_t)NTOK * D * 2;
constexpr size_t WS_QH = WS_SSQ + (size_t)NTOK * 16 * 4;
constexpr size_t WS_KK = WS_QH + (size_t)NTOK * 512 * 2;
constexpr size_t WS_LOGF = WS_KK + (size_t)NTOK * 512 * 2;
constexpr size_t WS_V = WS_LOGF + (size_t)NTOK * 512 * 4;
constexpr size_t WS_G = WS_V + (size_t)NTOK * 1024 * 2;
constexpr size_t WS_CKV = WS_G + (size_t)NTOK * 1024 * 2;
constexpr size_t WS_KR = WS_CKV + (size_t)NTOK * 256 * 4;
constexpr size_t WS_CQ = WS_KR + (size_t)NTOK * 64 * 4;
constexpr size_t WS_SSQCQ = WS_CQ + (size_t)NTOK * 384 * 2;
constexpr size_t WS_KVL = WS_SSQCQ + (size_t)NTOK * 16 * 4;
constexpr size_t WS_QL = WS_KVL + (size_t)NTOK * LAT * 2;
constexpr size_t WS_OA = WS_QL + (size_t)NTOK * QL_LD * 2;
constexpr size_t WS_FFB = WS_OA + (size_t)NTOK * KOE * 2;
constexpr size_t WS_PO = WS_FFB + (size_t)NTOK * FF * 2;
constexpr size_t WS_PML = WS_PO + 32ull * NSE * 32 * 256 * 4;
constexpr size_t WS_END = WS_PML + 32ull * NSE * 32 * 2 * 4;
constexpr int CW_BAR = 4096;
constexpr int CW_QUEUE = 16384;

constexpr int RING_BYTES = 131072, SCL_OFF = RING_BYTES  , MISC_OFF = SCL_OFF + 2048, LDS_BYTES = MISC_OFF + 2048;

__device__ __forceinline__ unsigned cvt_pk_bf16(float lo, float hi) { unsigned r; asm volatile("v_cvt_pk_bf16_f32 %0, %1, %2" : "=v"(r) : "v"(lo), "v"(hi)); return r; }
__device__ __forceinline__ float bf2f(bf16_t b) { return __uint_as_float(((unsigned)b) << 16); }
__device__ __forceinline__ float bflo(unsigned w) { return __uint_as_float(w << 16); }
__device__ __forceinline__ float bfhi(unsigned w) { return __uint_as_float(w & 0xffff0000u); }
__device__ __forceinline__ float fexp2(float x) { return __builtin_amdgcn_exp2f(x); }
__device__ __forceinline__ float fexp(float x) { return __builtin_amdgcn_exp2f(x * 1.4426950408889634f); }
__device__ __forceinline__ float frcp(float x) { return __builtin_amdgcn_rcpf(x); }
__device__ __forceinline__ float sigm(float x) { return frcp(1.f + fexp(-x)); }
__device__ __forceinline__ float wave_sum(float v) {
#pragma unroll
    for (int o = 1; o < 64; o <<= 1) v += __shfl_xor(v, o);
    return v;
}
__device__ __forceinline__ int rope_idx(int row) { return row < NP ? (row & (SEQ - 1)) : SEQ + ((row - NP) & (DSEQ - 1)); }

#define XB_TMO      128
#define XB_XCNT(j)  (256  + 64 * (j))
#define XB_XSUB(j)  (1280 + 64 * (j))
#define XB_XGEN(j)  (2304 + 64 * (j))
#define XB_TOP      3328
#define XB_TOPGEN   3392
#define XCD_BAR_WORDS 3456
#define XB_SPIN_CAP (1u << 18)
__device__ __forceinline__ unsigned xb_ld(unsigned* p)              { return __hip_atomic_load(p, __ATOMIC_RELAXED, __HIP_MEMORY_SCOPE_AGENT); }
__device__ __forceinline__ unsigned xb_add(unsigned* p, unsigned v) { return __hip_atomic_fetch_add(p, v, __ATOMIC_RELAXED, __HIP_MEMORY_SCOPE_AGENT); }
__device__ __forceinline__ unsigned xb_xcc_id() { return (unsigned)__builtin_amdgcn_s_getreg((3 << 11) | 20) & 0xFu; }
#define XB_SPIN(cond, bar) do { unsigned _sp = 0; while (cond) { __builtin_amdgcn_s_sleep(1); \
    if ((++_sp & 255u) == 0u) { if (xb_ld(&(bar)[XB_TMO])) break; if (_sp > XB_SPIN_CAP) { atomicAdd(&(bar)[XB_TMO], 1u); break; } } } } while (0)
struct XcdBarrier { unsigned* bar; unsigned x; volatile LAS unsigned* st; };
__device__ __forceinline__ XcdBarrier xcd_barrier_post(unsigned* bar, volatile LAS unsigned* st) {
    XcdBarrier b; b.bar = bar; b.x = xb_xcc_id(); b.st = st;
    if (threadIdx.x == 0) (void)xb_add(&bar[XB_XCNT(b.x)], 1u);
    return b;
}
__device__ __forceinline__ void xcd_barrier_complete(unsigned* bar, unsigned x, unsigned& nloc, unsigned& nx) {
    const unsigned G = gridDim.x * gridDim.y * gridDim.z;
    unsigned sum, cnt, mine, sp = 0u;
    for (;;) {
        sum = 0u; cnt = 0u; mine = 0u;
#pragma unroll
        for (unsigned j = 0; j < 16; ++j) { const unsigned c = xb_ld(&bar[XB_XCNT(j)]); sum += c; cnt += (c > 0u) ? 1u : 0u; mine = (j == x) ? c : mine; }
        if (sum == G) break;
        __builtin_amdgcn_s_sleep(1);
        if ((++sp & 255u) == 0u) { if (xb_ld(&bar[XB_TMO])) break; if (sp > XB_SPIN_CAP) { atomicAdd(&bar[XB_TMO], 1u); break; } }
    }
    nloc = mine > 0u ? mine : 1u; nx = cnt > 0u ? cnt : 1u;
}
__device__ __forceinline__ void xcd_barrier(const XcdBarrier& b) {
    asm volatile("s_waitcnt vmcnt(0)" ::: "memory");
    __syncthreads();
    if (threadIdx.x == 0) {
        unsigned* bar = b.bar;
        __builtin_amdgcn_s_waitcnt(0);
        unsigned nloc = b.st[0], nx = b.st[1];
        if (nloc == 0u) { xcd_barrier_complete(bar, b.x, nloc, nx); b.st[0] = nloc; b.st[1] = nx; }
        const unsigned old = xb_add(&bar[XB_XSUB(b.x)], 1u);
        const unsigned gen = old / nloc;
        if (old + 1u == (gen + 1u) * nloc) {
            __builtin_amdgcn_fence(__ATOMIC_RELEASE, "agent");
            asm volatile("s_waitcnt vmcnt(0)" ::: "memory");
            const unsigned og = xb_add(&bar[XB_TOP], 1u);
            const unsigned tg = og / nx;
            if (og + 1u == (tg + 1u) * nx) xb_add(&bar[XB_TOPGEN], 1u);
            else XB_SPIN(xb_ld(&bar[XB_TOPGEN]) == tg, bar);
            __builtin_amdgcn_fence(__ATOMIC_ACQUIRE, "agent");
            xb_add(&bar[XB_XGEN(b.x)], 1u);
            asm volatile("s_waitcnt vmcnt(0)" ::: "memory");
        } else {
            XB_SPIN(xb_ld(&bar[XB_XGEN(b.x)]) == gen, bar);
            __builtin_amdgcn_fence(__ATOMIC_ACQUIRE, "agent");
            asm volatile("s_waitcnt vmcnt(0)" ::: "memory");
        }
    }
    __syncthreads();
}

constexpr int BM = 256, BK = 64, HALF = 128, HTB = HALF * BK * 2, NXCD = 8, WGM = 8;
__host__ __device__ __forceinline__ int lds_byte(int r, int c) { const int st = (r >> 4) * 2 + (c >> 5), rr = r & 15, cc = c & 31, ob = rr * 64 + cc * 2; return st * 1024 + (ob ^ (((ob >> 9) & 1) << 5)); }
__host__ __device__ __forceinline__ void stage_rc(int b, int& R, int& C) { const int st = b / 1024, sb = b % 1024, swz = sb ^ (((sb >> 9) & 1) << 5); R = (st >> 1) * 16 + swz / 64; C = (st & 1) * 32 + (swz % 64) / 2; }
__host__ __device__ __forceinline__ int perm32(int rho) { const int n = rho >> 4, i = rho & 15; return 8 * (i >> 2) + 4 * n + (i & 3); }
struct Unit { int pm, pn, idx; };
struct Gemm { const bf16_t* A; const bf16_t* Bt; int lda, ldb, M, N, K; };
struct RowScale { const float* part; int stride, np4; float inv_n; };
struct StaticOrder {
    int nM, nN, nwg, G, c;
    __device__ void init(int M, int N, int G_, int c_) { nM = M / BM; nN = N / BM; nwg = nM * nN; G = G_; c = c_; }
    __device__ bool next(int i, Unit& u) const {
        const long L = (long)i * G + c; if (L >= nwg) return false;
        int wgid = (int)L; { const int q = nwg / NXCD, r = nwg % NXCD, xcd = wgid % NXCD, off = wgid / NXCD; wgid = (xcd < r ? xcd * (q + 1) : r * (q + 1) + (xcd - r) * q) + off; }
        const int nig = WGM * nN, gid = wgid / nig, fm = gid * WGM, gsz = (nM - fm) < WGM ? (nM - fm) : WGM;
        u.pm = fm + ((wgid % nig) % gsz); u.pn = (wgid % nig) / gsz; u.idx = i; return true;
    }
};
template <bool SCALE>
__device__ __forceinline__ void rs_fill(LAS unsigned char* ldsbase, const RowScale& rs, const Unit& u, int tid) {
    if constexpr (SCALE) {
        if (tid < 256) {
            const f32x4* p = (const f32x4*)(rs.part + (size_t)(u.pm * BM + tid) * rs.stride); float s = 0.f;
            for (int j = 0; j < rs.np4; ++j) { const f32x4 v = p[j]; s += (v[0] + v[1]) + (v[2] + v[3]); }
            ((LAS float*)(ldsbase + SCL_OFF))[(u.idx & 1) * 256 + tid] = rsqrtf(s * rs.inv_n + EPS);
        }
    }
}
template <class Epi, bool SCALE>
__device__ __forceinline__ void gemm_phase(LAS unsigned char* lds, const Gemm g, const StaticOrder& S, const Epi& E, const RowScale rs) {
    int tid = threadIdx.x; asm volatile("" : "+v"(tid));
    const int wid = __builtin_amdgcn_readfirstlane(tid >> 6), lane = tid & 63, wr = wid >> 2, wc = wid & 3, fr = lane & 15, fq = lane >> 4;
    const int K = g.K, nt = K / BK;
    unsigned voffA[2], voffB[2];
#pragma unroll
    for (int i = 0; i < 2; ++i) { int R, C; stage_rc(tid * 16 + i * 8192, R, C); const int Rb = (R & ~31) + perm32(R & 31);
        voffA[i] = (unsigned)(R * g.lda + C) * 2u; voffB[i] = (unsigned)(Rb * g.ldb + C) * 2u; }
    const size_t kstep = (size_t)(BK * 2);
    const size_t hstepA = (size_t)HALF * g.lda * 2, hstepB = (size_t)HALF * g.ldb * 2;
    const size_t tstepA = 2 * hstepA, tstepB = 2 * hstepB;
    const unsigned ldsw = (unsigned)wid * 1024u;
    const int aoff = lds_byte(wr * 64 + fr, fq * 8), boff = lds_byte(wc * 32 + fr, fq * 8);
#define PG8_SA(b, h) (((b) * 2 + (h)) * HTB)
#define PG8_SB(b, h) ((4 + (b) * 2 + (h)) * HTB)
#define PG8_STAGE(bufoff, gbase, voff) do { _Pragma("unroll") for (int _i = 0; _i < 2; ++_i) \
        __builtin_amdgcn_global_load_lds((const unsigned*)((const char*)(gbase) + (voff)[_i]), (LAS unsigned*)(lds + (bufoff) + ldsw + _i * 8192), 16, 0, 0); } while (0)
#define PG8_LDA(dst, b, h) do { _Pragma("unroll") for (int m = 0; m < 4; ++m) _Pragma("unroll") for (int k = 0; k < 2; ++k) dst[m][k] = *(const LAS bf16x8*)(lds + PG8_SA(b, h) + aoff + m * 2048 + k * 1024); } while (0)
#define PG8_LDB(dst, b, h) do { _Pragma("unroll") for (int n = 0; n < 2; ++n) _Pragma("unroll") for (int k = 0; k < 2; ++k) dst[n][k] = *(const LAS bf16x8*)(lds + PG8_SB(b, h) + boff + n * 2048 + k * 1024); } while (0)
#define PG8_MMA(ai, bj, At, Bt) do { __builtin_amdgcn_s_setprio(1); _Pragma("unroll") for (int m = 0; m < 4; ++m) _Pragma("unroll") for (int n = 0; n < 2; ++n) _Pragma("unroll") for (int k = 0; k < 2; ++k) \
        acc[ai][bj][m][n] = __builtin_amdgcn_mfma_f32_16x16x32_bf16(Bt[n][k], At[m][k], acc[ai][bj][m][n], 0, 0, 0); __builtin_amdgcn_s_setprio(0); } while (0)
#define PG8_WAIT_V(n) asm volatile("s_waitcnt vmcnt(" #n ")" ::: "memory")
#define PG8_WAIT_L(n) asm volatile("s_waitcnt lgkmcnt(" #n ")" ::: "memory")
#define PG8_BAR __builtin_amdgcn_s_barrier()
#define PG8_SCHED __builtin_amdgcn_sched_barrier(0)
    Unit cur, nxt; int ui = 0;
    if (!S.next(0, cur)) return;
    f32x4 acc[2][2][4][2];
#pragma unroll
    for (int a = 0; a < 2; ++a)
#pragma unroll
        for (int b = 0; b < 2; ++b)
#pragma unroll
            for (int m = 0; m < 4; ++m)
#pragma unroll
                for (int n = 0; n < 2; ++n) acc[a][b][m][n] = (f32x4){0.f, 0.f, 0.f, 0.f};
    bf16x8 At[4][2], B0[2][2], B1[2][2];
    const char* cA = (const char*)g.A + (size_t)cur.pm * tstepA; const char* cB = (const char*)g.Bt + (size_t)cur.pn * tstepB;
    rs_fill<SCALE>(lds, rs, cur, tid);
    PG8_STAGE(PG8_SB(0, 0), cB, voffB); PG8_STAGE(PG8_SB(0, 1), cB + hstepB, voffB); PG8_STAGE(PG8_SA(0, 0), cA, voffA); PG8_STAGE(PG8_SA(0, 1), cA + hstepA, voffA);
    if (wr == 1) PG8_BAR;
    PG8_WAIT_V(2); PG8_BAR;
    PG8_STAGE(PG8_SB(1, 0), cB + kstep, voffB); PG8_STAGE(PG8_SA(1, 0), cA + kstep, voffA); PG8_STAGE(PG8_SB(1, 1), cB + hstepB + kstep, voffB);
    PG8_WAIT_V(6); PG8_BAR;
    for (;;) {
        const bool has_next = S.next(ui + 1, nxt);
        const char* nA = has_next ? (const char*)g.A + (size_t)nxt.pm * tstepA : cA; const char* nB = has_next ? (const char*)g.Bt + (size_t)nxt.pn * tstepB : cB;
#pragma unroll 1
        for (int t = 0; t < nt; t += 2) {
            const bool last = (t == nt - 2);
            const char* a1 = cA + (size_t)(t + 1) * kstep;
            const char* a2 = last ? nA : cA + (size_t)(t + 2) * kstep; const char* b2 = last ? nB : cB + (size_t)(t + 2) * kstep;
            const char* a3 = a2 + kstep; const char* b3 = b2 + kstep;
            if (last && has_next) rs_fill<SCALE>(lds, rs, nxt, tid);
            PG8_LDB(B0, 0, 0); PG8_LDB(B1, 0, 1); PG8_SCHED; PG8_LDA(At, 0, 0); PG8_STAGE(PG8_SA(1, 1), a1 + hstepA, voffA);
            PG8_WAIT_V(8); PG8_WAIT_L(0); PG8_BAR; PG8_MMA(0, 0, At, B0); PG8_MMA(0, 1, At, B1); PG8_BAR; PG8_SCHED;
            PG8_LDA(At, 0, 1); PG8_STAGE(PG8_SB(0, 0), b2, voffB); PG8_STAGE(PG8_SB(0, 1), b2 + hstepB, voffB); PG8_STAGE(PG8_SA(0, 0), a2, voffA);
            PG8_WAIT_V(8); PG8_WAIT_L(0); PG8_BAR; PG8_MMA(1, 0, At, B0); PG8_MMA(1, 1, At, B1); PG8_BAR; PG8_SCHED;
            PG8_LDB(B0, 1, 0); PG8_LDB(B1, 1, 1); PG8_SCHED; PG8_LDA(At, 1, 0); PG8_STAGE(PG8_SA(0, 1), a2 + hstepA, voffA);
            PG8_WAIT_V(8); PG8_WAIT_L(0); PG8_BAR; PG8_MMA(0, 0, At, B0); PG8_MMA(0, 1, At, B1); PG8_BAR; PG8_SCHED;
            PG8_LDA(At, 1, 1); PG8_STAGE(PG8_SB(1, 0), b3, voffB); PG8_STAGE(PG8_SB(1, 1), b3 + hstepB, voffB); PG8_STAGE(PG8_SA(1, 0), a3, voffA);
            PG8_WAIT_V(8); PG8_WAIT_L(0); PG8_BAR; PG8_MMA(1, 0, At, B0); PG8_MMA(1, 1, At, B1); PG8_BAR; PG8_SCHED;
        }
        if (wr == 0) PG8_BAR;
        { int fr_ = fr, fq_ = fq; asm volatile("" : "+v"(fr_), "+v"(fq_));
          E(acc, cur, wr, wc, fr_, fq_, (const LAS float*)(lds + SCL_OFF) + (cur.idx & 1) * 256); }
        if (!has_next) break;
#pragma unroll
        for (int a = 0; a < 2; ++a)
#pragma unroll
            for (int b = 0; b < 2; ++b)
#pragma unroll
                for (int m = 0; m < 4; ++m)
#pragma unroll
                    for (int n = 0; n < 2; ++n) acc[a][b][m][n] = (f32x4){0.f, 0.f, 0.f, 0.f};
        cur = nxt; cA = nA; cB = nB; ++ui;
        if (wr == 1) PG8_BAR;
    }
    PG8_WAIT_V(0);
    PG8_BAR;
#undef PG8_SA
#undef PG8_SB
#undef PG8_STAGE
#undef PG8_LDA
#undef PG8_LDB
#undef PG8_MMA
#undef PG8_WAIT_V
#undef PG8_WAIT_L
#undef PG8_BAR
#undef PG8_SCHED
}

#define EPI_ROWS_BEGIN  _Pragma("unroll") for (int ai = 0; ai < 2; ++ai) _Pragma("unroll") for (int m = 0; m < 4; ++m) { \
        const int rl = ai * HALF + wr * 64 + m * 16 + fr; const int row = u.pm * BM + rl; (void)row;
#define EPI_ROWS_END asm volatile("" ::: "memory"); }
__device__ __forceinline__ void st_bf8(bf16_t* p, const f32x4 a, const f32x4 b) { u32x4 w; w.x = cvt_pk_bf16(a[0], a[1]); w.y = cvt_pk_bf16(a[2], a[3]); w.z = cvt_pk_bf16(b[0], b[1]); w.w = cvt_pk_bf16(b[2], b[3]); *(u32x4*)p = w; }
__device__ __forceinline__ float sq8(const f32x4 a, const f32x4 b) { return (a[0] * a[0] + a[1] * a[1]) + (a[2] * a[2] + a[3] * a[3]) + (b[0] * b[0] + b[1] * b[1]) + (b[2] * b[2] + b[3] * b[3]); }
__device__ __forceinline__ float silu1(float x) { return x * frcp(1.f + fexp(-x)); }

struct EpiInEven {
    bf16_t* Qh; bf16_t* KK; float* LOGF; bf16_t* V; bf16_t* G; float* CKV; float* KR; bf16_t* CQ; float* SSQCQ; const float* lbs;
    __device__ __forceinline__ void operator()(const f32x4 (&acc)[2][2][4][2], const Unit& u, int wr, int wc, int fr, int fq, const LAS float* scl) const {
        const int pn = u.pn;
        EPI_ROWS_BEGIN
            const float s = scl[rl];
#pragma unroll
            for (int bj = 0; bj < 2; ++bj) {
                const int cl = bj * HALF + wc * 32 + 8 * fq;
                f32x4 a = acc[ai][bj][m][0] * s, b = acc[ai][bj][m][1] * s;
                if (pn < 2) {
#pragma unroll
                    for (int j = 0; j < 4; ++j) { a[j] = silu1(a[j]) * 0.08838834764831845f; b[j] = silu1(b[j]) * 0.08838834764831845f; }
                    st_bf8(Qh + (size_t)row * 512 + pn * 256 + cl, a, b);
                } else if (pn < 4) {
                    const int c = (pn - 2) * 256 + cl; const f32x4 l0 = *(const f32x4*)(lbs + c), l1 = *(const f32x4*)(lbs + c + 4);
                    f32x4 lf0, lf1, k0, k1;
#pragma unroll
                    for (int j = 0; j < 4; ++j) {
                        { const float z = a[j], lb = l0[j], sp = sigm(z), sn = sigm(-z); lf0[j] = __logf(fmaxf(lb + (1.f - lb) * sp, 1e-30f)); k0[j] = (1.f - lb) * sn; }
                        { const float z = b[j], lb = l1[j], sp = sigm(z), sn = sigm(-z); lf1[j] = __logf(fmaxf(lb + (1.f - lb) * sp, 1e-30f)); k1[j] = (1.f - lb) * sn; }
                    }
                    *(f32x4*)(LOGF + (size_t)row * 512 + c) = lf0; *(f32x4*)(LOGF + (size_t)row * 512 + c + 4) = lf1;
                    st_bf8(KK + (size_t)row * 512 + c, k0, k1);
                } else if (pn < 6) {
                    st_bf8(V + (size_t)row * 512 + (pn - 4) * 256 + cl, a, b);
                } else if (pn < 8) {
#pragma unroll
                    for (int j = 0; j < 4; ++j) { a[j] = silu1(a[j]); b[j] = silu1(b[j]); }
                    st_bf8(G + (size_t)row * 512 + (pn - 6) * 256 + cl, a, b);
                } else if (pn == 8) {
                    *(f32x4*)(CKV + (size_t)row * 256 + cl) = a; *(f32x4*)(CKV + (size_t)row * 256 + cl + 4) = b;
                } else if (pn == 9 || bj == 0) {
                    const int c = (pn - 9) * 256 + cl;
                    st_bf8(CQ + (size_t)row * 384 + c, a, b);
                    float ss = sq8(a, b); ss += __shfl_xor(ss, 16); ss += __shfl_xor(ss, 32);
                    if (fq == 0) SSQCQ[(size_t)row * 16 + (pn == 9 ? bj * 4 + wc : 8 + wc)] = ss;
                } else if (wc < 2) {
                    const int c = wc * 32 + 8 * fq;
                    *(f32x4*)(KR + (size_t)row * 64 + c) = a; *(f32x4*)(KR + (size_t)row * 64 + c + 4) = b;
                }
            }
        EPI_ROWS_END
    }
};
struct EpiQ2 {
    bf16_t* QL; const float* rope;
    __device__ __forceinline__ void operator()(const f32x4 (&acc)[2][2][4][2], const Unit& u, int wr, int wc, int fr, int fq, const LAS float* scl) const {
        const int pn = u.pn;
        if (pn < 4) {
            EPI_ROWS_BEGIN
                const float s = scl[rl]; bf16_t* dst = QL + (size_t)row * QL_LD + pn * LAT + wc * 32 + 8 * fq;
                st_bf8(dst, acc[ai][0][m][0] * s, acc[ai][0][m][1] * s); st_bf8(dst + HALF, acc[ai][1][m][0] * s, acc[ai][1][m][1] * s);
            EPI_ROWS_END
        } else {
            const int g = (wc & 1) * 4 + fq;
            EPI_ROWS_BEGIN
                const float s = scl[rl]; const float* rp = rope + rope_idx(row) * 64 + 4 * g;
                const f32x4 c = *(const f32x4*)rp, sn = *(const f32x4*)(rp + 32);
#pragma unroll
                for (int bj = 0; bj < 2; ++bj) {
                    const f32x4 a = acc[ai][bj][m][0] * s, b = acc[ai][bj][m][1] * s, o1 = a * c - b * sn, o2 = a * sn + b * c;
                    bf16_t* dst = QL + (size_t)row * QL_LD + (bj * 2 + (wc >> 1)) * LAT + 256 + 4 * g;
                    u32x2 w1, w2; w1.x = cvt_pk_bf16(o1[0], o1[1]); w1.y = cvt_pk_bf16(o1[2], o1[3]); w2.x = cvt_pk_bf16(o2[0], o2[1]); w2.y = cvt_pk_bf16(o2[2], o2[3]);
                    *(u32x2*)dst = w1; *(u32x2*)(dst + 32) = w2;
                }
            EPI_ROWS_END
        }
    }
};
struct EpiOutRes {
    const float* resP; const float* resS; float* X; bf16_t* XB; float* SSQ;
    __device__ __forceinline__ void operator()(const f32x4 (&acc)[2][2][4][2], const Unit& u, int wr, int wc, int fr, int fq, const LAS float* scl) const {
        EPI_ROWS_BEGIN
            const float* rr = row < NP ? resP + (size_t)row * D : resS + (size_t)(row - NP) * D;
            float ss = 0.f;
#pragma unroll
            for (int bj = 0; bj < 2; ++bj) {
                const int c = u.pn * BM + bj * HALF + wc * 32 + 8 * fq;
                const f32x4 a = acc[ai][bj][m][0] + *(const f32x4*)(rr + c), b = acc[ai][bj][m][1] + *(const f32x4*)(rr + c + 4);
                *(f32x4*)(X + (size_t)row * D + c) = a; *(f32x4*)(X + (size_t)row * D + c + 4) = b;
                st_bf8(XB + (size_t)row * D + c, a, b);
                ss += sq8(a, b);
            }
            ss += __shfl_xor(ss, 16); ss += __shfl_xor(ss, 32);
            if (fq == 0) SSQ[(size_t)row * 16 + u.pn * 4 + wc] = ss;
        EPI_ROWS_END
    }
};
struct EpiUp {
    bf16_t* FFB;
    __device__ __forceinline__ void operator()(const f32x4 (&acc)[2][2][4][2], const Unit& u, int wr, int wc, int fr, int fq, const LAS float* scl) const {
        EPI_ROWS_BEGIN
            const float s = scl[rl];
#pragma unroll
            for (int bj = 0; bj < 2; ++bj) {
                f32x4 a = acc[ai][bj][m][0] * s, b = acc[ai][bj][m][1] * s;
#pragma unroll
                for (int j = 0; j < 4; ++j) { const float x = fmaxf(a[j], 0.f), y = fmaxf(b[j], 0.f); a[j] = x * x; b[j] = y * y; }
                st_bf8(FFB + (size_t)row * FF + u.pn * BM + bj * HALF + wc * 32 + 8 * fq, a, b);
            }
        EPI_ROWS_END
    }
};
struct EpiInOdd {
    bf16_t* Qh; bf16_t* KK; bf16_t* V; bf16_t* G; float* LOGF; const float* ba;
    __device__ __forceinline__ void operator()(const f32x4 (&acc)[2][2][4][2], const Unit& u, int wr, int wc, int fr, int fq, const LAS float* scl) const {
        const int pn = u.pn;
        EPI_ROWS_BEGIN
            const float s = scl[rl];
#pragma unroll
            for (int bj = 0; bj < 2; ++bj) {
                const int cl = bj * HALF + wc * 32 + 8 * fq;
                f32x4 a = acc[ai][bj][m][0] * s, b = acc[ai][bj][m][1] * s;
                if (pn < 2) { a = a * 0.08838834764831845f; b = b * 0.08838834764831845f; st_bf8(Qh + (size_t)row * 512 + pn * 256 + cl, a, b); }
                else if (pn < 4) st_bf8(KK + (size_t)row * 512 + (pn - 2) * 256 + cl, a, b);
                else if (pn < 8) st_bf8(V + (size_t)row * 1024 + (pn - 4) * 256 + cl, a, b);
                else if (pn < 12) {
#pragma unroll
                    for (int j = 0; j < 4; ++j) { a[j] = silu1(a[j]); b[j] = silu1(b[j]); }
                    st_bf8(G + (size_t)row * 1024 + (pn - 8) * 256 + cl, a, b);
                } else {
                    const int c = (pn - 12) * 256 + cl; const f32x4 b0 = *(const f32x4*)(ba + c), b1 = *(const f32x4*)(ba + c + 4);
                    f32x4 l0, l1;
#pragma unroll
                    for (int j = 0; j < 4; ++j) {
                        { const float x = a[j] + b0[j]; l0[j] = (fminf(x, 0.f) - __logf(1.f + fexp(-fabsf(x)))) * 0.0625f; }
                        { const float x = b[j] + b1[j]; l1[j] = (fminf(x, 0.f) - __logf(1.f + fexp(-fabsf(x)))) * 0.0625f; }
                    }
                    *(f32x4*)(LOGF + (size_t)row * 512 + c) = l0; *(f32x4*)(LOGF + (size_t)row * 512 + c + 4) = l1;
                }
            }
        EPI_ROWS_END
    }
};
struct Args { const void* in[25]; float* out; unsigned char* ws; int ph_lo, ph_hi; };
struct Frame {
    LAS unsigned char* lds; volatile LAS unsigned* MISC; unsigned* ctl; unsigned char* ws;
    int tid, lane, wave, G, gw, NGW;
};
#define IN_F(i) ((const float*)args.in[i])
constexpr size_t OUT_YP = 0, OUT_YS = OUT_YP + (size_t)NP * D, OUT_MRP = OUT_YS + (size_t)NS * D, OUT_MRS = OUT_MRP + (size_t)2 * NP * LAT, OUT_HSP = OUT_MRS + (size_t)2 * NS * LAT,
                 OUT_HSS = OUT_HSP + (size_t)2 * 8 * 4 * 128 * 128, OUT_GSP = OUT_HSS + (size_t)2 * 32 * 4 * 128 * 128, OUT_GSS = OUT_GSP + (size_t)2 * 8 * 4 * 128 * 256;
#define WSP(T, off) ((T*)(F.ws + (off)))

struct TJob { const float* W; const float* gain; bf16_t* WT; int ldw, scol, K, ncols, ldt, drow, dk0; };
__device__ __forceinline__ void transpose_item(const TJob& J, int item, LAS float* scr, int lane) {
    const int nblk = J.ncols / 32, kb = item / nblk, nb = item % nblk, k0 = 64 * kb, n0 = 32 * nb;
#pragma unroll 8
    for (int i = 0; i < 32; ++i) { const int kk = 2 * i + (lane >> 5); float v = J.W[(size_t)(k0 + kk) * J.ldw + J.scol + n0 + (lane & 31)]; if (J.gain) v *= J.gain[k0 + kk]; scr[kk * 33 + (lane & 31)] = v; }
    asm volatile("s_waitcnt lgkmcnt(0)" ::: "memory");
    const int c = lane & 7;
#pragma unroll
    for (int j = 0; j < 4; ++j) { const int n = (lane >> 3) + 8 * j; const LAS float* s = scr + (8 * c) * 33 + n;
        u32x4 o; o.x = cvt_pk_bf16(s[0 * 33], s[1 * 33]); o.y = cvt_pk_bf16(s[2 * 33], s[3 * 33]); o.z = cvt_pk_bf16(s[4 * 33], s[5 * 33]); o.w = cvt_pk_bf16(s[6 * 33], s[7 * 33]);
        *(u32x4*)(J.WT + (size_t)(J.drow + n0 + n) * J.ldt + J.dk0 + k0 + 8 * c) = o; }
    asm volatile("s_waitcnt lgkmcnt(0)" ::: "memory");
}
__device__ __forceinline__ TJob get_job(const Frame& F, const Args& args, int j) {
    TJob J;
    if (j < 10) { const int e = j / 5, s = j % 5; const float* W = IN_F(9) + (size_t)e * 1024 * 2752; bf16_t* WT = WSP(bf16_t, WS_WINE) + (size_t)e * NE1 * 1024;
        const float* gn = IN_F(6) + (2 * e) * 1024;
        if (s == 0) J = TJob{W, gn, WT, 2752, 0, 1024, 2048, 1024, 0, 0};
        else if (s == 1) J = TJob{W, gn, WT, 2752, 2432, 1024, 256, 1024, 2048, 0};
        else if (s == 2) J = TJob{W, gn, WT, 2752, 2048, 1024, 384, 1024, 2304, 0};
        else if (s == 3) J = TJob{W, gn, WT, 2752, 2688, 1024, 64, 1024, 2688, 0};
        else J = TJob{IN_F(17) + (size_t)e * 1024 * 1024, nullptr, WSP(bf16_t, WS_WOUTE) + (size_t)e * 1024 * KOE, 1024, 0, 512, 1024, KOE, 0, 0};
    } else if (j < 14) { const int o = (j - 10) >> 1;
        if (((j - 10) & 1) == 0) J = TJob{IN_F(18) + (size_t)o * 1024 * 3088, IN_F(6) + (2 * o + 1) * 1024, WSP(bf16_t, WS_WINO) + (size_t)o * NO1 * 1024, 3088, 0, 1024, 3072, 1024, 0, 0};
        else J = TJob{IN_F(22) + (size_t)o * 1024 * 1024, nullptr, WSP(bf16_t, WS_WOUTO) + (size_t)o * 1024 * 1024, 1024, 0, 1024, 1024, 1024, 0, 0};
    } else { const int l = (j - 14) >> 1;
        if (((j - 14) & 1) == 0) J = TJob{IN_F(23) + (size_t)l * 1024 * FF, IN_F(7) + l * 1024, WSP(bf16_t, WS_WUP) + (size_t)l * FF * 1024, FF, 0, 1024, FF, 1024, 0, 0};
        else J = TJob{IN_F(24) + (size_t)l * FF * 1024, nullptr, WSP(bf16_t, WS_WDOWN) + (size_t)l * 1024 * FF, 1024, 0, FF, 1024, FF, 0, 0};
    }
    return J;
}
__device__ __forceinline__ void p0_prologue(Frame& F, const Args& args) {
    LAS float* scr = (LAS float*)(F.lds + F.wave * 16384);
    for (int j = 0; j < 22; ++j) { const TJob J = get_job(F, args, j); const int nit = (J.K / 64) * (J.ncols / 32);
        for (int it = F.gw; it < nit; it += F.NGW) transpose_item(J, it, scr, F.lane); }
    __syncthreads();
    LAS float* sm = (LAS float*)(F.lds);
    for (int it = blockIdx.x; it < 512; it += F.G) {
        const int kind = it >> 8, r = it & 255, e = r >> 7, h = (r >> 5) & 3, c8 = r & 31;
        __syncthreads();
        if (kind == 0) {
            for (int i = F.tid; i < 1024; i += 512) sm[i] = IN_F(15)[((size_t)((e * 4 + h) * 256 + c8 * 8 + (i >> 7))) * 128 + (i & 127)];
            __syncthreads();
            if (F.tid < 384) { const int k = F.tid; const f32x4* a = (const f32x4*)(IN_F(13) + (size_t)(e * 384 + k) * 768 + h * 192); float acc[8] = {};
                for (int n4 = 0; n4 < 32; ++n4) { const f32x4 av = a[n4];
#pragma unroll
                    for (int c = 0; c < 8; ++c) { const f32x4 bv = *(const LAS f32x4*)(sm + c * 128 + n4 * 4); acc[c] += (av[0] * bv[0] + av[1] * bv[1]) + (av[2] * bv[2] + av[3] * bv[3]); } }
                const float gq = IN_F(12)[e * 384 + k] * QSCALE; bf16_t* dst = WSP(bf16_t, WS_WQ2) + ((size_t)e * NQ2 + h * 256 + c8 * 8) * 384 + k;
#pragma unroll
                for (int c = 0; c < 8; ++c) dst[(size_t)c * 384] = (bf16_t)(cvt_pk_bf16(acc[c] * gq, 0.f) & 0xffffu); }
        } else {
            for (int i = F.tid; i < 1024; i += 512) sm[i] = IN_F(16)[((size_t)((e * 4 + h) * 256 + c8 * 8 + (i >> 7))) * 128 + (i & 127)];
            __syncthreads();
            for (int n = F.tid; n < 1024; n += 512) { const float* wo = IN_F(17) + ((size_t)e * 1024 + 512 + h * 128) * 1024 + n; float acc[8] = {};
                for (int v = 0; v < 128; ++v) { const float x = wo[(size_t)v * 1024];
#pragma unroll
                    for (int c = 0; c < 8; ++c) acc[c] += sm[c * 128 + v] * x; }
                u32x4 o; o.x = cvt_pk_bf16(acc[0], acc[1]); o.y = cvt_pk_bf16(acc[2], acc[3]); o.z = cvt_pk_bf16(acc[4], acc[5]); o.w = cvt_pk_bf16(acc[6], acc[7]);
                *(u32x4*)(WSP(bf16_t, WS_WOUTE) + ((size_t)e * 1024 + n) * KOE + 512 + h * 256 + c8 * 8) = o; }
        }
    }
    const int gt = blockIdx.x * 512 + F.tid, NT = F.G * 512;
    for (int idx = gt; idx < 2 * 256 * 384; idx += NT) {
        const int k = idx % 384, cc = (idx / 384) & 255, e = idx / (384 * 256), hh = cc >> 6, w6 = cc & 63, g = w6 >> 3, i = w6 & 7, sj = i < 4 ? 4 * g + i : 32 + 4 * g + (i - 4);
        const float v = IN_F(13)[(size_t)(e * 384 + k) * 768 + hh * 192 + 128 + sj] * IN_F(12)[e * 384 + k] * QSCALE;
        WSP(bf16_t, WS_WQ2)[((size_t)e * NQ2 + 1024 + cc) * 384 + k] = (bf16_t)(cvt_pk_bf16(v, 0.f) & 0xffffu); }
    for (int idx = gt; idx < 2 * 8 * 1024; idx += NT) {
        const int k = idx & 1023, jp = (idx >> 10) & 7, o = idx >> 13; const f32x4* ar = (const f32x4*)(IN_F(18) + (size_t)(o * 1024 + k) * 3088 + 3072);
        const f32x4 a0 = ar[0], a1 = ar[1], a2 = ar[2], a3 = ar[3]; const float gn = IN_F(6)[(2 * o + 1) * 1024 + k];
        const float av[16] = {a0[0], a0[1], a0[2], a0[3], a1[0], a1[1], a1[2], a1[3], a2[0], a2[1], a2[2], a2[3], a3[0], a3[1], a3[2], a3[3]};
        for (int j = jp * 64; j < jp * 64 + 64; ++j) { float s = 0.f;
#pragma unroll
            for (int r = 0; r < 16; ++r) s += av[r] * IN_F(19)[(size_t)(o * 16 + r) * 512 + j];
            WSP(bf16_t, WS_WINO)[((size_t)o * NO1 + 3072 + j) * 1024 + k] = (bf16_t)(cvt_pk_bf16(s * gn, 0.f) & 0xffffu); } }
    for (int idx = gt; idx < 2 * 64 * 128; idx += NT) {
        const int e = idx >> 13, r = idx & 8191; *(u32x4*)(WSP(bf16_t, WS_WINE) + ((size_t)e * NE1 + 2752) * 1024 + (size_t)r * 8) = (u32x4){0u, 0u, 0u, 0u}; }
    for (int idx = gt; idx < 512; idx += NT) {
        const float a = IN_F(10)[idx], b = IN_F(10)[512 + idx], mx = fmaxf(a, b), ea = __expf(a - mx), eb = __expf(b - mx);
        WSP(float, WS_LBS)[idx] = 0.f; WSP(float, WS_LBS)[512 + idx] = eb / (ea + eb); }
    for (int idx = gt; idx < 2056 * 32; idx += NT) {
        const int j = idx & 31, pi = idx >> 5; const double pos = (double)(pi < SEQ ? pi : PAST + (pi - SEQ));
        const double inv = exp2(-(double)j * (13.287712379549449 / 32.0)), ang = pos * inv, n = rint(ang * 0.15915494309189535), r = ang - n * 6.283185307179586;
        WSP(float, WS_ROPE)[(size_t)pi * 64 + j] = cosf((float)r); WSP(float, WS_ROPE)[(size_t)pi * 64 + 32 + j] = sinf((float)r); }
    for (int m = F.gw; m < NTOK; m += F.NGW) {
        const float* xr = m < NP ? IN_F(0) + (size_t)m * D : IN_F(1) + (size_t)(m - NP) * D; float s = 0.f;
#pragma unroll
        for (int j = 0; j < 4; ++j) { const f32x4 v = *(const f32x4*)(xr + j * 256 + F.lane * 4); s += (v[0] * v[0] + v[1] * v[1]) + (v[2] * v[2] + v[3] * v[3]);
            u32x2 w; w.x = cvt_pk_bf16(v[0], v[1]); w.y = cvt_pk_bf16(v[2], v[3]); *(u32x2*)(WSP(bf16_t, WS_XB) + (size_t)m * D + j * 256 + F.lane * 4) = w; }
        s = wave_sum(s);
        if (F.lane < 16) WSP(float, WS_SSQ)[(size_t)m * 16 + F.lane] = F.lane == 0 ? s : 0.f;
    }
}

__device__ __forceinline__ void finalize_rows(Frame& F, const Args& args, int e) {
    const float* CKV = WSP(float, WS_CKV); const float* KR = WSP(float, WS_KR); bf16_t* KVL = WSP(bf16_t, WS_KVL); const float* rope = WSP(float, WS_ROPE);
    int lane_ = F.lane; asm volatile("" : "+v"(lane_));
    const f32x4 w4 = *(const f32x4*)(IN_F(14) + e * 256 + lane_ * 4);
    for (int r = F.gw; r < NTOK; r += F.NGW) {
        const f32x4 v = *(const f32x4*)(CKV + (size_t)r * 256 + lane_ * 4);
        const float ss = wave_sum((v[0] * v[0] + v[1] * v[1]) + (v[2] * v[2] + v[3] * v[3])), rs = rsqrtf(ss * (1.f / 256.f) + EPS);
        const f32x4 o = v * rs * w4;
        float* od = r < NP ? (args.out + OUT_MRP) + ((size_t)e * NP + r) * LAT : (args.out + OUT_MRS) + ((size_t)e * NS + (r - NP)) * LAT;
        *(f32x4*)(od + lane_ * 4) = o;
        u32x2 w; w.x = cvt_pk_bf16(o[0], o[1]); w.y = cvt_pk_bf16(o[2], o[3]); *(u32x2*)(KVL + (size_t)r * LAT + lane_ * 4) = w;
        if (lane_ < 32) { const float x1 = KR[(size_t)r * 64 + lane_], x2 = KR[(size_t)r * 64 + 32 + lane_]; const float* rp = rope + (size_t)rope_idx(r) * 64;
            const float c = rp[lane_], sn = rp[32 + lane_], a = x1 * c - x2 * sn, b = x1 * sn + x2 * c;
            od[256 + lane_] = a; od[288 + lane_] = b;
            KVL[(size_t)r * LAT + 256 + lane_] = (bf16_t)(cvt_pk_bf16(a, 0.f) & 0xffffu); KVL[(size_t)r * LAT + 288 + lane_] = (bf16_t)(cvt_pk_bf16(b, 0.f) & 0xffffu); }
    }
}

constexpr int KP = 656, KT_BYTES = 64 * KP;
#define NEG_INF (-__builtin_inff())
__device__ __forceinline__ s16x4 tr_read(const LAS unsigned char* p) { return __builtin_amdgcn_ds_read_tr16_b64_v4i16((LAS s16x4*)p); }
__device__ __forceinline__ bf16x8 pack_frag(const f32x4 a, const f32x4 b) { u32x4 w; w.x = cvt_pk_bf16(a[0], a[1]); w.y = cvt_pk_bf16(a[2], a[3]); w.z = cvt_pk_bf16(b[0], b[1]); w.w = cvt_pk_bf16(b[2], b[3]); return __builtin_bit_cast(bf16x8, w); }
__device__ __forceinline__ bf16x8 join_frag(const s16x4 a, const s16x4 b) { return (bf16x8){a[0], a[1], a[2], a[3], b[0], b[1], b[2], b[3]}; }
template <int NKB, int NCB, bool MASK>
__device__ __forceinline__ void attn_tile(const LAS unsigned char* kt, int key0, int cbase, const bf16x8 (&qf)[10], f32x4 (&O)[NCB], float& m, float& l, int lane, int keyabs0, int limit) {
    const int fr = lane & 15, g = lane >> 4;
    f32x4 S[NKB];
#pragma unroll
    for (int kb = 0; kb < NKB; ++kb) { S[kb] = (f32x4){0.f, 0.f, 0.f, 0.f};
        const LAS unsigned char* kr = kt + (key0 + kb * 16 + fr) * KP + g * 16;
#pragma unroll
        for (int ds = 0; ds < 10; ++ds) S[kb] = __builtin_amdgcn_mfma_f32_16x16x32_bf16(*(const LAS bf16x8*)(kr + ds * 64), qf[ds], S[kb], 0, 0, 0);
        asm volatile("" ::: "memory"); }
    if constexpr (MASK) {
#pragma unroll
        for (int kb = 0; kb < NKB; ++kb)
#pragma unroll
            for (int i = 0; i < 4; ++i) if (keyabs0 + key0 + kb * 16 + 4 * g + i > limit) S[kb][i] = NEG_INF;
    }
    float mx = NEG_INF;
#pragma unroll
    for (int kb = 0; kb < NKB; ++kb) mx = fmaxf(fmaxf(mx, fmaxf(S[kb][0], S[kb][1])), fmaxf(S[kb][2], S[kb][3]));
    mx = fmaxf(mx, __shfl_xor(mx, 16)); mx = fmaxf(mx, __shfl_xor(mx, 32));
    const float mn = fmaxf(m, mx), mu = (mn == NEG_INF) ? 0.f : mn, alpha = fexp2(m - mu);
    float ls = 0.f;
#pragma unroll
    for (int kb = 0; kb < NKB; ++kb)
#pragma unroll
        for (int i = 0; i < 4; ++i) { const float p = fexp2(S[kb][i] - mu); S[kb][i] = p; ls += p; }
    l = l * alpha + ls; m = mn;
#pragma unroll
    for (int cb = 0; cb < NCB; ++cb) O[cb] = O[cb] * alpha;
#pragma unroll
    for (int p2 = 0; p2 < NKB / 2; ++p2) {
        const bf16x8 pf = pack_frag(S[2 * p2], S[2 * p2 + 1]);
        const LAS unsigned char* vr = kt + (key0 + 32 * p2 + 4 * g + (fr >> 2)) * KP + (cbase + 4 * (fr & 3)) * 2;
#pragma unroll
        for (int cb = 0; cb < NCB; ++cb) { const bf16x8 a = join_frag(tr_read(vr + cb * 32), tr_read(vr + cb * 32 + 16 * KP)); O[cb] = __builtin_amdgcn_mfma_f32_16x16x32_bf16(a, pf, O[cb], 0, 0, 0);
            if ((cb & 3) == 3) asm volatile("" ::: "memory"); }
    }
}
__device__ __forceinline__ void attn_prompt_unit(Frame& F, int b, int qb) {
    const bf16_t* KVL = WSP(bf16_t, WS_KVL); const bf16_t* QL = WSP(bf16_t, WS_QL); bf16_t* OA = WSP(bf16_t, WS_OA);
    int tid_ = F.tid; asm volatile("" : "+v"(tid_));
    const int w = F.wave, lane = tid_ & 63, fr = lane & 15, g = lane >> 4, h = w & 3, half = w >> 2;
    const int pos = 32 * qb + 16 * half + fr, row = b * SEQ + pos;
    bf16x8 qf[10];
#pragma unroll
    for (int ds = 0; ds < 10; ++ds) qf[ds] = *(const bf16x8*)(QL + (size_t)row * QL_LD + h * LAT + ds * 32 + g * 8);
    f32x4 O[16];
#pragma unroll
    for (int cb = 0; cb < 16; ++cb) O[cb] = (f32x4){0.f, 0.f, 0.f, 0.f};
    float m = NEG_INF, l = 0.f;
    const int ntiles = (qb >> 1) + 1;
    const u32x4* src = (const u32x4*)(KVL + (size_t)b * SEQ * LAT);
    u32x4 st[5];
#define PA_LOAD(kt) do { _Pragma("unroll") for (int i = 0; i < 5; ++i) st[i] = src[(size_t)(kt) * 2560 + tid_ + 512 * i]; } while (0)
#define PA_WRITE(buf) do { _Pragma("unroll") for (int i = 0; i < 5; ++i) { const int ch = tid_ + 512 * i, key = ch / 40, c16 = ch % 40; *(LAS u32x4*)(F.lds + (buf) * KT_BYTES + key * KP + c16 * 16) = st[i]; } } while (0)
    PA_LOAD(0); PA_WRITE(0); __syncthreads();
    for (int kt = 0; kt < ntiles; ++kt) {
        if (kt + 1 < ntiles) PA_LOAD(kt + 1);
        const LAS unsigned char* kb = F.lds + (kt & 1) * KT_BYTES;
        attn_tile<4, 16, true>(kb, 0, 0, qf, O, m, l, lane, 64 * kt, pos);
        if (kt + 1 < ntiles) PA_WRITE((kt + 1) & 1);
        __syncthreads();
    }
#undef PA_LOAD
#undef PA_WRITE
    l += __shfl_xor(l, 16); l += __shfl_xor(l, 32);
    const float inv = 1.f / l;
    bf16_t* dst = OA + (size_t)row * KOE + 512 + h * 256 + 4 * g;
#pragma unroll
    for (int cb = 0; cb < 16; ++cb) { const f32x4 o = O[cb] * inv; u32x2 wv; wv.x = cvt_pk_bf16(o[0], o[1]); wv.y = cvt_pk_bf16(o[2], o[3]); *(u32x2*)(dst + cb * 16) = wv; }
}
__device__ __forceinline__ void attn_decode_unit(Frame& F, const Args& args, int e, int bd, int sp) {
    const bf16_t* KVL = WSP(bf16_t, WS_KVL); const bf16_t* QL = WSP(bf16_t, WS_QL); float* PO = WSP(float, WS_PO); float* PML = WSP(float, WS_PML);
    const float* cache = IN_F(2) + (size_t)e * NPHYS * PAGE * LAT;
    int tid_ = F.tid; asm volatile("" : "+v"(tid_));
    const int w = F.wave, lane = tid_ & 63, fr = lane & 15, g = lane >> 4, rg = w & 1, kh = (w >> 1) & 1, ch = w >> 2;
    const int rr = 16 * rg + fr, td = rr >> 2, h = rr & 3, row = NP + bd * DSEQ + td;
    bf16x8 qf[10];
#pragma unroll
    for (int ds = 0; ds < 10; ++ds) qf[ds] = *(const bf16x8*)(QL + (size_t)row * QL_LD + h * LAT + ds * 32 + g * 8);
    f32x4 O[8];
#pragma unroll
    for (int cb = 0; cb < 8; ++cb) O[cb] = (f32x4){0.f, 0.f, 0.f, 0.f};
    float m = NEG_INF, l = 0.f;
    constexpr int PPS = NPAGES / NSPLIT, NT = 2 * PPS;
    f32x4 st[10];
#define DA_LOAD(t) do { const int pg = ((const int*)args.in[5])[bd * NPAGES + sp * PPS + ((t) >> 1)]; const f32x4* bp = (const f32x4*)(cache + ((size_t)pg * PAGE + ((t) & 1) * 64) * LAT); \
        _Pragma("unroll") for (int i = 0; i < 10; ++i) st[i] = __builtin_nontemporal_load(bp + tid_ + 512 * i); } while (0)
#define DA_WRITE(buf) do { _Pragma("unroll") for (int i = 0; i < 10; ++i) { const int idx = tid_ + 512 * i, key = idx / 80, d4 = idx % 80; u32x2 wv; wv.x = cvt_pk_bf16(st[i][0], st[i][1]); wv.y = cvt_pk_bf16(st[i][2], st[i][3]); \
        *(LAS u32x2*)(F.lds + (buf) * KT_BYTES + key * KP + d4 * 8) = wv; } } while (0)
    DA_LOAD(0); DA_WRITE(0); __syncthreads();
    for (int t = 0; t < NT; ++t) {
        if (t + 1 < NT) DA_LOAD(t + 1);
        attn_tile<2, 8, false>(F.lds + (t & 1) * KT_BYTES, 32 * kh, 128 * ch, qf, O, m, l, lane, 0, 0);
        if (t + 1 < NT) DA_WRITE((t + 1) & 1);
        __syncthreads();
    }
#undef DA_LOAD
#undef DA_WRITE
    if (sp == NSPLIT - 1) {
        for (int i = tid_; i < 320 + 24 * 41; i += 512) {
            if (i < 320) { const int key = i / 40, c16 = i % 40; *(LAS u32x4*)(F.lds + key * KP + c16 * 16) = *(const u32x4*)(KVL + (size_t)(NP + bd * DSEQ + key) * LAT + c16 * 8); }
            else { const int j = i - 320; *(LAS u32x4*)(F.lds + 8 * KP + j * 16) = (u32x4){0u, 0u, 0u, 0u}; }
        }
        __syncthreads();
        if (kh == 0) attn_tile<2, 8, true>(F.lds, 0, 128 * ch, qf, O, m, l, lane, PAST, PAST + td);
        __syncthreads();
    }
    l += __shfl_xor(l, 16); l += __shfl_xor(l, 32);
    const int se = sp * 2 + kh; const size_t pr = ((size_t)(bd * NSE + se) * 32 + rr);
#pragma unroll
    for (int cb = 0; cb < 8; ++cb) *(f32x4*)(PO + pr * 256 + 128 * ch + 16 * cb + 4 * g) = O[cb];
    if (ch == 0 && g == 0) { PML[pr * 2] = m; PML[pr * 2 + 1] = l; }
}
__device__ __forceinline__ void attn_decode_combine(Frame& F) {
    const float* PO = WSP(float, WS_PO); const float* PML = WSP(float, WS_PML); bf16_t* OA = WSP(bf16_t, WS_OA);
    for (int r = F.gw; r < 32 * 32; r += F.NGW) {
        const int bd = r >> 5, rr = r & 31, td = rr >> 2, h = rr & 3;
        float mm = NEG_INF, ll = 0.f;
        if (F.lane < NSE) { const size_t pr = ((size_t)(bd * NSE + F.lane) * 32 + rr); mm = PML[pr * 2]; ll = PML[pr * 2 + 1]; }
        float M = mm;
#pragma unroll
        for (int o = 1; o < 64; o <<= 1) M = fmaxf(M, __shfl_xor(M, o));
        const float wgt = (F.lane < NSE) ? fexp2(mm - M) : 0.f; const float L = wave_sum(wgt * ll);
        f32x4 acc = (f32x4){0.f, 0.f, 0.f, 0.f};
        for (int se = 0; se < NSE; ++se) { const float ws_ = __shfl(wgt, se); acc = acc + *(const f32x4*)(PO + ((size_t)(bd * NSE + se) * 32 + rr) * 256 + F.lane * 4) * ws_; }
        const float inv = 1.f / L; u32x2 wv; wv.x = cvt_pk_bf16(acc[0] * inv, acc[1] * inv); wv.y = cvt_pk_bf16(acc[2] * inv, acc[3] * inv);
        *(u32x2*)(OA + (size_t)(NP + bd * DSEQ + td) * KOE + 512 + h * 256 + F.lane * 4) = wv;
    }
}

template <int NV, bool HAS_S0>
__device__ __forceinline__ void scan_unit(Frame& F, const float* nw, const float* s0, float* sout, int ldo, int coff, int row0, int T, int h) {
    constexpr int VD = 128 * NV, LDV = 4 * VD, PV = 2 * VD + 16, PQ = 272, PK = 144;
    constexpr int O_QT0 = 0, O_QH = 64 * PQ, O_KH = 2 * 64 * PQ, O_KLT = 3 * 64 * PQ, O_VT = O_KLT + 128 * PK, O_DEC = O_VT + 64 * PV, O_XS = O_DEC + 512, O_NRM = O_XS + 8192;
    static_assert(O_NRM + 2048 <= RING_BYTES, "scan LDS");
    const bf16_t* Qh = WSP(bf16_t, WS_QH); const bf16_t* KK = WSP(bf16_t, WS_KK); const float* LOGF = WSP(float, WS_LOGF); const bf16_t* V = WSP(bf16_t, WS_V); const bf16_t* G = WSP(bf16_t, WS_G); bf16_t* OA = WSP(bf16_t, WS_OA);
    LAS unsigned char* lds = F.lds;
    int tid = F.tid; asm volatile("" : "+v"(tid));
    const int w = F.wave, lane = tid & 63, fr = lane & 15, g = lane >> 4;
    f32x4 S[8][NV];
#pragma unroll
    for (int kb = 0; kb < 8; ++kb)
#pragma unroll
        for (int nv = 0; nv < NV; ++nv) {
            if constexpr (HAS_S0) { const float* sp = s0 + (size_t)(16 * kb + 4 * g) * VD + (w * NV + nv) * 16 + fr;
                const float a0 = sp[0], a1 = sp[VD], a2 = sp[2 * VD], a3 = sp[3 * VD]; S[kb][nv] = (f32x4){a0, a1, a2, a3}; }
            else S[kb][nv] = (f32x4){0.f, 0.f, 0.f, 0.f};
        }
    for (int c0 = 0; c0 < T; c0 += 64) {
        {
            const int k4 = (tid & 31) * 4, ts = tid >> 5, t0 = 4 * ts;
            const size_t rbase = (size_t)(row0 + c0 + t0) * 512 + h * 128 + k4;
            f32x4 bl[4]; u32x2 qw[4], kw[4]; f32x4 run = (f32x4){0.f, 0.f, 0.f, 0.f};
#pragma unroll
            for (int i = 0; i < 4; ++i) { const bool ok = c0 + t0 + i < T; f32x4 lf = (f32x4){0.f, 0.f, 0.f, 0.f}; qw[i] = (u32x2){0u, 0u}; kw[i] = (u32x2){0u, 0u};
                if (ok) { lf = *(const f32x4*)(LOGF + rbase + (size_t)i * 512); qw[i] = *(const u32x2*)(Qh + rbase + (size_t)i * 512); kw[i] = *(const u32x2*)(KK + rbase + (size_t)i * 512); }
                run = run + lf; bl[i] = run; }
            *(LAS f32x4*)(lds + O_XS + (ts * 128 + k4) * 4) = run;
#pragma unroll
            for (int j = 0; j < 2 * NV; ++j) { const int chn = tid + 512 * j, s = chn / (VD / 8), cc = chn % (VD / 8); u32x4 val = (u32x4){0u, 0u, 0u, 0u};
                if (c0 + s < T) val = *(const u32x4*)(V + (size_t)(row0 + c0 + s) * LDV + h * VD + cc * 8);
                *(LAS u32x4*)(lds + O_VT + s * PV + cc * 16) = val; }
            __syncthreads();
            f32x4 pre = (f32x4){0.f, 0.f, 0.f, 0.f}, b31 = pre, bL = pre;
#pragma unroll
            for (int s = 0; s < 16; ++s) { const f32x4 x = *(const LAS f32x4*)(lds + O_XS + (s * 128 + k4) * 4); if (s < ts) pre = pre + x; if (s < 8) b31 = b31 + x; bL = bL + x; }
            f32x4 klv[4];
#pragma unroll
            for (int i = 0; i < 4; ++i) {
                const f32x4 b = pre + bl[i]; f32x4 q, k, e0, em, ek, eL;
                q[0] = bflo(qw[i].x); q[1] = bfhi(qw[i].x); q[2] = bflo(qw[i].y); q[3] = bfhi(qw[i].y);
                k[0] = bflo(kw[i].x); k[1] = bfhi(kw[i].x); k[2] = bflo(kw[i].y); k[3] = bfhi(kw[i].y);
#pragma unroll
                for (int c = 0; c < 4; ++c) { e0[c] = fexp(b[c]); em[c] = fexp(b[c] - b31[c]); ek[c] = fexp(b31[c] - b[c]); eL[c] = fexp(bL[c] - b[c]); }
                const f32x4 a0 = q * e0, a1 = q * em, a2 = k * ek; klv[i] = k * eL;
                const int ro = (t0 + i) * PQ + k4 * 2;
                *(LAS u32x2*)(lds + O_QT0 + ro) = (u32x2){cvt_pk_bf16(a0[0], a0[1]), cvt_pk_bf16(a0[2], a0[3])};
                *(LAS u32x2*)(lds + O_QH + ro) = (u32x2){cvt_pk_bf16(a1[0], a1[1]), cvt_pk_bf16(a1[2], a1[3])};
                *(LAS u32x2*)(lds + O_KH + ro) = (u32x2){cvt_pk_bf16(a2[0], a2[1]), cvt_pk_bf16(a2[2], a2[3])};
            }
#pragma unroll
            for (int c = 0; c < 4; ++c) *(LAS u32x2*)(lds + O_KLT + (k4 + c) * PK + t0 * 2) = (u32x2){cvt_pk_bf16(klv[0][c], klv[1][c]), cvt_pk_bf16(klv[2][c], klv[3][c])};
            if (ts == 0) { f32x4 d; d[0] = fexp(bL[0]); d[1] = fexp(bL[1]); d[2] = fexp(bL[2]); d[3] = fexp(bL[3]); *(LAS f32x4*)(lds + O_DEC + k4 * 4) = d; }
            __syncthreads();
        }
        bf16x8 sB[4][NV];
#pragma unroll
        for (int ks = 0; ks < 4; ++ks)
#pragma unroll
            for (int nv = 0; nv < NV; ++nv) sB[ks][nv] = pack_frag(S[2 * ks][nv], S[2 * ks + 1][nv]);
        f32x4 Oo[4][NV];
        {
            bf16x8 vP[2][NV];
#pragma unroll
            for (int p = 0; p < 2; ++p)
#pragma unroll
                for (int nv = 0; nv < NV; ++nv) { const LAS unsigned char* a1 = lds + O_VT + (32 * p + 4 * g + (fr >> 2)) * PV + ((w * NV + nv) * 16 + 4 * (fr & 3)) * 2; vP[p][nv] = join_frag(tr_read(a1), tr_read(a1 + 16 * PV)); }
#pragma unroll
            for (int tb = 0; tb < 4; ++tb) {
                f32x4 X[4];
                {
                    bf16x8 bq[4];
#pragma unroll
                    for (int ks = 0; ks < 4; ++ks) bq[ks] = *(const LAS bf16x8*)(lds + O_QH + (16 * tb + fr) * PQ + ks * 64 + g * 16);
#pragma unroll
                    for (int sb = 0; sb < 4; ++sb) { X[sb] = (f32x4){0.f, 0.f, 0.f, 0.f};
                        if (sb <= tb) {
#pragma unroll
                            for (int ks = 0; ks < 4; ++ks) X[sb] = __builtin_amdgcn_mfma_f32_16x16x32_bf16(*(const LAS bf16x8*)(lds + O_KH + (16 * sb + fr) * PQ + ks * 64 + g * 16), bq[ks], X[sb], 0, 0, 0);
                            if (sb == tb) {
#pragma unroll
                                for (int i = 0; i < 4; ++i) if (4 * g + i > fr) X[sb][i] = 0.f; } } }
                }
#pragma unroll
                for (int nv = 0; nv < NV; ++nv) Oo[tb][nv] = (f32x4){0.f, 0.f, 0.f, 0.f};
#pragma unroll
                for (int p = 0; p < 2; ++p) if (p <= (tb >> 1)) {
                    const bf16x8 pf = pack_frag(X[2 * p], X[2 * p + 1]);
#pragma unroll
                    for (int nv = 0; nv < NV; ++nv) Oo[tb][nv] = __builtin_amdgcn_mfma_f32_16x16x32_bf16(pf, vP[p][nv], Oo[tb][nv], 0, 0, 0);
                }
#pragma unroll
                for (int ks = 0; ks < 4; ++ks) {
                    const LAS unsigned char* qa = lds + O_QT0 + (16 * tb + fr) * PQ + (32 * ks + 4 * g) * 2;
                    const u32x2 q0 = *(const LAS u32x2*)qa, q1 = *(const LAS u32x2*)(qa + 32);
                    const bf16x8 aq = __builtin_bit_cast(bf16x8, (u32x4){q0.x, q0.y, q1.x, q1.y});
#pragma unroll
                    for (int nv = 0; nv < NV; ++nv) Oo[tb][nv] = __builtin_amdgcn_mfma_f32_16x16x32_bf16(aq, sB[ks][nv], Oo[tb][nv], 0, 0, 0);
                }
                asm volatile("" ::: "memory");
            }
        }
        bf16x8 vN[2][NV];
#pragma unroll
        for (int p = 0; p < 2; ++p)
#pragma unroll
            for (int nv = 0; nv < NV; ++nv) { const LAS unsigned char* a2 = lds + O_VT + (32 * p + 8 * g + (fr >> 2)) * PV + ((w * NV + nv) * 16 + 4 * (fr & 3)) * 2; vN[p][nv] = join_frag(tr_read(a2), tr_read(a2 + 4 * PV)); }
#pragma unroll
        for (int kb = 0; kb < 8; ++kb) {
            const f32x4 d4 = *(const LAS f32x4*)(lds + O_DEC + (16 * kb + 4 * g) * 4);
#pragma unroll
            for (int nv = 0; nv < NV; ++nv) S[kb][nv] = S[kb][nv] * d4;
#pragma unroll
            for (int p = 0; p < 2; ++p) { const bf16x8 a = *(const LAS bf16x8*)(lds + O_KLT + (16 * kb + fr) * PK + p * 64 + g * 16);
#pragma unroll
                for (int nv = 0; nv < NV; ++nv) S[kb][nv] = __builtin_amdgcn_mfma_f32_16x16x32_bf16(a, vN[p][nv], S[kb][nv], 0, 0, 0); }
        }
#pragma unroll
        for (int tb = 0; tb < 4; ++tb)
#pragma unroll
            for (int i = 0; i < 4; ++i) { float ss = 0.f;
#pragma unroll
                for (int nv = 0; nv < NV; ++nv) ss += Oo[tb][nv][i] * Oo[tb][nv][i];
                ss += __shfl_xor(ss, 1); ss += __shfl_xor(ss, 2); ss += __shfl_xor(ss, 4); ss += __shfl_xor(ss, 8);
                if (fr == 0) ((LAS float*)(lds + O_NRM))[(16 * tb + 4 * g + i) * 8 + w] = ss; }
        __syncthreads();
#pragma unroll
        for (int tb = 0; tb < 4; ++tb)
#pragma unroll
            for (int i = 0; i < 4; ++i) { const int tl = 16 * tb + 4 * g + i; const LAS f32x4* np = (const LAS f32x4*)(lds + O_NRM + tl * 32); const f32x4 n0 = np[0], n1 = np[1];
                const float rs = rsqrtf(((n0[0] + n0[1]) + (n0[2] + n0[3]) + (n1[0] + n1[1]) + (n1[2] + n1[3])) * (1.f / VD) + EPS);
                if (c0 + tl < T) { int ri = row0 + c0 + tl; asm volatile("" : "+v"(ri)); const size_t r = (size_t)ri;
#pragma unroll
                    for (int nv = 0; nv < NV; ++nv) { const int v = (w * NV + nv) * 16 + fr; const float gt = bf2f(G[r * LDV + h * VD + v]);
                        OA[r * ldo + coff + h * VD + v] = (bf16_t)(cvt_pk_bf16(Oo[tb][nv][i] * rs * nw[v] * gt, 0.f) & 0xffffu); } } }
    }
#pragma unroll
    for (int kb = 0; kb < 8; ++kb) {
        float* so = sout + (size_t)(16 * kb + 4 * g) * VD + w * NV * 16 + fr; asm volatile("" : "+v"(so));
#pragma unroll
        for (int nv = 0; nv < NV; ++nv)
#pragma unroll
            for (int i = 0; i < 4; ++i) so[i * VD + nv * 16] = S[kb][nv][i];
    }
    __syncthreads();
}
constexpr int N_PHASES = 30;
__device__ __forceinline__ int queue_claim(Frame& F, unsigned* head) {
    __syncthreads();
    if (F.tid == 0) F.MISC[16] = __hip_atomic_fetch_add(head, 1u, __ATOMIC_RELAXED, __HIP_MEMORY_SCOPE_AGENT);
    __syncthreads();
    return (int)F.MISC[16];
}
__global__ void __launch_bounds__(512, 2) mega_fwd(Args args) {
    extern __shared__ __attribute__((aligned(16))) unsigned char lds_raw[];
    Frame F;
    F.lds = (LAS unsigned char*)lds_raw; F.MISC = (volatile LAS unsigned*)(F.lds + MISC_OFF);
    F.tid = threadIdx.x; F.lane = F.tid & 63; F.wave = __builtin_amdgcn_readfirstlane(F.tid >> 6); F.G = gridDim.x; F.gw = blockIdx.x * 8 + F.wave; F.NGW = F.G * 8;
    F.ws = args.ws; F.ctl = (unsigned*)(args.ws + WS_CTL);
    for (int u = F.tid; u < (LDS_BYTES - MISC_OFF) / 4; u += 512) ((LAS unsigned*)(F.lds + MISC_OFF))[u] = 0u;
    __syncthreads();
    const int lo = args.ph_lo, hi = args.ph_hi;
    XcdBarrier bar; bar.bar = F.ctl + CW_BAR; bar.x = 0; bar.st = nullptr;
    if (hi - lo > 1) bar = xcd_barrier_post(F.ctl + CW_BAR, F.MISC + 8);
#ifdef MK_ONLY
#define INC(k, c) ((c) == MK_ONLY && lo <= (k) && (k) < hi)
#else
#define INC(k, c) (lo <= (k) && (k) < hi)
#endif
#define SEAM(k) do { if (hi > (k) + 1) xcd_barrier(bar); } while (0)
    const RowScale rsX{WSP(float, WS_SSQ), 16, 4, 1.f / 1024.f};
    const RowScale rsQ{WSP(float, WS_SSQCQ), 16, 3, 1.f / 384.f};
    const RowScale rsNone{nullptr, 0, 0, 0.f};

    if (INC(0, 0)) { asm volatile("" : "+s"(F.ws)); p0_prologue(F, args); SEAM(0); }

    for (int l = 0; l < 4; ++l) {
        const int pb = 1 + 7 * l, eo = l >> 1;
        const float* resP = l == 0 ? IN_F(0) : WSP(float, WS_X); const float* resS = l == 0 ? IN_F(1) : WSP(float, WS_X) + (size_t)NP * D;
        if ((l & 1) == 0) {
            if (INC(pb, 1)) { asm volatile("" : "+s"(F.ws));
                Gemm g{WSP(bf16_t, WS_XB), WSP(bf16_t, WS_WINE) + (size_t)eo * NE1 * 1024, 1024, 1024, NTOK, NE1, 1024}; StaticOrder S; S.init(NTOK, NE1, F.G, (int)blockIdx.x);
                EpiInEven E{WSP(bf16_t, WS_QH), WSP(bf16_t, WS_KK), WSP(float, WS_LOGF), WSP(bf16_t, WS_V), WSP(bf16_t, WS_G), WSP(float, WS_CKV), WSP(float, WS_KR), WSP(bf16_t, WS_CQ), WSP(float, WS_SSQCQ), WSP(float, WS_LBS) + eo * 512};
                gemm_phase<EpiInEven, true>(F.lds, g, S, E, rsX);
                SEAM(pb);
            }
            if (INC(pb + 1, 2)) { asm volatile("" : "+s"(F.ws));
#ifndef MK_NOFIN
                finalize_rows(F, args, eo);
#endif
                Gemm g{WSP(bf16_t, WS_CQ), WSP(bf16_t, WS_WQ2) + (size_t)eo * NQ2 * 384, 384, 384, NTOK, NQ2, 384}; StaticOrder S; S.init(NTOK, NQ2, F.G, (int)blockIdx.x);
                EpiQ2 E{WSP(bf16_t, WS_QL), WSP(float, WS_ROPE)};
                gemm_phase<EpiQ2, true>(F.lds, g, S, E, rsQ);
                SEAM(pb + 1);
            }
            if (INC(pb + 2, 3)) { asm volatile("" : "+s"(F.ws));
                unsigned* head = F.ctl + CW_QUEUE + 64 * l;
                for (;;) {
                    const int u = queue_claim(F, head);
                    if (u >= 32 + 1024 + 128) break;
#ifndef MK_SUB
#define MK_SUB 7
#endif
                    if (u < 32) { if (MK_SUB & 1) { const int b = u >> 2, h = u & 3; scan_unit<1, false>(F, IN_F(11) + eo * 128, nullptr, (args.out + OUT_HSP) + ((size_t)(eo * 8 + b) * 4 + h) * 128 * 128, KOE, 0, b * SEQ, SEQ, h); } }
                    else if (u < 32 + 1024) { const int j = u - 32, i = j >> 1;
                        if ((j & 1) == 0) { if (MK_SUB & 2) attn_decode_unit(F, args, eo, i & 31, i >> 5); }
                        else { if (MK_SUB & 4) attn_prompt_unit(F, i & 7, 63 - (i >> 3)); } }
                    else { if (MK_SUB & 1) { const int j = u - 1056, bd = j >> 2, h = j & 3;
                        scan_unit<1, true>(F, IN_F(11) + eo * 128, IN_F(3) + ((size_t)(eo * 32 + bd) * 4 + h) * 128 * 128, (args.out + OUT_HSS) + ((size_t)(eo * 32 + bd) * 4 + h) * 128 * 128, KOE, 0, NP + bd * DSEQ, DSEQ, h); } }
                }
                SEAM(pb + 2);
            }
            if (INC(pb + 3, 4)) { asm volatile("" : "+s"(F.ws)); attn_decode_combine(F); SEAM(pb + 3); }
            if (INC(pb + 4, 5)) { asm volatile("" : "+s"(F.ws));
                Gemm g{WSP(bf16_t, WS_OA), WSP(bf16_t, WS_WOUTE) + (size_t)eo * 1024 * KOE, KOE, KOE, NTOK, 1024, KOE}; StaticOrder S; S.init(NTOK, 1024, F.G, (int)blockIdx.x);
                EpiOutRes E{resP, resS, WSP(float, WS_X), WSP(bf16_t, WS_XB), WSP(float, WS_SSQ)};
                gemm_phase<EpiOutRes, false>(F.lds, g, S, E, rsNone);
                SEAM(pb + 4);
            }
        } else {
            if (INC(pb, 6)) { asm volatile("" : "+s"(F.ws));
                Gemm g{WSP(bf16_t, WS_XB), WSP(bf16_t, WS_WINO) + (size_t)eo * NO1 * 1024, 1024, 1024, NTOK, NO1, 1024}; StaticOrder S; S.init(NTOK, NO1, F.G, (int)blockIdx.x);
                EpiInOdd E{WSP(bf16_t, WS_QH), WSP(bf16_t, WS_KK), WSP(bf16_t, WS_V), WSP(bf16_t, WS_G), WSP(float, WS_LOGF), IN_F(20) + eo * 512};
                gemm_phase<EpiInOdd, true>(F.lds, g, S, E, rsX);
                SEAM(pb);
            }
            if (INC(pb + 2, 7)) { asm volatile("" : "+s"(F.ws));
                unsigned* head = F.ctl + CW_QUEUE + 64 * l;
                for (;;) {
                    const int u = queue_claim(F, head);
                    if (u >= 32 + 128) break;
                    if (u < 32) { const int b = u >> 2, h = u & 3; scan_unit<2, false>(F, IN_F(21) + eo * 256, nullptr, (args.out + OUT_GSP) + ((size_t)(eo * 8 + b) * 4 + h) * 128 * 256, 1024, 0, b * SEQ, SEQ, h); }
                    else { const int j = u - 32, bd = j >> 2, h = j & 3;
                        scan_unit<2, true>(F, IN_F(21) + eo * 256, IN_F(4) + ((size_t)(eo * 32 + bd) * 4 + h) * 128 * 256, (args.out + OUT_GSS) + ((size_t)(eo * 32 + bd) * 4 + h) * 128 * 256, 1024, 0, NP + bd * DSEQ, DSEQ, h); }
                }
                SEAM(pb + 2);
            }
            if (INC(pb + 4, 8)) { asm volatile("" : "+s"(F.ws));
                Gemm g{WSP(bf16_t, WS_OA), WSP(bf16_t, WS_WOUTO) + (size_t)eo * 1024 * 1024, 1024, 1024, NTOK, 1024, 1024}; StaticOrder S; S.init(NTOK, 1024, F.G, (int)blockIdx.x);
                EpiOutRes E{resP, resS, WSP(float, WS_X), WSP(bf16_t, WS_XB), WSP(float, WS_SSQ)};
                gemm_phase<EpiOutRes, false>(F.lds, g, S, E, rsNone);
                SEAM(pb + 4);
            }
        }
        if (INC(pb + 5, 9)) { asm volatile("" : "+s"(F.ws));
            Gemm g{WSP(bf16_t, WS_XB), WSP(bf16_t, WS_WUP) + (size_t)l * FF * 1024, 1024, 1024, NTOK, FF, 1024}; StaticOrder S; S.init(NTOK, FF, F.G, (int)blockIdx.x);
            EpiUp E{WSP(bf16_t, WS_FFB)};
            gemm_phase<EpiUp, true>(F.lds, g, S, E, rsX);
            SEAM(pb + 5);
        }
        if (INC(pb + 6, 10)) { asm volatile("" : "+s"(F.ws));
            Gemm g{WSP(bf16_t, WS_FFB), WSP(bf16_t, WS_WDOWN) + (size_t)l * 1024 * FF, FF, FF, NTOK, 1024, FF}; StaticOrder S; S.init(NTOK, 1024, F.G, (int)blockIdx.x);
            EpiOutRes E{WSP(float, WS_X), WSP(float, WS_X) + (size_t)NP * D, WSP(float, WS_X), WSP(bf16_t, WS_XB), WSP(float, WS_SSQ)};
            gemm_phase<EpiOutRes, false>(F.lds, g, S, E, rsNone);
            SEAM(pb + 6);
        }
    }
    if (INC(29, 11)) { asm volatile("" : "+s"(F.ws));
        const float* X = WSP(float, WS_X); const float* SSQ = WSP(float, WS_SSQ);
        for (int m = F.gw; m < NTOK; m += F.NGW) {
            const f32x4* sp = (const f32x4*)(SSQ + (size_t)m * 16); const f32x4 s0 = sp[0], s1 = sp[1], s2 = sp[2], s3 = sp[3];
            const float ss = ((s0[0] + s0[1]) + (s0[2] + s0[3])) + ((s1[0] + s1[1]) + (s1[2] + s1[3])) + ((s2[0] + s2[1]) + (s2[2] + s2[3])) + ((s3[0] + s3[1]) + (s3[2] + s3[3]));
            const float rs = rsqrtf(ss * (1.f / 1024.f) + EPS);
            float* od = m < NP ? (args.out + OUT_YP) + (size_t)m * D : (args.out + OUT_YS) + (size_t)(m - NP) * D;
#pragma unroll
            for (int j = 0; j < 4; ++j) { const int c = j * 256 + F.lane * 4; *(f32x4*)(od + c) = *(const f32x4*)(X + (size_t)m * D + c) * rs * *(const f32x4*)(IN_F(8) + c); }
        }
    }
#undef INC
#undef SEAM
}
#undef WSP
#undef IN_F
}

#ifndef MK_ONE_LAUNCH
#define MK_ONE_LAUNCH 0
#endif
static void mk_launch(void* const* d_in, void* d_out, void* d_ws, size_t ws_size, hipStream_t stream) {
    static int grid = 0;
    if (grid == 0) {
        int dev = 0, cus = 0, per_cu = 0;
        if (ws_size < mk::WS_END) { fprintf(stderr, "kernel_launch: workspace too small (%zu < %zu)\n", ws_size, (size_t)mk::WS_END); grid = -1; return; }
        if (hipGetDevice(&dev) != hipSuccess || hipDeviceGetAttribute(&cus, hipDeviceAttributeMultiprocessorCount, dev) != hipSuccess) { grid = -1; return; }
        if (hipFuncSetAttribute((const void*)mk::mega_fwd, hipFuncAttributeMaxDynamicSharedMemorySize, mk::LDS_BYTES) != hipSuccess) { fprintf(stderr, "kernel_launch: hipFuncSetAttribute failed\n"); grid = -1; return; }
        if (hipOccupancyMaxActiveBlocksPerMultiprocessor(&per_cu, (const void*)mk::mega_fwd, 512, mk::LDS_BYTES) != hipSuccess || per_cu < 1) { fprintf(stderr, "kernel_launch: occupancy query says %d blocks per CU\n", per_cu); }
        (void)hipGetLastError();
        grid = cus;
    }
    if (grid < 0) return;
    (void)hipMemsetAsync((char*)d_ws + mk::WS_CTL, 0, mk::CTL_BYTES, stream);
    mk::Args a{};
    for (int i = 0; i < 25; ++i) a.in[i] = d_in[i];
    a.out = (float*)d_out; a.ws = (unsigned char*)d_ws;
#if MK_ONE_LAUNCH
    a.ph_lo = 0; a.ph_hi = mk::N_PHASES;
    hipLaunchKernelGGL(mk::mega_fwd, dim3(grid), dim3(512), mk::LDS_BYTES, stream, a);
#else
    for (int p = 0; p < mk::N_PHASES; ++p) {
        if (p >= 1 && p < 29) { const int l = (p - 1) / 7, k = (p - 1) % 7; if ((l & 1) && (k == 1 || k == 3)) continue; }
        a.ph_lo = p; a.ph_hi = p + 1;
        hipLaunchKernelGGL(mk::mega_fwd, dim3(grid), dim3(512), mk::LDS_BYTES, stream, a);
    }
#endif
}

extern "C" void kernel_launch(void* const* d_in, const int* in_sizes, int n_in, void* d_out, int out_size, void* d_ws, size_t ws_size, hipStream_t stream) {
    if (n_in != 25) { fprintf(stderr, "kernel_launch: unexpected n_in %d\n", n_in); return; }
    mk_launch(d_in, d_out, d_ws, ws_size, stream);
}
```

```cpp
#include <hip/hip_runtime.h>
#include <cstdio>
#include <cstdint>
#define MK_ONE_LAUNCH 1
#ifndef MK_REPEAT
#define MK_REPEAT 0
#endif
namespace mk {
#define LAS __attribute__((address_space(3)))
typedef unsigned short bf16_t;
typedef short bf16x8 __attribute__((ext_vector_type(8)));
typedef short s16x4 __attribute__((ext_vector_type(4)));
typedef float f32x4 __attribute__((ext_vector_type(4)));
typedef unsigned u32x4 __attribute__((ext_vector_type(4)));
typedef unsigned u32x2 __attribute__((ext_vector_type(2)));

constexpr int D = 1024, NP = 16384, NS = 256, NTOK = NP + NS, SEQ = 2048, DSEQ = 8, PAST = 16384, PAGE = 128, NPAGES = 128, NPHYS = 5120;
constexpr int FF = 4096, LAT = 320, QL_LD = 1280, NE1 = 2816, NQ2 = 1280, KOE = 1536, NO1 = 3584;
constexpr int NSPLIT = 16, NSE = 2 * NSPLIT;
constexpr float EPS = 1e-6f;
constexpr float QSCALE = 0.07216878364870322f * 1.4426950408889634f;

constexpr size_t MiB = 1u << 20;
constexpr size_t WS_CTL = 0, CTL_BYTES = 2 * MiB;
constexpr size_t WS_WINE = 2 * MiB;
constexpr size_t WS_WQ2 = WS_WINE + 2ull * NE1 * 1024 * 2;
constexpr size_t WS_WOUTE = WS_WQ2 + 2ull * NQ2 * 384 * 2;
constexpr size_t WS_WINO = WS_WOUTE + 2ull * 1024 * KOE * 2;
constexpr size_t WS_WOUTO = WS_WINO + 2ull * NO1 * 1024 * 2;
constexpr size_t WS_WUP = WS_WOUTO + 2ull * 1024 * 1024 * 2;
constexpr size_t WS_WDOWN = WS_WUP + 4ull * FF * 1024 * 2;
constexpr size_t WS_LBS = WS_WDOWN + 4ull * FF * 1024 * 2;
constexpr size_t WS_ROPE = WS_LBS + 4096;
constexpr size_t WS_X = (WS_ROPE + 2056ull * 64 * 4 + 4095) & ~(size_t)4095;
constexpr size_t WS_XB = WS_X + (size_t)NTOK * D * 4;
constexpr size_t WS_SSQ = WS_XB + (size_t)NTOK * D * 2;
constexpr size_t WS_QH = WS_SSQ + (size_t)NTOK * 16 * 4;
constexpr size_t WS_KK = WS_QH + (size_t)NTOK * 512 * 2;
constexpr size_t WS_LOGF = WS_KK + (size_t)NTOK * 512 * 2;
constexpr size_t WS_V = WS_LOGF + (size_t)NTOK * 512 * 4;
constexpr size_t WS_G = WS_V + (size_t)NTOK * 1024 * 2;
constexpr size_t WS_CKV = WS_G + (size_t)NTOK * 1024 * 2;
constexpr size_t WS_KR = WS_CKV + (size_t)NTOK * 256 * 4;
constexpr size_t WS_CQ = WS_KR + (size_t)NTOK * 64 * 4;
constexpr size_t WS_SSQCQ = WS_CQ + (size_t)NTOK * 384 * 2;
constexpr size_t WS_KVL = WS_SSQCQ + (size_t)NTOK * 16 * 4;
constexpr size_t WS_QL = WS_KVL + (size_t)NTOK * LAT * 2;
constexpr size_t WS_OA = WS_QL + (size_t)NTOK * QL_LD * 2;
constexpr size_t WS_FFB = WS_OA + (size_t)NTOK * KOE * 2;
constexpr size_t WS_PO = WS_FFB + (size_t)NTOK * FF * 2;
constexpr size_t WS_PML = WS_PO + 32ull * NSE * 32 * 256 * 4;
constexpr size_t WS_SEGH = WS_PML + 32ull * NSE * 32 * 2 * 4;
constexpr size_t WS_SEGD = WS_SEGH + 32ull * 8 * 128 * 256 * 4;
constexpr size_t WS_END = WS_SEGD + 32ull * 8 * 128 * 4;
constexpr int CW_BAR = 4096;
constexpr int CW_QUEUE = 16384;

constexpr int RING_BYTES = 131072, SCL_OFF = RING_BYTES  , MISC_OFF = SCL_OFF + 2048, LDS_BYTES = MISC_OFF + 2048;

__device__ __forceinline__ unsigned cvt_pk_bf16(float lo, float hi) { unsigned r; asm volatile("v_cvt_pk_bf16_f32 %0, %1, %2" : "=v"(r) : "v"(lo), "v"(hi)); return r; }
__device__ __forceinline__ float bf2f(bf16_t b) { return __uint_as_float(((unsigned)b) << 16); }
__device__ __forceinline__ float bflo(unsigned w) { return __uint_as_float(w << 16); }
__device__ __forceinline__ float bfhi(unsigned w) { return __uint_as_float(w & 0xffff0000u); }
__device__ __forceinline__ float fexp2(float x) { return __builtin_amdgcn_exp2f(x); }
__device__ __forceinline__ float fexp(float x) { return __builtin_amdgcn_exp2f(x * 1.4426950408889634f); }
__device__ __forceinline__ float frcp(float x) { return __builtin_amdgcn_rcpf(x); }
__device__ __forceinline__ float sigm(float x) { return frcp(1.f + fexp(-x)); }
__device__ __forceinline__ float wave_sum(float v) {
#pragma unroll
    for (int o = 1; o < 64; o <<= 1) v += __shfl_xor(v, o);
    return v;
}
__device__ __forceinline__ int rope_idx(int row) { return row < NP ? (row & (SEQ - 1)) : SEQ + ((row - NP) & (DSEQ - 1)); }

#define XB_TMO      128
#define XB_XCNT(j)  (256  + 64 * (j))
#define XB_XSUB(j)  (1280 + 64 * (j))
#define XB_XGEN(j)  (2304 + 64 * (j))
#define XB_TOP      3328
#define XB_TOPGEN   3392
#define XCD_BAR_WORDS 3456
#define XB_SPIN_CAP (1u << 18)
__device__ __forceinline__ unsigned xb_ld(unsigned* p)              { return __hip_atomic_load(p, __ATOMIC_RELAXED, __HIP_MEMORY_SCOPE_AGENT); }
__device__ __forceinline__ unsigned xb_add(unsigned* p, unsigned v) { return __hip_atomic_fetch_add(p, v, __ATOMIC_RELAXED, __HIP_MEMORY_SCOPE_AGENT); }
__device__ __forceinline__ unsigned xb_xcc_id() { return (unsigned)__builtin_amdgcn_s_getreg((3 << 11) | 20) & 0xFu; }
#define XB_SPIN(cond, bar) do { unsigned _sp = 0; while (cond) { __builtin_amdgcn_s_sleep(1); \
    if ((++_sp & 255u) == 0u) { if (xb_ld(&(bar)[XB_TMO])) break; if (_sp > XB_SPIN_CAP) { atomicAdd(&(bar)[XB_TMO], 1u); break; } } } } while (0)
struct XcdBarrier { unsigned* bar; unsigned x; volatile LAS unsigned* st; };
__device__ __forceinline__ XcdBarrier xcd_barrier_post(unsigned* bar, volatile LAS unsigned* st) {
    XcdBarrier b; b.bar = bar; b.x = xb_xcc_id(); b.st = st;
    if (threadIdx.x == 0) (void)xb_add(&bar[XB_XCNT(b.x)], 1u);
    return b;
}
__device__ __forceinline__ void xcd_barrier_complete(unsigned* bar, unsigned x, unsigned& nloc, unsigned& nx) {
    const unsigned G = gridDim.x * gridDim.y * gridDim.z;
    unsigned sum, cnt, mine, sp = 0u;
    for (;;) {
        sum = 0u; cnt = 0u; mine = 0u;
#pragma unroll
        for (unsigned j = 0; j < 16; ++j) { const unsigned c = xb_ld(&bar[XB_XCNT(j)]); sum += c; cnt += (c > 0u) ? 1u : 0u; mine = (j == x) ? c : mine; }
        if (sum == G) break;
        __builtin_amdgcn_s_sleep(1);
        if ((++sp & 255u) == 0u) { if (xb_ld(&bar[XB_TMO])) break; if (sp > XB_SPIN_CAP) { atomicAdd(&bar[XB_TMO], 1u); break; } }
    }
    nloc = mine > 0u ? mine : 1u; nx = cnt > 0u ? cnt : 1u;
}
__device__ __forceinline__ void xcd_barrier(const XcdBarrier& b) {
    asm volatile("s_waitcnt vmcnt(0)" ::: "memory");
    __syncthreads();
    if (threadIdx.x == 0) {
        unsigned* bar = b.bar;
        __builtin_amdgcn_s_waitcnt(0);
        unsigned nloc = b.st[0], nx = b.st[1];
        if (nloc == 0u) { xcd_barrier_complete(bar, b.x, nloc, nx); b.st[0] = nloc; b.st[1] = nx; }
        const unsigned old = xb_add(&bar[XB_XSUB(b.x)], 1u);
        const unsigned gen = old / nloc;
        if (old + 1u == (gen + 1u) * nloc) {
            __builtin_amdgcn_fence(__ATOMIC_RELEASE, "agent");
            asm volatile("s_waitcnt vmcnt(0)" ::: "memory");
            const unsigned og = xb_add(&bar[XB_TOP], 1u);
            const unsigned tg = og / nx;
            if (og + 1u == (tg + 1u) * nx) xb_add(&bar[XB_TOPGEN], 1u);
            else XB_SPIN(xb_ld(&bar[XB_TOPGEN]) == tg, bar);
            __builtin_amdgcn_fence(__ATOMIC_ACQUIRE, "agent");
            xb_add(&bar[XB_XGEN(b.x)], 1u);
            asm volatile("s_waitcnt vmcnt(0)" ::: "memory");
        } else {
            XB_SPIN(xb_ld(&bar[XB_XGEN(b.x)]) == gen, bar);
            __builtin_amdgcn_fence(__ATOMIC_ACQUIRE, "agent");
            asm volatile("s_waitcnt vmcnt(0)" ::: "memory");
        }
    }
    __syncthreads();
}

constexpr int BM = 256, BK = 64, HALF = 128, HTB = HALF * BK * 2, NXCD = 8, WGM = 8;
__host__ __device__ __forceinline__ int lds_byte(int r, int c) { const int st = (r >> 4) * 2 + (c >> 5), rr = r & 15, cc = c & 31, ob = rr * 64 + cc * 2; return st * 1024 + (ob ^ (((ob >> 9) & 1) << 5)); }
__host__ __device__ __forceinline__ void stage_rc(int b, int& R, int& C) { const int st = b / 1024, sb = b % 1024, swz = sb ^ (((sb >> 9) & 1) << 5); R = (st >> 1) * 16 + swz / 64; C = (st & 1) * 32 + (swz % 64) / 2; }
__host__ __device__ __forceinline__ int perm32(int rho) { const int n = rho >> 4, i = rho & 15; return 8 * (i >> 2) + 4 * n + (i & 3); }
struct Unit { int pm, pn, idx; };
struct Gemm { const bf16_t* A; const bf16_t* Bt; int lda, ldb, M, N, K; };
struct RowScale { const float* part; int stride, np4; float inv_n; };
struct StaticOrder {
    int nM, nN, nwg, G, c;
    __device__ void init(int M, int N, int G_, int c_) { nM = M / BM; nN = N / BM; nwg = nM * nN; G = G_; c = c_; }
    __device__ bool next(int i, Unit& u) const {
        const long L = (long)i * G + c; if (L >= nwg) return false;
        int wgid = (int)L; { const int q = nwg / NXCD, r = nwg % NXCD, xcd = wgid % NXCD, off = wgid / NXCD; wgid = (xcd < r ? xcd * (q + 1) : r * (q + 1) + (xcd - r) * q) + off; }
        const int nig = WGM * nN, gid = wgid / nig, fm = gid * WGM, gsz = (nM - fm) < WGM ? (nM - fm) : WGM;
        u.pm = fm + ((wgid % nig) % gsz); u.pn = (wgid % nig) / gsz; u.idx = i; return true;
    }
};
template <bool SCALE>
__device__ __forceinline__ void rs_fill(LAS unsigned char* ldsbase, const RowScale& rs, const Unit& u, int tid) {
    if constexpr (SCALE) {
        if (tid < 256) {
            const f32x4* p = (const f32x4*)(rs.part + (size_t)(u.pm * BM + tid) * rs.stride); float s = 0.f;
            for (int j = 0; j < rs.np4; ++j) { const f32x4 v = p[j]; s += (v[0] + v[1]) + (v[2] + v[3]); }
            ((LAS float*)(ldsbase + SCL_OFF))[(u.idx & 1) * 256 + tid] = rsqrtf(s * rs.inv_n + EPS);
        }
    }
}
template <class Epi, bool SCALE>
__device__ __forceinline__ void gemm_phase(LAS unsigned char* lds, const Gemm g, const StaticOrder& S, const Epi& E, const RowScale rs) {
    int tid = threadIdx.x; asm volatile("" : "+v"(tid));
    const int wid = __builtin_amdgcn_readfirstlane(tid >> 6), lane = tid & 63, wr = wid >> 2, wc = wid & 3, fr = lane & 15, fq = lane >> 4;
    const int K = g.K, nt = K / BK;
    unsigned voffA[2], voffB[2];
#pragma unroll
    for (int i = 0; i < 2; ++i) { int R, C; stage_rc(tid * 16 + i * 8192, R, C); const int Rb = (R & ~31) + perm32(R & 31);
        voffA[i] = (unsigned)(R * g.lda + C) * 2u; voffB[i] = (unsigned)(Rb * g.ldb + C) * 2u; }
    const size_t kstep = (size_t)(BK * 2);
    const size_t hstepA = (size_t)HALF * g.lda * 2, hstepB = (size_t)HALF * g.ldb * 2;
    const size_t tstepA = 2 * hstepA, tstepB = 2 * hstepB;
    const unsigned ldsw = (unsigned)wid * 1024u;
    const int aoff = lds_byte(wr * 64 + fr, fq * 8), boff = lds_byte(wc * 32 + fr, fq * 8);
#define PG8_SA(b, h) (((b) * 2 + (h)) * HTB)
#define PG8_SB(b, h) ((4 + (b) * 2 + (h)) * HTB)
#define PG8_STAGE(bufoff, gbase, voff) do { _Pragma("unroll") for (int _i = 0; _i < 2; ++_i) \
        __builtin_amdgcn_global_load_lds((const unsigned*)((const char*)(gbase) + (voff)[_i]), (LAS unsigned*)(lds + (bufoff) + ldsw + _i * 8192), 16, 0, 0); } while (0)
#define PG8_LDA(dst, b, h) do { _Pragma("unroll") for (int m = 0; m < 4; ++m) _Pragma("unroll") for (int k = 0; k < 2; ++k) dst[m][k] = *(const LAS bf16x8*)(lds + PG8_SA(b, h) + aoff + m * 2048 + k * 1024); } while (0)
#define PG8_LDB(dst, b, h) do { _Pragma("unroll") for (int n = 0; n < 2; ++n) _Pragma("unroll") for (int k = 0; k < 2; ++k) dst[n][k] = *(const LAS bf16x8*)(lds + PG8_SB(b, h) + boff + n * 2048 + k * 1024); } while (0)
#define PG8_MMA(ai, bj, At, Bt) do { __builtin_amdgcn_s_setprio(1); _Pragma("unroll") for (int m = 0; m < 4; ++m) _Pragma("unroll") for (int n = 0; n < 2; ++n) _Pragma("unroll") for (int k = 0; k < 2; ++k) \
        acc[ai][bj][m][n] = __builtin_amdgcn_mfma_f32_16x16x32_bf16(Bt[n][k], At[m][k], acc[ai][bj][m][n], 0, 0, 0); __builtin_amdgcn_s_setprio(0); } while (0)
#define PG8_WAIT_V(n) asm volatile("s_waitcnt vmcnt(" #n ")" ::: "memory")
#define PG8_WAIT_L(n) asm volatile("s_waitcnt lgkmcnt(" #n ")" ::: "memory")
#define PG8_BAR __builtin_amdgcn_s_barrier()
#define PG8_SCHED __builtin_amdgcn_sched_barrier(0)
    Unit cur, nxt; int ui = 0;
    if (!S.next(0, cur)) return;
    f32x4 acc[2][2][4][2];
#pragma unroll
    for (int a = 0; a < 2; ++a)
#pragma unroll
        for (int b = 0; b < 2; ++b)
#pragma unroll
            for (int m = 0; m < 4; ++m)
#pragma unroll
                for (int n = 0; n < 2; ++n) acc[a][b][m][n] = (f32x4){0.f, 0.f, 0.f, 0.f};
    bf16x8 At[4][2], B0[2][2], B1[2][2];
    const char* cA = (const char*)g.A + (size_t)cur.pm * tstepA; const char* cB = (const char*)g.Bt + (size_t)cur.pn * tstepB;
    rs_fill<SCALE>(lds, rs, cur, tid);
    PG8_STAGE(PG8_SB(0, 0), cB, voffB); PG8_STAGE(PG8_SB(0, 1), cB + hstepB, voffB); PG8_STAGE(PG8_SA(0, 0), cA, voffA); PG8_STAGE(PG8_SA(0, 1), cA + hstepA, voffA);
    if (wr == 1) PG8_BAR;
    PG8_WAIT_V(2); PG8_BAR;
    PG8_STAGE(PG8_SB(1, 0), cB + kstep, voffB); PG8_STAGE(PG8_SA(1, 0), cA + kstep, voffA); PG8_STAGE(PG8_SB(1, 1), cB + hstepB + kstep, voffB);
    PG8_WAIT_V(6); PG8_BAR;
    for (;;) {
        const bool has_next = S.next(ui + 1, nxt);
        const char* nA = has_next ? (const char*)g.A + (size_t)nxt.pm * tstepA : cA; const char* nB = has_next ? (const char*)g.Bt + (size_t)nxt.pn * tstepB : cB;
#pragma unroll 1
        for (int t = 0; t < nt; t += 2) {
            const bool last = (t == nt - 2);
            const char* a1 = cA + (size_t)(t + 1) * kstep;
            const char* a2 = last ? nA : cA + (size_t)(t + 2) * kstep; const char* b2 = last ? nB : cB + (size_t)(t + 2) * kstep;
            const char* a3 = a2 + kstep; const char* b3 = b2 + kstep;
            if (last && has_next) rs_fill<SCALE>(lds, rs, nxt, tid);
            PG8_LDB(B0, 0, 0); PG8_LDB(B1, 0, 1); PG8_SCHED; PG8_LDA(At, 0, 0); PG8_STAGE(PG8_SA(1, 1), a1 + hstepA, voffA);
            PG8_WAIT_V(8); PG8_WAIT_L(0); PG8_BAR; PG8_MMA(0, 0, At, B0); PG8_MMA(0, 1, At, B1); PG8_BAR; PG8_SCHED;
            PG8_LDA(At, 0, 1); PG8_STAGE(PG8_SB(0, 0), b2, voffB); PG8_STAGE(PG8_SB(0, 1), b2 + hstepB, voffB); PG8_STAGE(PG8_SA(0, 0), a2, voffA);
            PG8_WAIT_V(8); PG8_WAIT_L(0); PG8_BAR; PG8_MMA(1, 0, At, B0); PG8_MMA(1, 1, At, B1); PG8_BAR; PG8_SCHED;
            PG8_LDB(B0, 1, 0); PG8_LDB(B1, 1, 1); PG8_SCHED; PG8_LDA(At, 1, 0); PG8_STAGE(PG8_SA(0, 1), a2 + hstepA, voffA);
            PG8_WAIT_V(8); PG8_WAIT_L(0); PG8_BAR; PG8_MMA(0, 0, At, B0); PG8_MMA(0, 1, At, B1); PG8_BAR; PG8_SCHED;
            PG8_LDA(At, 1, 1); PG8_STAGE(PG8_SB(1, 0), b3, voffB); PG8_STAGE(PG8_SB(1, 1), b3 + hstepB, voffB); PG8_STAGE(PG8_SA(1, 0), a3, voffA);
            PG8_WAIT_V(8); PG8_WAIT_L(0); PG8_BAR; PG8_MMA(1, 0, At, B0); PG8_MMA(1, 1, At, B1); PG8_BAR; PG8_SCHED;
        }
        if (wr == 0) PG8_BAR;
        { int fr_ = fr, fq_ = fq; asm volatile("" : "+v"(fr_), "+v"(fq_));
          E(acc, cur, wr, wc, fr_, fq_, (const LAS float*)(lds + SCL_OFF) + (cur.idx & 1) * 256); }
        if (!has_next) break;
#pragma unroll
        for (int a = 0; a < 2; ++a)
#pragma unroll
            for (int b = 0; b < 2; ++b)
#pragma unroll
                for (int m = 0; m < 4; ++m)
#pragma unroll
                    for (int n = 0; n < 2; ++n) acc[a][b][m][n] = (f32x4){0.f, 0.f, 0.f, 0.f};
        cur = nxt; cA = nA; cB = nB; ++ui;
        if (wr == 1) PG8_BAR;
    }
    PG8_WAIT_V(0);
    PG8_BAR;
#undef PG8_SA
#undef PG8_SB
#undef PG8_STAGE
#undef PG8_LDA
#undef PG8_LDB
#undef PG8_MMA
#undef PG8_WAIT_V
#undef PG8_WAIT_L
#undef PG8_BAR
#undef PG8_SCHED
}

#define EPI_ROWS_BEGIN  _Pragma("unroll") for (int ai = 0; ai < 2; ++ai) _Pragma("unroll") for (int m = 0; m < 4; ++m) { \
        const int rl = ai * HALF + wr * 64 + m * 16 + fr; const int row = u.pm * BM + rl; (void)row;
#define EPI_ROWS_END asm volatile("" ::: "memory"); }
__device__ __forceinline__ void st_bf8(bf16_t* p, const f32x4 a, const f32x4 b) { u32x4 w; w.x = cvt_pk_bf16(a[0], a[1]); w.y = cvt_pk_bf16(a[2], a[3]); w.z = cvt_pk_bf16(b[0], b[1]); w.w = cvt_pk_bf16(b[2], b[3]); *(u32x4*)p = w; }
__device__ __forceinline__ float sq8(const f32x4 a, const f32x4 b) { return (a[0] * a[0] + a[1] * a[1]) + (a[2] * a[2] + a[3] * a[3]) + (b[0] * b[0] + b[1] * b[1]) + (b[2] * b[2] + b[3] * b[3]); }
__device__ __forceinline__ float silu1(float x) { return x * frcp(1.f + fexp(-x)); }

struct EpiInEven {
    bf16_t* Qh; bf16_t* KK; float* LOGF; bf16_t* V; bf16_t* G; float* CKV; float* KR; bf16_t* CQ; float* SSQCQ; const float* lbs;
    __device__ __forceinline__ void operator()(const f32x4 (&acc)[2][2][4][2], const Unit& u, int wr, int wc, int fr, int fq, const LAS float* scl) const {
        const int pn = u.pn;
        EPI_ROWS_BEGIN
            const float s = scl[rl];
#pragma unroll
            for (int bj = 0; bj < 2; ++bj) {
                const int cl = bj * HALF + wc * 32 + 8 * fq;
                f32x4 a = acc[ai][bj][m][0] * s, b = acc[ai][bj][m][1] * s;
                if (pn < 2) {
#pragma unroll
                    for (int j = 0; j < 4; ++j) { a[j] = silu1(a[j]) * 0.08838834764831845f; b[j] = silu1(b[j]) * 0.08838834764831845f; }
                    st_bf8(Qh + (size_t)row * 512 + pn * 256 + cl, a, b);
                } else if (pn < 4) {
                    const int c = (pn - 2) * 256 + cl; const f32x4 l0 = *(const f32x4*)(lbs + c), l1 = *(const f32x4*)(lbs + c + 4);
                    f32x4 lf0, lf1, k0, k1;
#pragma unroll
                    for (int j = 0; j < 4; ++j) {
                        { const float z = a[j], lb = l0[j], sp = sigm(z), sn = sigm(-z); lf0[j] = __logf(fmaxf(lb + (1.f - lb) * sp, 1e-30f)); k0[j] = (1.f - lb) * sn; }
                        { const float z = b[j], lb = l1[j], sp = sigm(z), sn = sigm(-z); lf1[j] = __logf(fmaxf(lb + (1.f - lb) * sp, 1e-30f)); k1[j] = (1.f - lb) * sn; }
                    }
                    *(f32x4*)(LOGF + (size_t)row * 512 + c) = lf0; *(f32x4*)(LOGF + (size_t)row * 512 + c + 4) = lf1;
                    st_bf8(KK + (size_t)row * 512 + c, k0, k1);
                } else if (pn < 6) {
                    st_bf8(V + (size_t)row * 512 + (pn - 4) * 256 + cl, a, b);
                } else if (pn < 8) {
#pragma unroll
                    for (int j = 0; j < 4; ++j) { a[j] = silu1(a[j]); b[j] = silu1(b[j]); }
                    st_bf8(G + (size_t)row * 512 + (pn - 6) * 256 + cl, a, b);
                } else if (pn == 8) {
                    *(f32x4*)(CKV + (size_t)row * 256 + cl) = a; *(f32x4*)(CKV + (size_t)row * 256 + cl + 4) = b;
                } else if (pn == 9 || bj == 0) {
                    const int c = (pn - 9) * 256 + cl;
                    st_bf8(CQ + (size_t)row * 384 + c, a, b);
                    float ss = sq8(a, b); ss += __shfl_xor(ss, 16); ss += __shfl_xor(ss, 32);
                    if (fq == 0) SSQCQ[(size_t)row * 16 + (pn == 9 ? bj * 4 + wc : 8 + wc)] = ss;
                } else if (wc < 2) {
                    const int c = wc * 32 + 8 * fq;
                    *(f32x4*)(KR + (size_t)row * 64 + c) = a; *(f32x4*)(KR + (size_t)row * 64 + c + 4) = b;
                }
            }
        EPI_ROWS_END
    }
};
struct EpiQ2 {
    bf16_t* QL; const float* rope;
    __device__ __forceinline__ void operator()(const f32x4 (&acc)[2][2][4][2], const Unit& u, int wr, int wc, int fr, int fq, const LAS float* scl) const {
        const int pn = u.pn;
        if (pn < 4) {
            EPI_ROWS_BEGIN
                const float s = scl[rl]; bf16_t* dst = QL + (size_t)row * QL_LD + pn * LAT + wc * 32 + 8 * fq;
                st_bf8(dst, acc[ai][0][m][0] * s, acc[ai][0][m][1] * s); st_bf8(dst + HALF, acc[ai][1][m][0] * s, acc[ai][1][m][1] * s);
            EPI_ROWS_END
        } else {
            const int g = (wc & 1) * 4 + fq;
            EPI_ROWS_BEGIN
                const float s = scl[rl]; const float* rp = rope + rope_idx(row) * 64 + 4 * g;
                const f32x4 c = *(const f32x4*)rp, sn = *(const f32x4*)(rp + 32);
#pragma unroll
                for (int bj = 0; bj < 2; ++bj) {
                    const f32x4 a = acc[ai][bj][m][0] * s, b = acc[ai][bj][m][1] * s, o1 = a * c - b * sn, o2 = a * sn + b * c;
                    bf16_t* dst = QL + (size_t)row * QL_LD + (bj * 2 + (wc >> 1)) * LAT + 256 + 4 * g;
                    u32x2 w1, w2; w1.x = cvt_pk_bf16(o1[0], o1[1]); w1.y = cvt_pk_bf16(o1[2], o1[3]); w2.x = cvt_pk_bf16(o2[0], o2[1]); w2.y = cvt_pk_bf16(o2[2], o2[3]);
                    *(u32x2*)dst = w1; *(u32x2*)(dst + 32) = w2;
                }
            EPI_ROWS_END
        }
    }
};
struct EpiOutRes {
    const float* resP; const float* resS; float* X; bf16_t* XB; float* SSQ;
    __device__ __forceinline__ void operator()(const f32x4 (&acc)[2][2][4][2], const Unit& u, int wr, int wc, int fr, int fq, const LAS float* scl) const {
        EPI_ROWS_BEGIN
            const float* rr = row < NP ? resP + (size_t)row * D : resS + (size_t)(row - NP) * D;
            float ss = 0.f;
#pragma unroll
            for (int bj = 0; bj < 2; ++bj) {
                const int c = u.pn * BM + bj * HALF + wc * 32 + 8 * fq;
                const f32x4 a = acc[ai][bj][m][0] + *(const f32x4*)(rr + c), b = acc[ai][bj][m][1] + *(const f32x4*)(rr + c + 4);
                *(f32x4*)(X + (size_t)row * D + c) = a; *(f32x4*)(X + (size_t)row * D + c + 4) = b;
                st_bf8(XB + (size_t)row * D + c, a, b);
                ss += sq8(a, b);
            }
            ss += __shfl_xor(ss, 16); ss += __shfl_xor(ss, 32);
            if (fq == 0) SSQ[(size_t)row * 16 + u.pn * 4 + wc] = ss;
        EPI_ROWS_END
    }
};
struct EpiUp {
    bf16_t* FFB;
    __device__ __forceinline__ void operator()(const f32x4 (&acc)[2][2][4][2], const Unit& u, int wr, int wc, int fr, int fq, const LAS float* scl) const {
        EPI_ROWS_BEGIN
            const float s = scl[rl];
#pragma unroll
            for (int bj = 0; bj < 2; ++bj) {
                f32x4 a = acc[ai][bj][m][0] * s, b = acc[ai][bj][m][1] * s;
#pragma unroll
                for (int j = 0; j < 4; ++j) { const float x = fmaxf(a[j], 0.f), y = fmaxf(b[j], 0.f); a[j] = x * x; b[j] = y * y; }
                st_bf8(FFB + (size_t)row * FF + u.pn * BM + bj * HALF + wc * 32 + 8 * fq, a, b);
            }
        EPI_ROWS_END
    }
};
struct EpiInOdd {
    bf16_t* Qh; bf16_t* KK; bf16_t* V; bf16_t* G; float* LOGF; const float* ba;
    __device__ __forceinline__ void operator()(const f32x4 (&acc)[2][2][4][2], const Unit& u, int wr, int wc, int fr, int fq, const LAS float* scl) const {
        const int pn = u.pn;
        EPI_ROWS_BEGIN
            const float s = scl[rl];
#pragma unroll
            for (int bj = 0; bj < 2; ++bj) {
                const int cl = bj * HALF + wc * 32 + 8 * fq;
                f32x4 a = acc[ai][bj][m][0] * s, b = acc[ai][bj][m][1] * s;
                if (pn < 2) { a = a * 0.08838834764831845f; b = b * 0.08838834764831845f; st_bf8(Qh + (size_t)row * 512 + pn * 256 + cl, a, b); }
                else if (pn < 4) st_bf8(KK + (size_t)row * 512 + (pn - 2) * 256 + cl, a, b);
                else if (pn < 8) st_bf8(V + (size_t)row * 1024 + (pn - 4) * 256 + cl, a, b);
                else if (pn < 12) {
#pragma unroll
                    for (int j = 0; j < 4; ++j) { a[j] = silu1(a[j]); b[j] = silu1(b[j]); }
                    st_bf8(G + (size_t)row * 1024 + (pn - 8) * 256 + cl, a, b);
                } else {
                    const int c = (pn - 12) * 256 + cl; const f32x4 b0 = *(const f32x4*)(ba + c), b1 = *(const f32x4*)(ba + c + 4);
                    f32x4 l0, l1;
#pragma unroll
                    for (int j = 0; j < 4; ++j) {
                        { const float x = a[j] + b0[j]; l0[j] = (fminf(x, 0.f) - __logf(1.f + fexp(-fabsf(x)))) * 0.0625f; }
                        { const float x = b[j] + b1[j]; l1[j] = (fminf(x, 0.f) - __logf(1.f + fexp(-fabsf(x)))) * 0.0625f; }
                    }
                    *(f32x4*)(LOGF + (size_t)row * 512 + c) = l0; *(f32x4*)(LOGF + (size_t)row * 512 + c + 4) = l1;
                }
            }
        EPI_ROWS_END
    }
};
struct Args { const void* in[25]; float* out; unsigned char* ws; int ph_lo, ph_hi, qrep, pad; };
typedef const __attribute__((address_space(4))) Args* KArgs;
struct Frame {
    LAS unsigned char* lds; volatile LAS unsigned* MISC; unsigned* ctl; unsigned char* ws;
    int tid, lane, wave, G, gw, NGW;
};
#define IN_F(i) ((const float*)args->in[i])
constexpr size_t OUT_YP = 0, OUT_YS = OUT_YP + (size_t)NP * D, OUT_MRP = OUT_YS + (size_t)NS * D, OUT_MRS = OUT_MRP + (size_t)2 * NP * LAT, OUT_HSP = OUT_MRS + (size_t)2 * NS * LAT,
                 OUT_HSS = OUT_HSP + (size_t)2 * 8 * 4 * 128 * 128, OUT_GSP = OUT_HSS + (size_t)2 * 32 * 4 * 128 * 128, OUT_GSS = OUT_GSP + (size_t)2 * 8 * 4 * 128 * 256;
#define WSP(T, off) ((T*)(F.ws + (off)))

struct TJob { const float* W; const float* gain; bf16_t* WT; int ldw, scol, K, ncols, ldt, drow, dk0; };
__device__ __forceinline__ void transpose_item(const TJob& J, int item, LAS float* scr, int lane) {
    const int nblk = J.ncols / 32, kb = item / nblk, nb = item % nblk, k0 = 64 * kb, n0 = 32 * nb;
#pragma unroll 8
    for (int i = 0; i < 32; ++i) { const int kk = 2 * i + (lane >> 5); float v = J.W[(size_t)(k0 + kk) * J.ldw + J.scol + n0 + (lane & 31)]; if (J.gain) v *= J.gain[k0 + kk]; scr[kk * 33 + (lane & 31)] = v; }
    asm volatile("s_waitcnt lgkmcnt(0)" ::: "memory");
    const int c = lane & 7;
#pragma unroll
    for (int j = 0; j < 4; ++j) { const int n = (lane >> 3) + 8 * j; const LAS float* s = scr + (8 * c) * 33 + n;
        u32x4 o; o.x = cvt_pk_bf16(s[0 * 33], s[1 * 33]); o.y = cvt_pk_bf16(s[2 * 33], s[3 * 33]); o.z = cvt_pk_bf16(s[4 * 33], s[5 * 33]); o.w = cvt_pk_bf16(s[6 * 33], s[7 * 33]);
        *(u32x4*)(J.WT + (size_t)(J.drow + n0 + n) * J.ldt + J.dk0 + k0 + 8 * c) = o; }
    asm volatile("s_waitcnt lgkmcnt(0)" ::: "memory");
}
__device__ __forceinline__ TJob get_job(const Frame& F, KArgs args, int j) {
    TJob J;
    if (j < 10) { const int e = j / 5, s = j % 5; const float* W = IN_F(9) + (size_t)e * 1024 * 2752; bf16_t* WT = WSP(bf16_t, WS_WINE) + (size_t)e * NE1 * 1024;
        const float* gn = IN_F(6) + (2 * e) * 1024;
        if (s == 0) J = TJob{W, gn, WT, 2752, 0, 1024, 2048, 1024, 0, 0};
        else if (s == 1) J = TJob{W, gn, WT, 2752, 2432, 1024, 256, 1024, 2048, 0};
        else if (s == 2) J = TJob{W, gn, WT, 2752, 2048, 1024, 384, 1024, 2304, 0};
        else if (s == 3) J = TJob{W, gn, WT, 2752, 2688, 1024, 64, 1024, 2688, 0};
        else J = TJob{IN_F(17) + (size_t)e * 1024 * 1024, nullptr, WSP(bf16_t, WS_WOUTE) + (size_t)e * 1024 * KOE, 1024, 0, 512, 1024, KOE, 0, 0};
    } else if (j < 14) { const int o = (j - 10) >> 1;
        if (((j - 10) & 1) == 0) J = TJob{IN_F(18) + (size_t)o * 1024 * 3088, IN_F(6) + (2 * o + 1) * 1024, WSP(bf16_t, WS_WINO) + (size_t)o * NO1 * 1024, 3088, 0, 1024, 3072, 1024, 0, 0};
        else J = TJob{IN_F(22) + (size_t)o * 1024 * 1024, nullptr, WSP(bf16_t, WS_WOUTO) + (size_t)o * 1024 * 1024, 1024, 0, 1024, 1024, 1024, 0, 0};
    } else { const int l = (j - 14) >> 1;
        if (((j - 14) & 1) == 0) J = TJob{IN_F(23) + (size_t)l * 1024 * FF, IN_F(7) + l * 1024, WSP(bf16_t, WS_WUP) + (size_t)l * FF * 1024, FF, 0, 1024, FF, 1024, 0, 0};
        else J = TJob{IN_F(24) + (size_t)l * FF * 1024, nullptr, WSP(bf16_t, WS_WDOWN) + (size_t)l * 1024 * FF, 1024, 0, FF, 1024, FF, 0, 0};
    }
    return J;
}
__device__ __forceinline__ void p0_prologue(Frame& F, KArgs args) {
    LAS float* scr = (LAS float*)(F.lds + F.wave * 16384);
    for (int j = 0; j < 22; ++j) { const TJob J = get_job(F, args, j); const int nit = (J.K / 64) * (J.ncols / 32);
        for (int it = F.gw; it < nit; it += F.NGW) transpose_item(J, it, scr, F.lane); }
    __syncthreads();
    LAS float* sm = (LAS float*)(F.lds);
    for (int it = blockIdx.x; it < 512; it += F.G) {
        const int kind = it >> 8, r = it & 255, e = r >> 7, h = (r >> 5) & 3, c8 = r & 31;
        __syncthreads();
        if (kind == 0) {
            for (int i = F.tid; i < 1024; i += 512) sm[i] = IN_F(15)[((size_t)((e * 4 + h) * 256 + c8 * 8 + (i >> 7))) * 128 + (i & 127)];
            __syncthreads();
            if (F.tid < 384) { const int k = F.tid; const f32x4* a = (const f32x4*)(IN_F(13) + (size_t)(e * 384 + k) * 768 + h * 192); float acc[8] = {};
#pragma unroll 8
                for (int n4 = 0; n4 < 32; ++n4) { const f32x4 av = a[n4];
#pragma unroll
                    for (int c = 0; c < 8; ++c) { const f32x4 bv = *(const LAS f32x4*)(sm + c * 128 + n4 * 4); acc[c] += (av[0] * bv[0] + av[1] * bv[1]) + (av[2] * bv[2] + av[3] * bv[3]); } }
                const float gq = IN_F(12)[e * 384 + k] * QSCALE; bf16_t* dst = WSP(bf16_t, WS_WQ2) + ((size_t)e * NQ2 + h * 256 + c8 * 8) * 384 + k;
#pragma unroll
                for (int c = 0; c < 8; ++c) dst[(size_t)c * 384] = (bf16_t)(cvt_pk_bf16(acc[c] * gq, 0.f) & 0xffffu); }
        } else {
            for (int i = F.tid; i < 1024; i += 512) sm[i] = IN_F(16)[((size_t)((e * 4 + h) * 256 + c8 * 8 + (i >> 7))) * 128 + (i & 127)];
            __syncthreads();
            for (int n = F.tid; n < 1024; n += 512) { const float* wo = IN_F(17) + ((size_t)e * 1024 + 512 + h * 128) * 1024 + n; float acc[8] = {};
#pragma unroll 16
                for (int v = 0; v < 128; ++v) { const float x = wo[(size_t)v * 1024];
#pragma unroll
                    for (int c = 0; c < 8; ++c) acc[c] += sm[c * 128 + v] * x; }
                u32x4 o; o.x = cvt_pk_bf16(acc[0], acc[1]); o.y = cvt_pk_bf16(acc[2], acc[3]); o.z = cvt_pk_bf16(acc[4], acc[5]); o.w = cvt_pk_bf16(acc[6], acc[7]);
                *(u32x4*)(WSP(bf16_t, WS_WOUTE) + ((size_t)e * 1024 + n) * KOE + 512 + h * 256 + c8 * 8) = o; }
        }
    }
    const int gt = blockIdx.x * 512 + F.tid, NT = F.G * 512;
    for (int idx = gt; idx < 2 * 256 * 384; idx += NT) {
        const int k = idx % 384, cc = (idx / 384) & 255, e = idx / (384 * 256), hh = cc >> 6, w6 = cc & 63, g = w6 >> 3, i = w6 & 7, sj = i < 4 ? 4 * g + i : 32 + 4 * g + (i - 4);
        const float v = IN_F(13)[(size_t)(e * 384 + k) * 768 + hh * 192 + 128 + sj] * IN_F(12)[e * 384 + k] * QSCALE;
        WSP(bf16_t, WS_WQ2)[((size_t)e * NQ2 + 1024 + cc) * 384 + k] = (bf16_t)(cvt_pk_bf16(v, 0.f) & 0xffffu); }
    for (int idx = gt; idx < 2 * 8 * 1024; idx += NT) {
        const int k = idx & 1023, jp = (idx >> 10) & 7, o = idx >> 13; const f32x4* ar = (const f32x4*)(IN_F(18) + (size_t)(o * 1024 + k) * 3088 + 3072);
        const f32x4 a0 = ar[0], a1 = ar[1], a2 = ar[2], a3 = ar[3]; const float gn = IN_F(6)[(2 * o + 1) * 1024 + k];
        const float av[16] = {a0[0], a0[1], a0[2], a0[3], a1[0], a1[1], a1[2], a1[3], a2[0], a2[1], a2[2], a2[3], a3[0], a3[1], a3[2], a3[3]};
#pragma unroll 4
        for (int j = jp * 64; j < jp * 64 + 64; ++j) { float s = 0.f;
#pragma unroll
            for (int r = 0; r < 16; ++r) s += av[r] * IN_F(19)[(size_t)(o * 16 + r) * 512 + j];
            WSP(bf16_t, WS_WINO)[((size_t)o * NO1 + 3072 + j) * 1024 + k] = (bf16_t)(cvt_pk_bf16(s * gn, 0.f) & 0xffffu); } }
    for (int idx = gt; idx < 2 * 64 * 128; idx += NT) {
        const int e = idx >> 13, r = idx & 8191; *(u32x4*)(WSP(bf16_t, WS_WINE) + ((size_t)e * NE1 + 2752) * 1024 + (size_t)r * 8) = (u32x4){0u, 0u, 0u, 0u}; }
    for (int idx = gt; idx < 512; idx += NT) {
        const float a = IN_F(10)[idx], b = IN_F(10)[512 + idx], mx = fmaxf(a, b), ea = __expf(a - mx), eb = __expf(b - mx);
        WSP(float, WS_LBS)[idx] = 0.f; WSP(float, WS_LBS)[512 + idx] = eb / (ea + eb); }
    for (int idx = gt; idx < 2056 * 32; idx += NT) {
        const int j = idx & 31, pi = idx >> 5; const double pos = (double)(pi < SEQ ? pi : PAST + (pi - SEQ));
        const double inv = exp2(-(double)j * (13.287712379549449 / 32.0)), ang = pos * inv, n = rint(ang * 0.15915494309189535), r = ang - n * 6.283185307179586;
        WSP(float, WS_ROPE)[(size_t)pi * 64 + j] = cosf((float)r); WSP(float, WS_ROPE)[(size_t)pi * 64 + 32 + j] = sinf((float)r); }
    for (int m = F.gw; m < NTOK; m += F.NGW) {
        const float* xr = m < NP ? IN_F(0) + (size_t)m * D : IN_F(1) + (size_t)(m - NP) * D; float s = 0.f;
#pragma unroll
        for (int j = 0; j < 4; ++j) { const f32x4 v = *(const f32x4*)(xr + j * 256 + F.lane * 4); s += (v[0] * v[0] + v[1] * v[1]) + (v[2] * v[2] + v[3] * v[3]);
            u32x2 w; w.x = cvt_pk_bf16(v[0], v[1]); w.y = cvt_pk_bf16(v[2], v[3]); *(u32x2*)(WSP(bf16_t, WS_XB) + (size_t)m * D + j * 256 + F.lane * 4) = w; }
        s = wave_sum(s);
        if (F.lane < 16) WSP(float, WS_SSQ)[(size_t)m * 16 + F.lane] = F.lane == 0 ? s : 0.f;
    }
}

__device__ __forceinline__ void finalize_rows(Frame& F, KArgs args, int e) {
    const float* CKV = WSP(float, WS_CKV); const float* KR = WSP(float, WS_KR); bf16_t* KVL = WSP(bf16_t, WS_KVL); const float* rope = WSP(float, WS_ROPE);
    int lane_ = F.lane; asm volatile("" : "+v"(lane_));
    const f32x4 w4 = *(const f32x4*)(IN_F(14) + e * 256 + lane_ * 4);
    for (int r = F.gw; r < NTOK; r += F.NGW) {
        const f32x4 v = *(const f32x4*)(CKV + (size_t)r * 256 + lane_ * 4);
        const float ss = wave_sum((v[0] * v[0] + v[1] * v[1]) + (v[2] * v[2] + v[3] * v[3])), rs = rsqrtf(ss * (1.f / 256.f) + EPS);
        const f32x4 o = v * rs * w4;
        float* od = r < NP ? (args->out + OUT_MRP) + ((size_t)e * NP + r) * LAT : (args->out + OUT_MRS) + ((size_t)e * NS + (r - NP)) * LAT;
        *(f32x4*)(od + lane_ * 4) = o;
        u32x2 w; w.x = cvt_pk_bf16(o[0], o[1]); w.y = cvt_pk_bf16(o[2], o[3]); *(u32x2*)(KVL + (size_t)r * LAT + lane_ * 4) = w;
        if (lane_ < 32) { const float x1 = KR[(size_t)r * 64 + lane_], x2 = KR[(size_t)r * 64 + 32 + lane_]; const float* rp = rope + (size_t)rope_idx(r) * 64;
            const float c = rp[lane_], sn = rp[32 + lane_], a = x1 * c - x2 * sn, b = x1 * sn + x2 * c;
            od[256 + lane_] = a; od[288 + lane_] = b;
            KVL[(size_t)r * LAT + 256 + lane_] = (bf16_t)(cvt_pk_bf16(a, 0.f) & 0xffffu); KVL[(size_t)r * LAT + 288 + lane_] = (bf16_t)(cvt_pk_bf16(b, 0.f) & 0xffffu); }
    }
}

constexpr int KP = 656, KT_BYTES = 64 * KP;
#define NEG_INF (-__builtin_inff())
__device__ __forceinline__ s16x4 tr_read(const LAS unsigned char* p) { return __builtin_amdgcn_ds_read_tr16_b64_v4i16((LAS s16x4*)p); }
__device__ __forceinline__ bf16x8 pack_frag(const f32x4 a, const f32x4 b) { u32x4 w; w.x = cvt_pk_bf16(a[0], a[1]); w.y = cvt_pk_bf16(a[2], a[3]); w.z = cvt_pk_bf16(b[0], b[1]); w.w = cvt_pk_bf16(b[2], b[3]); return __builtin_bit_cast(bf16x8, w); }
__device__ __forceinline__ bf16x8 join_frag(const s16x4 a, const s16x4 b) { return (bf16x8){a[0], a[1], a[2], a[3], b[0], b[1], b[2], b[3]}; }
template <int NKB, int NCB, bool MASK>
__device__ __forceinline__ void attn_tile(const LAS unsigned char* kt, int key0, int cbase, const bf16x8 (&qf)[10], f32x4 (&O)[NCB], float& m, float& l, int lane, int keyabs0, int limit) {
    const int fr = lane & 15, g = lane >> 4;
    f32x4 S[NKB];
#pragma unroll
    for (int kb = 0; kb < NKB; ++kb) { S[kb] = (f32x4){0.f, 0.f, 0.f, 0.f};
        const LAS unsigned char* kr = kt + (key0 + kb * 16 + fr) * KP + g * 16;
#pragma unroll
        for (int ds = 0; ds < 10; ++ds) S[kb] = __builtin_amdgcn_mfma_f32_16x16x32_bf16(*(const LAS bf16x8*)(kr + ds * 64), qf[ds], S[kb], 0, 0, 0);
        asm volatile("" ::: "memory"); }
    if constexpr (MASK) {
#pragma unroll
        for (int kb = 0; kb < NKB; ++kb)
#pragma unroll
            for (int i = 0; i < 4; ++i) if (keyabs0 + key0 + kb * 16 + 4 * g + i > limit) S[kb][i] = NEG_INF;
    }
    float mx = NEG_INF;
#pragma unroll
    for (int kb = 0; kb < NKB; ++kb) mx = fmaxf(fmaxf(mx, fmaxf(S[kb][0], S[kb][1])), fmaxf(S[kb][2], S[kb][3]));
    mx = fmaxf(mx, __shfl_xor(mx, 16)); mx = fmaxf(mx, __shfl_xor(mx, 32));
    const float mn = fmaxf(m, mx), mu = (mn == NEG_INF) ? 0.f : mn, alpha = fexp2(m - mu);
    float ls = 0.f;
#pragma unroll
    for (int kb = 0; kb < NKB; ++kb)
#pragma unroll
        for (int i = 0; i < 4; ++i) { const float p = fexp2(S[kb][i] - mu); S[kb][i] = p; ls += p; }
    l = l * alpha + ls; m = mn;
#pragma unroll
    for (int cb = 0; cb < NCB; ++cb) O[cb] = O[cb] * alpha;
#pragma unroll
    for (int p2 = 0; p2 < NKB / 2; ++p2) {
        const bf16x8 pf = pack_frag(S[2 * p2], S[2 * p2 + 1]);
        const LAS unsigned char* vr = kt + (key0 + 32 * p2 + 4 * g + (fr >> 2)) * KP + (cbase + 4 * (fr & 3)) * 2;
#pragma unroll
        for (int cb = 0; cb < NCB; ++cb) { const bf16x8 a = join_frag(tr_read(vr + cb * 32), tr_read(vr + cb * 32 + 16 * KP)); O[cb] = __builtin_amdgcn_mfma_f32_16x16x32_bf16(a, pf, O[cb], 0, 0, 0);
            if ((cb & 3) == 3) asm volatile("" ::: "memory"); }
    }
}
__device__ __forceinline__ void attn_prompt_unit(Frame& F, int b, int qb) {
    const bf16_t* KVL = WSP(bf16_t, WS_KVL); const bf16_t* QL = WSP(bf16_t, WS_QL); bf16_t* OA = WSP(bf16_t, WS_OA);
    int tid_ = F.tid; asm volatile("" : "+v"(tid_));
    const int w = F.wave, lane = tid_ & 63, fr = lane & 15, g = lane >> 4, h = w & 3, half = w >> 2;
    const int pos = 32 * qb + 16 * half + fr, row = b * SEQ + pos;
    bf16x8 qf[10];
#pragma unroll
    for (int ds = 0; ds < 10; ++ds) qf[ds] = *(const bf16x8*)(QL + (size_t)row * QL_LD + h * LAT + ds * 32 + g * 8);
    f32x4 O[16];
#pragma unroll
    for (int cb = 0; cb < 16; ++cb) O[cb] = (f32x4){0.f, 0.f, 0.f, 0.f};
    float m = NEG_INF, l = 0.f;
    const int ntiles = (qb >> 1) + 1;
    const u32x4* src = (const u32x4*)(KVL + (size_t)b * SEQ * LAT);
    u32x4 st[5];
#define PA_LOAD(kt) do { _Pragma("unroll") for (int i = 0; i < 5; ++i) st[i] = src[(size_t)(kt) * 2560 + tid_ + 512 * i]; } while (0)
#define PA_WRITE(buf) do { _Pragma("unroll") for (int i = 0; i < 5; ++i) { const int ch = tid_ + 512 * i, key = ch / 40, c16 = ch % 40; *(LAS u32x4*)(F.lds + (buf) * KT_BYTES + key * KP + c16 * 16) = st[i]; } } while (0)
    PA_LOAD(0); PA_WRITE(0); __syncthreads();
    for (int kt = 0; kt < ntiles; ++kt) {
        if (kt + 1 < ntiles) PA_LOAD(kt + 1);
        const LAS unsigned char* kb = F.lds + (kt & 1) * KT_BYTES;
        attn_tile<4, 16, true>(kb, 0, 0, qf, O, m, l, lane, 64 * kt, pos);
        if (kt + 1 < ntiles) PA_WRITE((kt + 1) & 1);
        __syncthreads();
    }
#undef PA_LOAD
#undef PA_WRITE
    l += __shfl_xor(l, 16); l += __shfl_xor(l, 32);
    const float inv = 1.f / l;
    bf16_t* dst = OA + (size_t)row * KOE + 512 + h * 256 + 4 * g;
#pragma unroll
    for (int cb = 0; cb < 16; ++cb) { const f32x4 o = O[cb] * inv; u32x2 wv; wv.x = cvt_pk_bf16(o[0], o[1]); wv.y = cvt_pk_bf16(o[2], o[3]); *(u32x2*)(dst + cb * 16) = wv; }
}
__device__ __forceinline__ void attn_decode_unit(Frame& F, KArgs args, int e, int bd, int sp) {
    const bf16_t* KVL = WSP(bf16_t, WS_KVL); const bf16_t* QL = WSP(bf16_t, WS_QL); float* PO = WSP(float, WS_PO); float* PML = WSP(float, WS_PML);
    const float* cache = IN_F(2) + (size_t)e * NPHYS * PAGE * LAT;
    int tid_ = F.tid; asm volatile("" : "+v"(tid_));
    const int w = F.wave, lane = tid_ & 63, fr = lane & 15, g = lane >> 4, rg = w & 1, kh = (w >> 1) & 1, ch = w >> 2;
    const int rr = 16 * rg + fr, td = rr >> 2, h = rr & 3, row = NP + bd * DSEQ + td;
    bf16x8 qf[10];
#pragma unroll
    for (int ds = 0; ds < 10; ++ds) qf[ds] = *(const bf16x8*)(QL + (size_t)row * QL_LD + h * LAT + ds * 32 + g * 8);
    f32x4 O[8];
#pragma unroll
    for (int cb = 0; cb < 8; ++cb) O[cb] = (f32x4){0.f, 0.f, 0.f, 0.f};
    float m = NEG_INF, l = 0.f;
    constexpr int PPS = NPAGES / NSPLIT, NT = 2 * PPS;
    f32x4 st[10];
#define DA_LOAD(t) do { const int pg = ((const int*)args->in[5])[bd * NPAGES + sp * PPS + ((t) >> 1)]; const f32x4* bp = (const f32x4*)(cache + ((size_t)pg * PAGE + ((t) & 1) * 64) * LAT); \
        _Pragma("unroll") for (int i = 0; i < 10; ++i) st[i] = __builtin_nontemporal_load(bp + tid_ + 512 * i); } while (0)
#define DA_WRITE(buf) do { _Pragma("unroll") for (int i = 0; i < 10; ++i) { const int idx = tid_ + 512 * i, key = idx / 80, d4 = idx % 80; u32x2 wv; wv.x = cvt_pk_bf16(st[i][0], st[i][1]); wv.y = cvt_pk_bf16(st[i][2], st[i][3]); \
        *(LAS u32x2*)(F.lds + (buf) * KT_BYTES + key * KP + d4 * 8) = wv; } } while (0)
    DA_LOAD(0); DA_WRITE(0); __syncthreads();
    for (int t = 0; t < NT; ++t) {
        if (t + 1 < NT) DA_LOAD(t + 1);
        attn_tile<2, 8, false>(F.lds + (t & 1) * KT_BYTES, 32 * kh, 128 * ch, qf, O, m, l, lane, 0, 0);
        if (t + 1 < NT) DA_WRITE((t + 1) & 1);
        __syncthreads();
    }
#undef DA_LOAD
#undef DA_WRITE
    if (sp == NSPLIT - 1) {
        for (int i = tid_; i < 320 + 24 * 41; i += 512) {
            if (i < 320) { const int key = i / 40, c16 = i % 40; *(LAS u32x4*)(F.lds + key * KP + c16 * 16) = *(const u32x4*)(KVL + (size_t)(NP + bd * DSEQ + key) * LAT + c16 * 8); }
            else { const int j = i - 320; *(LAS u32x4*)(F.lds + 8 * KP + j * 16) = (u32x4){0u, 0u, 0u, 0u}; }
        }
        __syncthreads();
        if (kh == 0) attn_tile<2, 8, true>(F.lds, 0, 128 * ch, qf, O, m, l, lane, PAST, PAST + td);
        __syncthreads();
    }
    l += __shfl_xor(l, 16); l += __shfl_xor(l, 32);
    const int se = sp * 2 + kh; const size_t pr = ((size_t)(bd * NSE + se) * 32 + rr);
#pragma unroll
    for (int cb = 0; cb < 8; ++cb) *(f32x4*)(PO + pr * 256 + 128 * ch + 16 * cb + 4 * g) = O[cb];
    if (ch == 0 && g == 0) { PML[pr * 2] = m; PML[pr * 2 + 1] = l; }
}
__device__ __forceinline__ void attn_decode_combine(Frame& F) {
    const float* PO = WSP(float, WS_PO); const float* PML = WSP(float, WS_PML); bf16_t* OA = WSP(bf16_t, WS_OA);
    for (int r = F.gw; r < 32 * 32; r += F.NGW) {
        const int bd = r >> 5, rr = r & 31, td = rr >> 2, h = rr & 3;
        float mm = NEG_INF, ll = 0.f;
        if (F.lane < NSE) { const size_t pr = ((size_t)(bd * NSE + F.lane) * 32 + rr); mm = PML[pr * 2]; ll = PML[pr * 2 + 1]; }
        float M = mm;
#pragma unroll
        for (int o = 1; o < 64; o <<= 1) M = fmaxf(M, __shfl_xor(M, o));
        const float wgt = (F.lane < NSE) ? fexp2(mm - M) : 0.f; const float L = wave_sum(wgt * ll);
        f32x4 acc = (f32x4){0.f, 0.f, 0.f, 0.f};
        for (int se = 0; se < NSE; ++se) { const float ws_ = __shfl(wgt, se); acc = acc + *(const f32x4*)(PO + ((size_t)(bd * NSE + se) * 32 + rr) * 256 + F.lane * 4) * ws_; }
        const float inv = 1.f / L; u32x2 wv; wv.x = cvt_pk_bf16(acc[0] * inv, acc[1] * inv); wv.y = cvt_pk_bf16(acc[2] * inv, acc[3] * inv);
        *(u32x2*)(OA + (size_t)(NP + bd * DSEQ + td) * KOE + 512 + h * 256 + F.lane * 4) = wv;
    }
}

template <int NV, int INIT, bool FULL>
__device__ __forceinline__ void scan_unit(Frame& F, const float* nw, const float* s0, float* sout, float* segH, float* segD, int nprev, int ldo, int row0, int T, int h) {
    constexpr int VD = 128 * NV, LDV = 4 * VD, PV = 2 * VD + 16, PQ = 272, PK = 144;
    constexpr int O_QT0 = 0, O_QH = 64 * PQ, O_KH = 2 * 64 * PQ, O_KLT = 3 * 64 * PQ, O_VT = O_KLT + 128 * PK, O_DEC = O_VT + 64 * PV, O_XS = O_DEC + 512, O_NRM = O_XS + 8192;
    constexpr size_t SEGSZ = (size_t)128 * VD;
    static_assert(O_NRM + 2048 <= RING_BYTES, "scan LDS");
    const bf16_t* Qh = WSP(bf16_t, WS_QH); const bf16_t* KK = WSP(bf16_t, WS_KK); const float* LOGF = WSP(float, WS_LOGF); const bf16_t* V = WSP(bf16_t, WS_V); const bf16_t* G = WSP(bf16_t, WS_G); bf16_t* OA = WSP(bf16_t, WS_OA);
    LAS unsigned char* lds = F.lds;
    int tid = F.tid; asm volatile("" : "+v"(tid));
    const int w = F.wave, lane = tid & 63, fr = lane & 15, g = lane >> 4;
    f32x4 S[8][NV];
#pragma unroll
    for (int kb = 0; kb < 8; ++kb)
#pragma unroll
        for (int nv = 0; nv < NV; ++nv) {
            if constexpr (INIT == 1) { const float* sp = s0 + (size_t)(16 * kb + 4 * g) * VD + (w * NV + nv) * 16 + fr;
                const float a0 = sp[0], a1 = sp[VD], a2 = sp[2 * VD], a3 = sp[3 * VD]; S[kb][nv] = (f32x4){a0, a1, a2, a3}; }
            else S[kb][nv] = (f32x4){0.f, 0.f, 0.f, 0.f};
        }
    if constexpr (INIT == 2) {
        for (int j = 0; j < nprev; ++j) {
            const f32x4* hp = (const f32x4*)(segH + (size_t)j * SEGSZ) + (size_t)w * (8 * NV) * 64 + lane; const float* dp = segD + j * 128 + 4 * g;
#pragma unroll
            for (int kb = 0; kb < 8; ++kb) { const f32x4 d4 = *(const f32x4*)(dp + 16 * kb);
#pragma unroll
                for (int nv = 0; nv < NV; ++nv) S[kb][nv] = S[kb][nv] * d4 + hp[(kb * NV + nv) * 64]; }
        }
    }
    f32x4 segsum = (f32x4){0.f, 0.f, 0.f, 0.f};
    for (int c0 = 0; c0 < T; c0 += 64) {
        {
            const int k4 = (tid & 31) * 4, ts = tid >> 5, t0 = 4 * ts;
            const size_t rbase = (size_t)(row0 + c0 + t0) * 512 + h * 128 + k4;
            f32x4 bl[4]; u32x2 qw[4], kw[4]; f32x4 run = (f32x4){0.f, 0.f, 0.f, 0.f};
#pragma unroll
            for (int i = 0; i < 4; ++i) { const bool ok = c0 + t0 + i < T; f32x4 lf = (f32x4){0.f, 0.f, 0.f, 0.f}; qw[i] = (u32x2){0u, 0u}; kw[i] = (u32x2){0u, 0u};
                if (ok) { lf = *(const f32x4*)(LOGF + rbase + (size_t)i * 512); if constexpr (FULL) qw[i] = *(const u32x2*)(Qh + rbase + (size_t)i * 512); kw[i] = *(const u32x2*)(KK + rbase + (size_t)i * 512); }
                run = run + lf; bl[i] = run; }
            *(LAS f32x4*)(lds + O_XS + (ts * 128 + k4) * 4) = run;
#pragma unroll
            for (int j = 0; j < 2 * NV; ++j) { const int chn = tid + 512 * j, s = chn / (VD / 8), cc = chn % (VD / 8); u32x4 val = (u32x4){0u, 0u, 0u, 0u};
                if (c0 + s < T) val = *(const u32x4*)(V + (size_t)(row0 + c0 + s) * LDV + h * VD + cc * 8);
                *(LAS u32x4*)(lds + O_VT + s * PV + cc * 16) = val; }
            __syncthreads();
            f32x4 pre = (f32x4){0.f, 0.f, 0.f, 0.f}, b31 = pre, bL = pre;
#pragma unroll
            for (int s = 0; s < 16; ++s) { const f32x4 x = *(const LAS f32x4*)(lds + O_XS + (s * 128 + k4) * 4); if (s < ts) pre = pre + x; if (s < 8) b31 = b31 + x; bL = bL + x; }
            f32x4 klv[4];
#pragma unroll
            for (int i = 0; i < 4; ++i) {
                const f32x4 b = pre + bl[i]; f32x4 k, eL;
                k[0] = bflo(kw[i].x); k[1] = bfhi(kw[i].x); k[2] = bflo(kw[i].y); k[3] = bfhi(kw[i].y);
#pragma unroll
                for (int c = 0; c < 4; ++c) eL[c] = fexp(bL[c] - b[c]);
                klv[i] = k * eL;
                if constexpr (FULL) {
                    f32x4 q, e0, em, ek;
                    q[0] = bflo(qw[i].x); q[1] = bfhi(qw[i].x); q[2] = bflo(qw[i].y); q[3] = bfhi(qw[i].y);
#pragma unroll
                    for (int c = 0; c < 4; ++c) { e0[c] = fexp(b[c]); em[c] = fexp(b[c] - b31[c]); ek[c] = fexp(b31[c] - b[c]); }
                    const f32x4 a0 = q * e0, a1 = q * em, a2 = k * ek;
                    const int ro = (t0 + i) * PQ + k4 * 2;
                    *(LAS u32x2*)(lds + O_QT0 + ro) = (u32x2){cvt_pk_bf16(a0[0], a0[1]), cvt_pk_bf16(a0[2], a0[3])};
                    *(LAS u32x2*)(lds + O_QH + ro) = (u32x2){cvt_pk_bf16(a1[0], a1[1]), cvt_pk_bf16(a1[2], a1[3])};
                    *(LAS u32x2*)(lds + O_KH + ro) = (u32x2){cvt_pk_bf16(a2[0], a2[1]), cvt_pk_bf16(a2[2], a2[3])};
                }
            }
#pragma unroll
            for (int c = 0; c < 4; ++c) *(LAS u32x2*)(lds + O_KLT + (k4 + c) * PK + t0 * 2) = (u32x2){cvt_pk_bf16(klv[0][c], klv[1][c]), cvt_pk_bf16(klv[2][c], klv[3][c])};
            if (ts == 0) { f32x4 d; d[0] = fexp(bL[0]); d[1] = fexp(bL[1]); d[2] = fexp(bL[2]); d[3] = fexp(bL[3]); *(LAS f32x4*)(lds + O_DEC + k4 * 4) = d; segsum = segsum + bL; }
            __syncthreads();
        }
        f32x4 Oo[4][NV];
        if constexpr (FULL) {
            bf16x8 sB[4][NV];
#pragma unroll
            for (int ks = 0; ks < 4; ++ks)
#pragma unroll
                for (int nv = 0; nv < NV; ++nv) sB[ks][nv] = pack_frag(S[2 * ks][nv], S[2 * ks + 1][nv]);
            bf16x8 vP[2][NV];
#pragma unroll
            for (int p = 0; p < 2; ++p)
#pragma unroll
                for (int nv = 0; nv < NV; ++nv) { const LAS unsigned char* a1 = lds + O_VT + (32 * p + 4 * g + (fr >> 2)) * PV + ((w * NV + nv) * 16 + 4 * (fr & 3)) * 2; vP[p][nv] = join_frag(tr_read(a1), tr_read(a1 + 16 * PV)); }
#pragma unroll
            for (int tb = 0; tb < 4; ++tb) {
                f32x4 X[4];
                {
                    bf16x8 bq[4];
#pragma unroll
                    for (int ks = 0; ks < 4; ++ks) bq[ks] = *(const LAS bf16x8*)(lds + O_QH + (16 * tb + fr) * PQ + ks * 64 + g * 16);
#pragma unroll
                    for (int sb = 0; sb < 4; ++sb) { X[sb] = (f32x4){0.f, 0.f, 0.f, 0.f};
                        if (sb <= tb) {
#pragma unroll
                            for (int ks = 0; ks < 4; ++ks) X[sb] = __builtin_amdgcn_mfma_f32_16x16x32_bf16(*(const LAS bf16x8*)(lds + O_KH + (16 * sb + fr) * PQ + ks * 64 + g * 16), bq[ks], X[sb], 0, 0, 0);
                            if (sb == tb) {
#pragma unroll
                                for (int i = 0; i < 4; ++i) if (4 * g + i > fr) X[sb][i] = 0.f; } } }
                }
#pragma unroll
                for (int nv = 0; nv < NV; ++nv) Oo[tb][nv] = (f32x4){0.f, 0.f, 0.f, 0.f};
#pragma unroll
                for (int p = 0; p < 2; ++p) if (p <= (tb >> 1)) {
                    const bf16x8 pf = pack_frag(X[2 * p], X[2 * p + 1]);
#pragma unroll
                    for (int nv = 0; nv < NV; ++nv) Oo[tb][nv] = __builtin_amdgcn_mfma_f32_16x16x32_bf16(pf, vP[p][nv], Oo[tb][nv], 0, 0, 0);
                }
#pragma unroll
                for (int ks = 0; ks < 4; ++ks) {
                    const LAS unsigned char* qa = lds + O_QT0 + (16 * tb + fr) * PQ + (32 * ks + 4 * g) * 2;
                    const u32x2 q0 = *(const LAS u32x2*)qa, q1 = *(const LAS u32x2*)(qa + 32);
                    const bf16x8 aq = __builtin_bit_cast(bf16x8, (u32x4){q0.x, q0.y, q1.x, q1.y});
#pragma unroll
                    for (int nv = 0; nv < NV; ++nv) Oo[tb][nv] = __builtin_amdgcn_mfma_f32_16x16x32_bf16(aq, sB[ks][nv], Oo[tb][nv], 0, 0, 0);
                }
                asm volatile("" ::: "memory");
            }
        }
        bf16x8 vN[2][NV];
#pragma unroll
        for (int p = 0; p < 2; ++p)
#pragma unroll
            for (int nv = 0; nv < NV; ++nv) { const LAS unsigned char* a2 = lds + O_VT + (32 * p + 8 * g + (fr >> 2)) * PV + ((w * NV + nv) * 16 + 4 * (fr & 3)) * 2; vN[p][nv] = join_frag(tr_read(a2), tr_read(a2 + 4 * PV)); }
#pragma unroll
        for (int kb = 0; kb < 8; ++kb) {
            const f32x4 d4 = *(const LAS f32x4*)(lds + O_DEC + (16 * kb + 4 * g) * 4);
#pragma unroll
            for (int nv = 0; nv < NV; ++nv) S[kb][nv] = S[kb][nv] * d4;
#pragma unroll
            for (int p = 0; p < 2; ++p) { const bf16x8 a = *(const LAS bf16x8*)(lds + O_KLT + (16 * kb + fr) * PK + p * 64 + g * 16);
#pragma unroll
                for (int nv = 0; nv < NV; ++nv) S[kb][nv] = __builtin_amdgcn_mfma_f32_16x16x32_bf16(a, vN[p][nv], S[kb][nv], 0, 0, 0); }
        }
        if constexpr (FULL) {
#pragma unroll
            for (int tb = 0; tb < 4; ++tb)
#pragma unroll
                for (int i = 0; i < 4; ++i) { float ss = 0.f;
#pragma unroll
                    for (int nv = 0; nv < NV; ++nv) ss += Oo[tb][nv][i] * Oo[tb][nv][i];
                    ss += __shfl_xor(ss, 1); ss += __shfl_xor(ss, 2); ss += __shfl_xor(ss, 4); ss += __shfl_xor(ss, 8);
                    if (fr == 0) ((LAS float*)(lds + O_NRM))[(16 * tb + 4 * g + i) * 8 + w] = ss; }
            __syncthreads();
#pragma unroll
            for (int tb = 0; tb < 4; ++tb)
#pragma unroll
                for (int i = 0; i < 4; ++i) { const int tl = 16 * tb + 4 * g + i; const LAS f32x4* np = (const LAS f32x4*)(lds + O_NRM + tl * 32); const f32x4 n0 = np[0], n1 = np[1];
                    const float rs = rsqrtf(((n0[0] + n0[1]) + (n0[2] + n0[3]) + (n1[0] + n1[1]) + (n1[2] + n1[3])) * (1.f / VD) + EPS);
                    if (c0 + tl < T) { int ri = row0 + c0 + tl; asm volatile("" : "+v"(ri)); const size_t r = (size_t)ri;
#pragma unroll
                        for (int nv = 0; nv < NV; ++nv) { const int v = (w * NV + nv) * 16 + fr; const float gt = bf2f(G[r * LDV + h * VD + v]);
                            OA[r * ldo + h * VD + v] = (bf16_t)(cvt_pk_bf16(Oo[tb][nv][i] * rs * nw[v] * gt, 0.f) & 0xffffu); } } }
        } else __syncthreads();
    }
    if constexpr (!FULL) {
        f32x4* hp = (f32x4*)segH + (size_t)w * (8 * NV) * 64 + lane;
#pragma unroll
        for (int kb = 0; kb < 8; ++kb)
#pragma unroll
            for (int nv = 0; nv < NV; ++nv) hp[(kb * NV + nv) * 64] = S[kb][nv];
        if ((tid >> 5) == 0) { f32x4 d; d[0] = fexp(segsum[0]); d[1] = fexp(segsum[1]); d[2] = fexp(segsum[2]); d[3] = fexp(segsum[3]); *(f32x4*)(segD + (tid & 31) * 4) = d; }
    } else if (sout) {
#pragma unroll
        for (int kb = 0; kb < 8; ++kb) {
            float* so = sout + (size_t)(16 * kb + 4 * g) * VD + w * NV * 16 + fr; asm volatile("" : "+v"(so));
#pragma unroll
            for (int nv = 0; nv < NV; ++nv)
#pragma unroll
                for (int i = 0; i < 4; ++i) so[i * VD + nv * 16] = S[kb][nv][i];
        }
    }
    __syncthreads();
}
constexpr int N_PHASES = 30;
__device__ __forceinline__ int queue_claim(Frame& F, unsigned* head) {
    __syncthreads();
    if (F.tid == 0) F.MISC[16] = __hip_atomic_fetch_add(head, 1u, __ATOMIC_RELAXED, __HIP_MEMORY_SCOPE_AGENT);
    __syncthreads();
    return (int)F.MISC[16];
}
__global__ void __launch_bounds__(512, 2) mega_fwd(Args args_byval) {
    KArgs args = (KArgs)__builtin_amdgcn_kernarg_segment_ptr(); (void)args_byval;
    extern __shared__ __attribute__((aligned(16))) unsigned char lds_raw[];
    Frame F;
    F.lds = (LAS unsigned char*)lds_raw; F.MISC = (volatile LAS unsigned*)(F.lds + MISC_OFF);
    F.tid = threadIdx.x; F.lane = F.tid & 63; F.wave = __builtin_amdgcn_readfirstlane(F.tid >> 6); F.G = gridDim.x; F.gw = blockIdx.x * 8 + F.wave; F.NGW = F.G * 8;
    F.ws = args->ws; F.ctl = (unsigned*)(args->ws + WS_CTL);
    for (int u = F.tid; u < (LDS_BYTES - MISC_OFF) / 4; u += 512) ((LAS unsigned*)(F.lds + MISC_OFF))[u] = 0u;
    __syncthreads();
    const int lo = args->ph_lo, hi = args->ph_hi;
    XcdBarrier bar; bar.bar = F.ctl + CW_BAR; bar.x = 0; bar.st = nullptr;
    if (hi - lo > 1) bar = xcd_barrier_post(F.ctl + CW_BAR, F.MISC + 8);
#ifdef MK_ONLY
#define INC(k, c) ((c) == MK_ONLY && lo <= (k) && (k) < hi)
#else
#define INC(k, c) (lo <= (k) && (k) < hi)
#endif
#define SEAM(k) do { if (hi > (k) + 1) xcd_barrier(bar); } while (0)

    const RowScale rsX{WSP(float, WS_SSQ), 16, 4, 1.f / 1024.f};
    const RowScale rsQ{WSP(float, WS_SSQCQ), 16, 3, 1.f / 384.f};
    const RowScale rsNone{nullptr, 0, 0, 0.f};

    if (INC(0, 0)) { asm volatile("" : "+s"(F.ws), "+s"(args)); p0_prologue(F, args); SEAM(0); }

    for (int l = 0; l < 4; ++l) {
        const int pb = 1 + 7 * l, eo = l >> 1;
        const float* resP = l == 0 ? IN_F(0) : WSP(float, WS_X); const float* resS = l == 0 ? IN_F(1) : WSP(float, WS_X) + (size_t)NP * D;
        if ((l & 1) == 0) {
            if (INC(pb, 1)) { asm volatile("" : "+s"(F.ws), "+s"(args));
                Gemm g{WSP(bf16_t, WS_XB), WSP(bf16_t, WS_WINE) + (size_t)eo * NE1 * 1024, 1024, 1024, NTOK, NE1, 1024}; StaticOrder S; S.init(NTOK, NE1, F.G, (int)blockIdx.x);
                EpiInEven E{WSP(bf16_t, WS_QH), WSP(bf16_t, WS_KK), WSP(float, WS_LOGF), WSP(bf16_t, WS_V), WSP(bf16_t, WS_G), WSP(float, WS_CKV), WSP(float, WS_KR), WSP(bf16_t, WS_CQ), WSP(float, WS_SSQCQ), WSP(float, WS_LBS) + eo * 512};
                gemm_phase<EpiInEven, true>(F.lds, g, S, E, rsX);
                SEAM(pb);
            }
            if (INC(pb + 1, 2)) { asm volatile("" : "+s"(F.ws), "+s"(args));
#ifndef MK_NOFIN
                finalize_rows(F, args, eo);
#endif
                Gemm g{WSP(bf16_t, WS_CQ), WSP(bf16_t, WS_WQ2) + (size_t)eo * NQ2 * 384, 384, 384, NTOK, NQ2, 384}; StaticOrder S; S.init(NTOK, NQ2, F.G, (int)blockIdx.x);
                EpiQ2 E{WSP(bf16_t, WS_QL), WSP(float, WS_ROPE)};
                gemm_phase<EpiQ2, true>(F.lds, g, S, E, rsQ);
                {
                    unsigned* head = F.ctl + CW_QUEUE + 64 * (l + 4 + 16 * args->qrep);
                    for (;;) { const int u = queue_claim(F, head); if (u >= 256) break; const int bh = u >> 3, seg = u & 7;
                        scan_unit<1, 0, false>(F, nullptr, nullptr, nullptr, WSP(float, WS_SEGH) + (size_t)(bh * 8 + seg) * 128 * 128, WSP(float, WS_SEGD) + (bh * 8 + seg) * 128, 0, KOE, (bh >> 2) * SEQ + seg * 256, 256, bh & 3); }
                }
                SEAM(pb + 1);
            }
            if (INC(pb + 2, 3)) { asm volatile("" : "+s"(F.ws), "+s"(args));
                unsigned* head = F.ctl + CW_QUEUE + 64 * (l + 16 * args->qrep);
                for (;;) {
                    const int u = queue_claim(F, head);
                    if (u >= 256 + 1024 + 128) break;
                    if (u < 256) { const int seg = 7 - (u >> 5), bh = u & 31;
                        scan_unit<1, 2, true>(F, IN_F(11) + eo * 128, nullptr, seg == 7 ? (args->out + OUT_HSP) + ((size_t)(eo * 32 + bh)) * 128 * 128 : nullptr,
                                              WSP(float, WS_SEGH) + (size_t)(bh * 8) * 128 * 128, WSP(float, WS_SEGD) + (bh * 8) * 128, seg, KOE, (bh >> 2) * SEQ + seg * 256, 256, bh & 3); }
                    else if (u < 256 + 1024) { const int j = u - 256, i = j >> 1;
                        if ((j & 1) == 0) attn_decode_unit(F, args, eo, i & 31, i >> 5);
                        else attn_prompt_unit(F, i & 7, 63 - (i >> 3)); }
                    else { const int j = u - 1280, bd = j >> 2, h = j & 3;
                        scan_unit<1, 1, true>(F, IN_F(11) + eo * 128, IN_F(3) + ((size_t)(eo * 32 + bd) * 4 + h) * 128 * 128, (args->out + OUT_HSS) + ((size_t)(eo * 32 + bd) * 4 + h) * 128 * 128, nullptr, nullptr, 0, KOE, NP + bd * DSEQ, DSEQ, h); }
                }
                SEAM(pb + 2);
            }
            if (INC(pb + 3, 4)) { asm volatile("" : "+s"(F.ws), "+s"(args)); attn_decode_combine(F); SEAM(pb + 3); }
            if (INC(pb + 4, 5)) { asm volatile("" : "+s"(F.ws), "+s"(args));
                Gemm g{WSP(bf16_t, WS_OA), WSP(bf16_t, WS_WOUTE) + (size_t)eo * 1024 * KOE, KOE, KOE, NTOK, 1024, KOE}; StaticOrder S; S.init(NTOK, 1024, F.G, (int)blockIdx.x);
                EpiOutRes E{resP, resS, WSP(float, WS_X), WSP(bf16_t, WS_XB), WSP(float, WS_SSQ)};
                gemm_phase<EpiOutRes, false>(F.lds, g, S, E, rsNone);
                SEAM(pb + 4);
            }
        } else {
            if (INC(pb, 6)) { asm volatile("" : "+s"(F.ws), "+s"(args));
                Gemm g{WSP(bf16_t, WS_XB), WSP(bf16_t, WS_WINO) + (size_t)eo * NO1 * 1024, 1024, 1024, NTOK, NO1, 1024}; StaticOrder S; S.init(NTOK, NO1, F.G, (int)blockIdx.x);
                EpiInOdd E{WSP(bf16_t, WS_QH), WSP(bf16_t, WS_KK), WSP(bf16_t, WS_V), WSP(bf16_t, WS_G), WSP(float, WS_LOGF), IN_F(20) + eo * 512};
                gemm_phase<EpiInOdd, true>(F.lds, g, S, E, rsX);
                SEAM(pb);
            }
            if (INC(pb + 1, 12)) { asm volatile("" : "+s"(F.ws), "+s"(args));
                unsigned* head = F.ctl + CW_QUEUE + 64 * (l + 4 + 16 * args->qrep);
                for (;;) { const int u = queue_claim(F, head); if (u >= 256) break; const int bh = u >> 3, seg = u & 7;
                    scan_unit<2, 0, false>(F, nullptr, nullptr, nullptr, WSP(float, WS_SEGH) + (size_t)(bh * 8 + seg) * 128 * 256, WSP(float, WS_SEGD) + (bh * 8 + seg) * 128, 0, 1024, (bh >> 2) * SEQ + seg * 256, 256, bh & 3); }
                SEAM(pb + 1);
            }
            if (INC(pb + 2, 7)) { asm volatile("" : "+s"(F.ws), "+s"(args));
                unsigned* head = F.ctl + CW_QUEUE + 64 * (l + 16 * args->qrep);
                for (;;) {
                    const int u = queue_claim(F, head);
                    if (u >= 256 + 128) break;
                    if (u < 256) { const int seg = 7 - (u >> 5), bh = u & 31;
                        scan_unit<2, 2, true>(F, IN_F(21) + eo * 256, nullptr, seg == 7 ? (args->out + OUT_GSP) + ((size_t)(eo * 32 + bh)) * 128 * 256 : nullptr,
                                              WSP(float, WS_SEGH) + (size_t)(bh * 8) * 128 * 256, WSP(float, WS_SEGD) + (bh * 8) * 128, seg, 1024, (bh >> 2) * SEQ + seg * 256, 256, bh & 3); }
                    else { const int j = u - 256, bd = j >> 2, h = j & 3;
                        scan_unit<2, 1, true>(F, IN_F(21) + eo * 256, IN_F(4) + ((size_t)(eo * 32 + bd) * 4 + h) * 128 * 256, (args->out + OUT_GSS) + ((size_t)(eo * 32 + bd) * 4 + h) * 128 * 256, nullptr, nullptr, 0, 1024, NP + bd * DSEQ, DSEQ, h); }
                }
                SEAM(pb + 2);
            }
            if (INC(pb + 4, 8)) { asm volatile("" : "+s"(F.ws), "+s"(args));
                Gemm g{WSP(bf16_t, WS_OA), WSP(bf16_t, WS_WOUTO) + (size_t)eo * 1024 * 1024, 1024, 1024, NTOK, 1024, 1024}; StaticOrder S; S.init(NTOK, 1024, F.G, (int)blockIdx.x);
                EpiOutRes E{resP, resS, WSP(float, WS_X), WSP(bf16_t, WS_XB), WSP(float, WS_SSQ)};
                gemm_phase<EpiOutRes, false>(F.lds, g, S, E, rsNone);
                SEAM(pb + 4);
            }
        }
        if (INC(pb + 5, 9)) { asm volatile("" : "+s"(F.ws), "+s"(args));
            Gemm g{WSP(bf16_t, WS_XB), WSP(bf16_t, WS_WUP) + (size_t)l * FF * 1024, 1024, 1024, NTOK, FF, 1024}; StaticOrder S; S.init(NTOK, FF, F.G, (int)blockIdx.x);
            EpiUp E{WSP(bf16_t, WS_FFB)};
            gemm_phase<EpiUp, true>(F.lds, g, S, E, rsX);
            SEAM(pb + 5);
        }
        if (INC(pb + 6, 10)) { asm volatile("" : "+s"(F.ws), "+s"(args));
            Gemm g{WSP(bf16_t, WS_FFB), WSP(bf16_t, WS_WDOWN) + (size_t)l * 1024 * FF, FF, FF, NTOK, 1024, FF}; StaticOrder S; S.init(NTOK, 1024, F.G, (int)blockIdx.x);
            EpiOutRes E{WSP(float, WS_X), WSP(float, WS_X) + (size_t)NP * D, WSP(float, WS_X), WSP(bf16_t, WS_XB), WSP(float, WS_SSQ)};
            gemm_phase<EpiOutRes, false>(F.lds, g, S, E, rsNone);
            SEAM(pb + 6);
        }
    }
    if (INC(29, 11)) { asm volatile("" : "+s"(F.ws), "+s"(args));
        const float* X = WSP(float, WS_X); const float* SSQ = WSP(float, WS_SSQ);
        for (int m = F.gw; m < NTOK; m += F.NGW) {
            const f32x4* sp = (const f32x4*)(SSQ + (size_t)m * 16); const f32x4 s0 = sp[0], s1 = sp[1], s2 = sp[2], s3 = sp[3];
            const float ss = ((s0[0] + s0[1]) + (s0[2] + s0[3])) + ((s1[0] + s1[1]) + (s1[2] + s1[3])) + ((s2[0] + s2[1]) + (s2[2] + s2[3])) + ((s3[0] + s3[1]) + (s3[2] + s3[3]));
            const float rs = rsqrtf(ss * (1.f / 1024.f) + EPS);
            float* od = m < NP ? (args->out + OUT_YP) + (size_t)m * D : (args->out + OUT_YS) + (size_t)(m - NP) * D;
#pragma unroll
            for (int j = 0; j < 4; ++j) { const int c = j * 256 + F.lane * 4; *(f32x4*)(od + c) = *(const f32x4*)(X + (size_t)m * D + c) * rs * *(const f32x4*)(IN_F(8) + c); }
        }
    }
#undef INC
#undef SEAM
}
#undef WSP
#undef IN_F
}

#ifndef MK_ONE_LAUNCH
#define MK_ONE_LAUNCH 0
#endif
static void mk_launch(void* const* d_in, void* d_out, void* d_ws, size_t ws_size, hipStream_t stream) {
    static int grid = 0;
    if (grid == 0) {
        int dev = 0, cus = 0, per_cu = 0;
        if (ws_size < mk::WS_END) { fprintf(stderr, "kernel_launch: workspace too small (%zu < %zu)\n", ws_size, (size_t)mk::WS_END); grid = -1; return; }
        if (hipGetDevice(&dev) != hipSuccess || hipDeviceGetAttribute(&cus, hipDeviceAttributeMultiprocessorCount, dev) != hipSuccess) { grid = -1; return; }
        if (hipFuncSetAttribute((const void*)mk::mega_fwd, hipFuncAttributeMaxDynamicSharedMemorySize, mk::LDS_BYTES) != hipSuccess) { fprintf(stderr, "kernel_launch: hipFuncSetAttribute failed\n"); grid = -1; return; }
        if (hipOccupancyMaxActiveBlocksPerMultiprocessor(&per_cu, (const void*)mk::mega_fwd, 512, mk::LDS_BYTES) != hipSuccess || per_cu < 1) { fprintf(stderr, "kernel_launch: occupancy query says %d blocks per CU\n", per_cu); }
        (void)hipGetLastError();
        grid = cus;
    }
    if (grid < 0) return;
    (void)hipMemsetAsync((char*)d_ws + mk::WS_CTL, 0, mk::CTL_BYTES, stream);
    mk::Args a{};
    for (int i = 0; i < 25; ++i) a.in[i] = d_in[i];
    a.out = (float*)d_out; a.ws = (unsigned char*)d_ws;
#if MK_ONE_LAUNCH
    a.ph_lo = 0; a.ph_hi = mk::N_PHASES;
    hipLaunchKernelGGL(mk::mega_fwd, dim3(grid), dim3(512), mk::LDS_BYTES, stream, a);
#else
    for (int p = 0; p < mk::N_PHASES; ++p) {
        int cls = p == 0 ? 0 : 11;
        if (p >= 1 && p < 29) { const int l = (p - 1) / 7, k = (p - 1) % 7; if ((l & 1) && k == 3) continue;
            static const int ce[7] = {1, 2, 3, 4, 5, 9, 10}, co[7] = {6, 12, 7, -1, 8, 9, 10}; cls = (l & 1) ? co[k] : ce[k]; }
        const int reps = 1 + ((MK_REPEAT >> cls) & 1);
        for (int r = 0; r < reps; ++r) { a.ph_lo = p; a.ph_hi = p + 1; a.qrep = r;
            hipLaunchKernelGGL(mk::mega_fwd, dim3(grid), dim3(512), mk::LDS_BYTES, stream, a); }
    }
#endif
}

extern "C" void kernel_launch(void* const* d_in, const int* in_sizes, int n_in, void* d_out, int out_size, void* d_ws, size_t ws_size, hipStream_t stream) {
    if (n_in != 25) { fprintf(stderr, "kernel_launch: unexpected n_in %d\n", n_in); return; }
    mk_launch(d_in, d_out, d_ws, ws_size, stream);
}
```

```cpp
#include <hip/hip_runtime.h>
#include <cstdio>
#include <cstdint>
#define MK_ONE_LAUNCH 1
#ifndef MK_REPEAT
#define MK_REPEAT 0
#endif
#define MK_PROBE_PART 7
namespace mk {
#define LAS __attribute__((address_space(3)))
typedef unsigned short bf16_t;
typedef short bf16x8 __attribute__((ext_vector_type(8)));
typedef short s16x4 __attribute__((ext_vector_type(4)));
typedef float f32x4 __attribute__((ext_vector_type(4)));
typedef unsigned u32x4 __attribute__((ext_vector_type(4)));
typedef unsigned u32x2 __attribute__((ext_vector_type(2)));

constexpr int D = 1024, NP = 16384, NS = 256, NTOK = NP + NS, SEQ = 2048, DSEQ = 8, PAST = 16384, PAGE = 128, NPAGES = 128, NPHYS = 5120;
constexpr int FF = 4096, LAT = 320, QL_LD = 1280, NE1 = 2816, NQ2 = 1280, KOE = 1536, NO1 = 3584;
constexpr int NSPLIT = 16, NSE = 2 * NSPLIT;
constexpr float EPS = 1e-6f;
constexpr float QSCALE = 0.07216878364870322f * 1.4426950408889634f;

constexpr size_t MiB = 1u << 20;
constexpr size_t WS_CTL = 0, CTL_BYTES = 2 * MiB;
constexpr size_t WS_WINE = 2 * MiB;
constexpr size_t WS_WQ2 = WS_WINE + 2ull * NE1 * 1024 * 2;
constexpr size_t WS_WOUTE = WS_WQ2 + 2ull * NQ2 * 384 * 2;
constexpr size_t WS_WINO = WS_WOUTE + 2ull * 1024 * KOE * 2;
constexpr size_t WS_WOUTO = WS_WINO + 2ull * NO1 * 1024 * 2;
constexpr size_t WS_WUP = WS_WOUTO + 2ull * 1024 * 1024 * 2;
constexpr size_t WS_WDOWN = WS_WUP + 4ull * FF * 1024 * 2;
constexpr size_t WS_LBS = WS_WDOWN + 4ull * FF * 1024 * 2;
constexpr size_t WS_ROPE = WS_LBS + 4096;
constexpr size_t WS_X = (WS_ROPE + 2056ull * 64 * 4 + 4095) & ~(size_t)4095;
constexpr size_t WS_XB = WS_X + (size_t)NTOK * D * 4;
constexpr size_t WS_SSQ = WS_XB + (size_t)NTOK * D * 2;
constexpr size_t WS_QH = WS_SSQ + (size_t)NTOK * 16 * 4;
constexpr size_t WS_KK = WS_QH + (size_t)NTOK * 512 * 2;
constexpr size_t WS_LOGF = WS_KK + (size_t)NTOK * 512 * 2;
constexpr size_t WS_V = WS_LOGF + (size_t)NTOK * 512 * 4;
constexpr size_t WS_G = WS_V + (size_t)NTOK * 1024 * 2;
constexpr size_t WS_CKV = WS_G + (size_t)NTOK * 1024 * 2;
constexpr size_t WS_KR = WS_CKV + (size_t)NTOK * 256 * 4;
constexpr size_t WS_CQ = WS_KR + (size_t)NTOK * 64 * 4;
constexpr size_t WS_SSQCQ = WS_CQ + (size_t)NTOK * 384 * 2;
constexpr size_t WS_KVL = WS_SSQCQ + (size_t)NTOK * 16 * 4;
constexpr size_t WS_QL = WS_KVL + (size_t)NTOK * LAT * 2;
constexpr size_t WS_OA = WS_QL + (size_t)NTOK * QL_LD * 2;
constexpr size_t WS_FFB = WS_OA + (size_t)NTOK * KOE * 2;
constexpr size_t WS_PO = WS_FFB + (size_t)NTOK * FF * 2;
constexpr size_t WS_PML = WS_PO + 32ull * NSE * 32 * 256 * 4;
constexpr size_t WS_SEGH = WS_PML + 32ull * NSE * 32 * 2 * 4;
constexpr size_t WS_SEGD = WS_SEGH + 32ull * 8 * 128 * 256 * 4;
constexpr size_t WS_END = WS_SEGD + 32ull * 8 * 128 * 4;
constexpr int CW_BAR = 4096;
constexpr int CW_QUEUE = 16384;

constexpr int RING_BYTES = 131072, PRO_BYTES = 8 * 17408  , SCL_OFF = PRO_BYTES  , MISC_OFF = SCL_OFF + 2048, LDS_BYTES = MISC_OFF + 2048;

__device__ __forceinline__ unsigned cvt_pk_bf16(float lo, float hi) { unsigned r; asm volatile("v_cvt_pk_bf16_f32 %0, %1, %2" : "=v"(r) : "v"(lo), "v"(hi)); return r; }
__device__ __forceinline__ float bf2f(bf16_t b) { return __uint_as_float(((unsigned)b) << 16); }
__device__ __forceinline__ float bflo(unsigned w) { return __uint_as_float(w << 16); }
__device__ __forceinline__ float bfhi(unsigned w) { return __uint_as_float(w & 0xffff0000u); }
__device__ __forceinline__ float fexp2(float x) { return __builtin_amdgcn_exp2f(x); }
__device__ __forceinline__ float fexp(float x) { return __builtin_amdgcn_exp2f(x * 1.4426950408889634f); }
__device__ __forceinline__ float frcp(float x) { return __builtin_amdgcn_rcpf(x); }
__device__ __forceinline__ float sigm(float x) { return frcp(1.f + fexp(-x)); }
__device__ __forceinline__ float wave_sum(float v) {
#pragma unroll
    for (int o = 1; o < 64; o <<= 1) v += __shfl_xor(v, o);
    return v;
}
__device__ __forceinline__ int rope_idx(int row) { return row < NP ? (row & (SEQ - 1)) : SEQ + ((row - NP) & (DSEQ - 1)); }

#define XB_TMO      128
#define XB_XCNT(j)  (256  + 64 * (j))
#define XB_XSUB(j)  (1280 + 64 * (j))
#define XB_XGEN(j)  (2304 + 64 * (j))
#define XB_TOP      3328
#define XB_TOPGEN   3392
#define XCD_BAR_WORDS 3456
#define XB_SPIN_CAP (1u << 18)
__device__ __forceinline__ unsigned xb_ld(unsigned* p)              { return __hip_atomic_load(p, __ATOMIC_RELAXED, __HIP_MEMORY_SCOPE_AGENT); }
__device__ __forceinline__ unsigned xb_add(unsigned* p, unsigned v) { return __hip_atomic_fetch_add(p, v, __ATOMIC_RELAXED, __HIP_MEMORY_SCOPE_AGENT); }
__device__ __forceinline__ unsigned xb_xcc_id() { return (unsigned)__builtin_amdgcn_s_getreg((3 << 11) | 20) & 0xFu; }
#define XB_SPIN(cond, bar) do { unsigned _sp = 0; while (cond) { __builtin_amdgcn_s_sleep(1); \
    if ((++_sp & 255u) == 0u) { if (xb_ld(&(bar)[XB_TMO])) break; if (_sp > XB_SPIN_CAP) { atomicAdd(&(bar)[XB_TMO], 1u); break; } } } } while (0)
struct XcdBarrier { unsigned* bar; unsigned x; volatile LAS unsigned* st; };
__device__ __forceinline__ XcdBarrier xcd_barrier_post(unsigned* bar, volatile LAS unsigned* st) {
    XcdBarrier b; b.bar = bar; b.x = xb_xcc_id(); b.st = st;
    if (threadIdx.x == 0) (void)xb_add(&bar[XB_XCNT(b.x)], 1u);
    return b;
}
__device__ __forceinline__ void xcd_barrier_complete(unsigned* bar, unsigned x, unsigned& nloc, unsigned& nx) {
    const unsigned G = gridDim.x * gridDim.y * gridDim.z;
    unsigned sum, cnt, mine, sp = 0u;
    for (;;) {
        sum = 0u; cnt = 0u; mine = 0u;
#pragma unroll
        for (unsigned j = 0; j < 16; ++j) { const unsigned c = xb_ld(&bar[XB_XCNT(j)]); sum += c; cnt += (c > 0u) ? 1u : 0u; mine = (j == x) ? c : mine; }
        if (sum == G) break;
        __builtin_amdgcn_s_sleep(1);
        if ((++sp & 255u) == 0u) { if (xb_ld(&bar[XB_TMO])) break; if (sp > XB_SPIN_CAP) { atomicAdd(&bar[XB_TMO], 1u); break; } }
    }
    nloc = mine > 0u ? mine : 1u; nx = cnt > 0u ? cnt : 1u;
}
__device__ __forceinline__ void xcd_barrier(const XcdBarrier& b) {
    asm volatile("s_waitcnt vmcnt(0)" ::: "memory");
    __syncthreads();
    if (threadIdx.x == 0) {
        unsigned* bar = b.bar;
        __builtin_amdgcn_s_waitcnt(0);
        unsigned nloc = b.st[0], nx = b.st[1];
        if (nloc == 0u) { xcd_barrier_complete(bar, b.x, nloc, nx); b.st[0] = nloc; b.st[1] = nx; }
        const unsigned old = xb_add(&bar[XB_XSUB(b.x)], 1u);
        const unsigned gen = old / nloc;
        if (old + 1u == (gen + 1u) * nloc) {
            __builtin_amdgcn_fence(__ATOMIC_RELEASE, "agent");
            asm volatile("s_waitcnt vmcnt(0)" ::: "memory");
            const unsigned og = xb_add(&bar[XB_TOP], 1u);
            const unsigned tg = og / nx;
            if (og + 1u == (tg + 1u) * nx) xb_add(&bar[XB_TOPGEN], 1u);
            else XB_SPIN(xb_ld(&bar[XB_TOPGEN]) == tg, bar);
            __builtin_amdgcn_fence(__ATOMIC_ACQUIRE, "agent");
            xb_add(&bar[XB_XGEN(b.x)], 1u);
            asm volatile("s_waitcnt vmcnt(0)" ::: "memory");
        } else {
            XB_SPIN(xb_ld(&bar[XB_XGEN(b.x)]) == gen, bar);
            __builtin_amdgcn_fence(__ATOMIC_ACQUIRE, "agent");
            asm volatile("s_waitcnt vmcnt(0)" ::: "memory");
        }
    }
    __syncthreads();
}

constexpr int BM = 256, BK = 64, HALF = 128, HTB = HALF * BK * 2, NXCD = 8, WGM = 8;
__host__ __device__ __forceinline__ int lds_byte(int r, int c) { const int st = (r >> 4) * 2 + (c >> 5), rr = r & 15, cc = c & 31, ob = rr * 64 + cc * 2; return st * 1024 + (ob ^ (((ob >> 9) & 1) << 5)); }
__host__ __device__ __forceinline__ void stage_rc(int b, int& R, int& C) { const int st = b / 1024, sb = b % 1024, swz = sb ^ (((sb >> 9) & 1) << 5); R = (st >> 1) * 16 + swz / 64; C = (st & 1) * 32 + (swz % 64) / 2; }
__host__ __device__ __forceinline__ int perm32(int rho) { const int n = rho >> 4, i = rho & 15; return 8 * (i >> 2) + 4 * n + (i & 3); }
struct Unit { int pm, pn, idx; };
struct Gemm { const bf16_t* A; const bf16_t* Bt; int lda, ldb, M, N, K; };
struct RowScale { const float* part; int stride, np4; float inv_n; };
struct StaticOrder {
    int nM, nN, nwg, G, c;
    __device__ void init(int M, int N, int G_, int c_) { nM = M / BM; nN = N / BM; nwg = nM * nN; G = G_; c = c_; }
    __device__ bool next(int i, Unit& u) const {
        const long L = (long)i * G + c; if (L >= nwg) return false;
        int wgid = (int)L; { const int q = nwg / NXCD, r = nwg % NXCD, xcd = wgid % NXCD, off = wgid / NXCD; wgid = (xcd < r ? xcd * (q + 1) : r * (q + 1) + (xcd - r) * q) + off; }
        const int nig = WGM * nN, gid = wgid / nig, fm = gid * WGM, gsz = (nM - fm) < WGM ? (nM - fm) : WGM;
        u.pm = fm + ((wgid % nig) % gsz); u.pn = (wgid % nig) / gsz; u.idx = i; return true;
    }
};
template <bool SCALE>
__device__ __forceinline__ void rs_fill(LAS unsigned char* ldsbase, const RowScale& rs, const Unit& u, int tid) {
    if constexpr (SCALE) {
        if (tid < 256) {
            const f32x4* p = (const f32x4*)(rs.part + (size_t)(u.pm * BM + tid) * rs.stride); float s = 0.f;
            for (int j = 0; j < rs.np4; ++j) { const f32x4 v = p[j]; s += (v[0] + v[1]) + (v[2] + v[3]); }
            ((LAS float*)(ldsbase + SCL_OFF))[(u.idx & 1) * 256 + tid] = rsqrtf(s * rs.inv_n + EPS);
        }
    }
}
template <class Epi, bool SCALE>
__device__ __forceinline__ void gemm_phase(LAS unsigned char* lds, const Gemm g, const StaticOrder& S, const Epi& E, const RowScale rs) {
    int tid = threadIdx.x; asm volatile("" : "+v"(tid));
    const int wid = __builtin_amdgcn_readfirstlane(tid >> 6), lane = tid & 63, wr = wid >> 2, wc = wid & 3, fr = lane & 15, fq = lane >> 4;
    const int K = g.K, nt = K / BK;
    unsigned voffA[2], voffB[2];
#pragma unroll
    for (int i = 0; i < 2; ++i) { int R, C; stage_rc(tid * 16 + i * 8192, R, C); const int Rb = (R & ~31) + perm32(R & 31);
        voffA[i] = (unsigned)(R * g.lda + C) * 2u; voffB[i] = (unsigned)(Rb * g.ldb + C) * 2u; }
    const size_t kstep = (size_t)(BK * 2);
    const size_t hstepA = (size_t)HALF * g.lda * 2, hstepB = (size_t)HALF * g.ldb * 2;
    const size_t tstepA = 2 * hstepA, tstepB = 2 * hstepB;
    const unsigned ldsw = (unsigned)wid * 1024u;
    const int aoff = lds_byte(wr * 64 + fr, fq * 8), boff = lds_byte(wc * 32 + fr, fq * 8);
#define PG8_SA(b, h) (((b) * 2 + (h)) * HTB)
#define PG8_SB(b, h) ((4 + (b) * 2 + (h)) * HTB)
#define PG8_STAGE(bufoff, gbase, voff) do { _Pragma("unroll") for (int _i = 0; _i < 2; ++_i) \
        __builtin_amdgcn_global_load_lds((const unsigned*)((const char*)(gbase) + (voff)[_i]), (LAS unsigned*)(lds + (bufoff) + ldsw + _i * 8192), 16, 0, 0); } while (0)
#define PG8_LDA(dst, b, h) do { _Pragma("unroll") for (int m = 0; m < 4; ++m) _Pragma("unroll") for (int k = 0; k < 2; ++k) dst[m][k] = *(const LAS bf16x8*)(lds + PG8_SA(b, h) + aoff + m * 2048 + k * 1024); } while (0)
#define PG8_LDB(dst, b, h) do { _Pragma("unroll") for (int n = 0; n < 2; ++n) _Pragma("unroll") for (int k = 0; k < 2; ++k) dst[n][k] = *(const LAS bf16x8*)(lds + PG8_SB(b, h) + boff + n * 2048 + k * 1024); } while (0)
#define PG8_MMA(ai, bj, At, Bt) do { __builtin_amdgcn_s_setprio(1); _Pragma("unroll") for (int m = 0; m < 4; ++m) _Pragma("unroll") for (int n = 0; n < 2; ++n) _Pragma("unroll") for (int k = 0; k < 2; ++k) \
        acc[ai][bj][m][n] = __builtin_amdgcn_mfma_f32_16x16x32_bf16(Bt[n][k], At[m][k], acc[ai][bj][m][n], 0, 0, 0); __builtin_amdgcn_s_setprio(0); } while (0)
#define PG8_WAIT_V(n) asm volatile("s_waitcnt vmcnt(" #n ")" ::: "memory")
#define PG8_WAIT_L(n) asm volatile("s_waitcnt lgkmcnt(" #n ")" ::: "memory")
#define PG8_BAR __builtin_amdgcn_s_barrier()
#define PG8_SCHED __builtin_amdgcn_sched_barrier(0)
    Unit cur, nxt; int ui = 0;
    if (!S.next(0, cur)) return;
    f32x4 acc[2][2][4][2];
#pragma unroll
    for (int a = 0; a < 2; ++a)
#pragma unroll
        for (int b = 0; b < 2; ++b)
#pragma unroll
            for (int m = 0; m < 4; ++m)
#pragma unroll
                for (int n = 0; n < 2; ++n) acc[a][b][m][n] = (f32x4){0.f, 0.f, 0.f, 0.f};
    bf16x8 At[4][2], B0[2][2], B1[2][2];
    const char* cA = (const char*)g.A + (size_t)cur.pm * tstepA; const char* cB = (const char*)g.Bt + (size_t)cur.pn * tstepB;
    rs_fill<SCALE>(lds, rs, cur, tid);
    PG8_STAGE(PG8_SB(0, 0), cB, voffB); PG8_STAGE(PG8_SB(0, 1), cB + hstepB, voffB); PG8_STAGE(PG8_SA(0, 0), cA, voffA); PG8_STAGE(PG8_SA(0, 1), cA + hstepA, voffA);
    if (wr == 1) PG8_BAR;
    PG8_WAIT_V(2); PG8_BAR;
    PG8_STAGE(PG8_SB(1, 0), cB + kstep, voffB); PG8_STAGE(PG8_SA(1, 0), cA + kstep, voffA); PG8_STAGE(PG8_SB(1, 1), cB + hstepB + kstep, voffB);
    PG8_WAIT_V(6); PG8_BAR;
    for (;;) {
        const bool has_next = S.next(ui + 1, nxt);
        const char* nA = has_next ? (const char*)g.A + (size_t)nxt.pm * tstepA : cA; const char* nB = has_next ? (const char*)g.Bt + (size_t)nxt.pn * tstepB : cB;
#pragma unroll 1
        for (int t = 0; t < nt; t += 2) {
            const bool last = (t == nt - 2);
            const char* a1 = cA + (size_t)(t + 1) * kstep;
            const char* a2 = last ? nA : cA + (size_t)(t + 2) * kstep; const char* b2 = last ? nB : cB + (size_t)(t + 2) * kstep;
            const char* a3 = a2 + kstep; const char* b3 = b2 + kstep;
            if (last && has_next) rs_fill<SCALE>(lds, rs, nxt, tid);
            PG8_LDB(B0, 0, 0); PG8_LDB(B1, 0, 1); PG8_SCHED; PG8_LDA(At, 0, 0); PG8_STAGE(PG8_SA(1, 1), a1 + hstepA, voffA);
            PG8_WAIT_V(8); PG8_WAIT_L(0); PG8_BAR; PG8_MMA(0, 0, At, B0); PG8_MMA(0, 1, At, B1); PG8_BAR; PG8_SCHED;
            PG8_LDA(At, 0, 1); PG8_STAGE(PG8_SB(0, 0), b2, voffB); PG8_STAGE(PG8_SB(0, 1), b2 + hstepB, voffB); PG8_STAGE(PG8_SA(0, 0), a2, voffA);
            PG8_WAIT_V(8); PG8_WAIT_L(0); PG8_BAR; PG8_MMA(1, 0, At, B0); PG8_MMA(1, 1, At, B1); PG8_BAR; PG8_SCHED;
            PG8_LDB(B0, 1, 0); PG8_LDB(B1, 1, 1); PG8_SCHED; PG8_LDA(At, 1, 0); PG8_STAGE(PG8_SA(0, 1), a2 + hstepA, voffA);
            PG8_WAIT_V(8); PG8_WAIT_L(0); PG8_BAR; PG8_MMA(0, 0, At, B0); PG8_MMA(0, 1, At, B1); PG8_BAR; PG8_SCHED;
            PG8_LDA(At, 1, 1); PG8_STAGE(PG8_SB(1, 0), b3, voffB); PG8_STAGE(PG8_SB(1, 1), b3 + hstepB, voffB); PG8_STAGE(PG8_SA(1, 0), a3, voffA);
            PG8_WAIT_V(8); PG8_WAIT_L(0); PG8_BAR; PG8_MMA(1, 0, At, B0); PG8_MMA(1, 1, At, B1); PG8_BAR; PG8_SCHED;
        }
        if (wr == 0) PG8_BAR;
        { int fr_ = fr, fq_ = fq; asm volatile("" : "+v"(fr_), "+v"(fq_));
          E(acc, cur, wr, wc, fr_, fq_, (const LAS float*)(lds + SCL_OFF) + (cur.idx & 1) * 256); }
        if (!has_next) break;
#pragma unroll
        for (int a = 0; a < 2; ++a)
#pragma unroll
            for (int b = 0; b < 2; ++b)
#pragma unroll
                for (int m = 0; m < 4; ++m)
#pragma unroll
                    for (int n = 0; n < 2; ++n) acc[a][b][m][n] = (f32x4){0.f, 0.f, 0.f, 0.f};
        cur = nxt; cA = nA; cB = nB; ++ui;
        if (wr == 1) PG8_BAR;
    }
    PG8_WAIT_V(0);
    PG8_BAR;
#undef PG8_SA
#undef PG8_SB
#undef PG8_STAGE
#undef PG8_LDA
#undef PG8_LDB
#undef PG8_MMA
#undef PG8_WAIT_V
#undef PG8_WAIT_L
#undef PG8_BAR
#undef PG8_SCHED
}

#define EPI_ROWS_BEGIN  _Pragma("unroll") for (int ai = 0; ai < 2; ++ai) _Pragma("unroll") for (int m = 0; m < 4; ++m) { \
        const int rl = ai * HALF + wr * 64 + m * 16 + fr; const int row = u.pm * BM + rl; (void)row;
#define EPI_ROWS_END asm volatile("" ::: "memory"); }
__device__ __forceinline__ void st_bf8(bf16_t* p, const f32x4 a, const f32x4 b) { u32x4 w; w.x = cvt_pk_bf16(a[0], a[1]); w.y = cvt_pk_bf16(a[2], a[3]); w.z = cvt_pk_bf16(b[0], b[1]); w.w = cvt_pk_bf16(b[2], b[3]); *(u32x4*)p = w; }
__device__ __forceinline__ float sq8(const f32x4 a, const f32x4 b) { return (a[0] * a[0] + a[1] * a[1]) + (a[2] * a[2] + a[3] * a[3]) + (b[0] * b[0] + b[1] * b[1]) + (b[2] * b[2] + b[3] * b[3]); }
__device__ __forceinline__ float silu1(float x) { return x * frcp(1.f + fexp(-x)); }

struct EpiInEven {
    bf16_t* Qh; bf16_t* KK; float* LOGF; bf16_t* V; bf16_t* G; float* CKV; float* KR; bf16_t* CQ; float* SSQCQ; const float* lbs;
    __device__ __forceinline__ void operator()(const f32x4 (&acc)[2][2][4][2], const Unit& u, int wr, int wc, int fr, int fq, const LAS float* scl) const {
        const int pn = u.pn;
        EPI_ROWS_BEGIN
            const float s = scl[rl];
#pragma unroll
            for (int bj = 0; bj < 2; ++bj) {
                const int cl = bj * HALF + wc * 32 + 8 * fq;
                f32x4 a = acc[ai][bj][m][0] * s, b = acc[ai][bj][m][1] * s;
                if (pn < 2) {
#pragma unroll
                    for (int j = 0; j < 4; ++j) { a[j] = silu1(a[j]) * 0.08838834764831845f; b[j] = silu1(b[j]) * 0.08838834764831845f; }
                    st_bf8(Qh + (size_t)row * 512 + pn * 256 + cl, a, b);
                } else if (pn < 4) {
                    const int c = (pn - 2) * 256 + cl; const f32x4 l0 = *(const f32x4*)(lbs + c), l1 = *(const f32x4*)(lbs + c + 4);
                    f32x4 lf0, lf1, k0, k1;
#pragma unroll
                    for (int j = 0; j < 4; ++j) {
                        { const float z = a[j], lb = l0[j], sp = sigm(z), sn = sigm(-z); lf0[j] = __logf(fmaxf(lb + (1.f - lb) * sp, 1e-30f)); k0[j] = (1.f - lb) * sn; }
                        { const float z = b[j], lb = l1[j], sp = sigm(z), sn = sigm(-z); lf1[j] = __logf(fmaxf(lb + (1.f - lb) * sp, 1e-30f)); k1[j] = (1.f - lb) * sn; }
                    }
                    *(f32x4*)(LOGF + (size_t)row * 512 + c) = lf0; *(f32x4*)(LOGF + (size_t)row * 512 + c + 4) = lf1;
                    st_bf8(KK + (size_t)row * 512 + c, k0, k1);
                } else if (pn < 6) {
                    st_bf8(V + (size_t)row * 512 + (pn - 4) * 256 + cl, a, b);
                } else if (pn < 8) {
#pragma unroll
                    for (int j = 0; j < 4; ++j) { a[j] = silu1(a[j]); b[j] = silu1(b[j]); }
                    st_bf8(G + (size_t)row * 512 + (pn - 6) * 256 + cl, a, b);
                } else if (pn == 8) {
                    *(f32x4*)(CKV + (size_t)row * 256 + cl) = a; *(f32x4*)(CKV + (size_t)row * 256 + cl + 4) = b;
                } else if (pn == 9 || bj == 0) {
                    const int c = (pn - 9) * 256 + cl;
                    st_bf8(CQ + (size_t)row * 384 + c, a, b);
                    float ss = sq8(a, b); ss += __shfl_xor(ss, 16); ss += __shfl_xor(ss, 32);
                    if (fq == 0) SSQCQ[(size_t)row * 16 + (pn == 9 ? bj * 4 + wc : 8 + wc)] = ss;
                } else if (wc < 2) {
                    const int c = wc * 32 + 8 * fq;
                    *(f32x4*)(KR + (size_t)row * 64 + c) = a; *(f32x4*)(KR + (size_t)row * 64 + c + 4) = b;
                }
            }
        EPI_ROWS_END
    }
};
struct EpiQ2 {
    bf16_t* QL; const float* rope;
    __device__ __forceinline__ void operator()(const f32x4 (&acc)[2][2][4][2], const Unit& u, int wr, int wc, int fr, int fq, const LAS float* scl) const {
        const int pn = u.pn;
        if (pn < 4) {
            EPI_ROWS_BEGIN
                const float s = scl[rl]; bf16_t* dst = QL + (size_t)row * QL_LD + pn * LAT + wc * 32 + 8 * fq;
                st_bf8(dst, acc[ai][0][m][0] * s, acc[ai][0][m][1] * s); st_bf8(dst + HALF, acc[ai][1][m][0] * s, acc[ai][1][m][1] * s);
            EPI_ROWS_END
        } else {
            const int g = (wc & 1) * 4 + fq;
            EPI_ROWS_BEGIN
                const float s = scl[rl]; const float* rp = rope + rope_idx(row) * 64 + 4 * g;
                const f32x4 c = *(const f32x4*)rp, sn = *(const f32x4*)(rp + 32);
#pragma unroll
                for (int bj = 0; bj < 2; ++bj) {
                    const f32x4 a = acc[ai][bj][m][0] * s, b = acc[ai][bj][m][1] * s, o1 = a * c - b * sn, o2 = a * sn + b * c;
                    bf16_t* dst = QL + (size_t)row * QL_LD + (bj * 2 + (wc >> 1)) * LAT + 256 + 4 * g;
                    u32x2 w1, w2; w1.x = cvt_pk_bf16(o1[0], o1[1]); w1.y = cvt_pk_bf16(o1[2], o1[3]); w2.x = cvt_pk_bf16(o2[0], o2[1]); w2.y = cvt_pk_bf16(o2[2], o2[3]);
                    *(u32x2*)dst = w1; *(u32x2*)(dst + 32) = w2;
                }
            EPI_ROWS_END
        }
    }
};
struct EpiOutRes {
    const float* resP; const float* resS; float* X; bf16_t* XB; float* SSQ;
    __device__ __forceinline__ void operator()(const f32x4 (&acc)[2][2][4][2], const Unit& u, int wr, int wc, int fr, int fq, const LAS float* scl) const {
        EPI_ROWS_BEGIN
            const float* rr = row < NP ? resP + (size_t)row * D : resS + (size_t)(row - NP) * D;
            float ss = 0.f;
#pragma unroll
            for (int bj = 0; bj < 2; ++bj) {
                const int c = u.pn * BM + bj * HALF + wc * 32 + 8 * fq;
                const f32x4 a = acc[ai][bj][m][0] + *(const f32x4*)(rr + c), b = acc[ai][bj][m][1] + *(const f32x4*)(rr + c + 4);
                *(f32x4*)(X + (size_t)row * D + c) = a; *(f32x4*)(X + (size_t)row * D + c + 4) = b;
                st_bf8(XB + (size_t)row * D + c, a, b);
                ss += sq8(a, b);
            }
            ss += __shfl_xor(ss, 16); ss += __shfl_xor(ss, 32);
            if (fq == 0) SSQ[(size_t)row * 16 + u.pn * 4 + wc] = ss;
        EPI_ROWS_END
    }
};
struct EpiUp {
    bf16_t* FFB;
    __device__ __forceinline__ void operator()(const f32x4 (&acc)[2][2][4][2], const Unit& u, int wr, int wc, int fr, int fq, const LAS float* scl) const {
        EPI_ROWS_BEGIN
            const float s = scl[rl];
#pragma unroll
            for (int bj = 0; bj < 2; ++bj) {
                f32x4 a = acc[ai][bj][m][0] * s, b = acc[ai][bj][m][1] * s;
#pragma unroll
                for (int j = 0; j < 4; ++j) { const float x = fmaxf(a[j], 0.f), y = fmaxf(b[j], 0.f); a[j] = x * x; b[j] = y * y; }
                st_bf8(FFB + (size_t)row * FF + u.pn * BM + bj * HALF + wc * 32 + 8 * fq, a, b);
            }
        EPI_ROWS_END
    }
};
struct EpiInOdd {
    bf16_t* Qh; bf16_t* KK; bf16_t* V; bf16_t* G; float* LOGF; const float* ba;
    __device__ __forceinline__ void operator()(const f32x4 (&acc)[2][2][4][2], const Unit& u, int wr, int wc, int fr, int fq, const LAS float* scl) const {
        const int pn = u.pn;
        EPI_ROWS_BEGIN
            const float s = scl[rl];
#pragma unroll
            for (int bj = 0; bj < 2; ++bj) {
                const int cl = bj * HALF + wc * 32 + 8 * fq;
                f32x4 a = acc[ai][bj][m][0] * s, b = acc[ai][bj][m][1] * s;
                if (pn < 2) { a = a * 0.08838834764831845f; b = b * 0.08838834764831845f; st_bf8(Qh + (size_t)row * 512 + pn * 256 + cl, a, b); }
                else if (pn < 4) st_bf8(KK + (size_t)row * 512 + (pn - 2) * 256 + cl, a, b);
                else if (pn < 8) st_bf8(V + (size_t)row * 1024 + (pn - 4) * 256 + cl, a, b);
                else if (pn < 12) {
#pragma unroll
                    for (int j = 0; j < 4; ++j) { a[j] = silu1(a[j]); b[j] = silu1(b[j]); }
                    st_bf8(G + (size_t)row * 1024 + (pn - 8) * 256 + cl, a, b);
                } else {
                    const int c = (pn - 12) * 256 + cl; const f32x4 b0 = *(const f32x4*)(ba + c), b1 = *(const f32x4*)(ba + c + 4);
                    f32x4 l0, l1;
#pragma unroll
                    for (int j = 0; j < 4; ++j) {
                        { const float x = a[j] + b0[j]; l0[j] = (fminf(x, 0.f) - __logf(1.f + fexp(-fabsf(x)))) * 0.0625f; }
                        { const float x = b[j] + b1[j]; l1[j] = (fminf(x, 0.f) - __logf(1.f + fexp(-fabsf(x)))) * 0.0625f; }
                    }
                    *(f32x4*)(LOGF + (size_t)row * 512 + c) = l0; *(f32x4*)(LOGF + (size_t)row * 512 + c + 4) = l1;
                }
            }
        EPI_ROWS_END
    }
};
struct Args { const void* in[25]; float* out; unsigned char* ws; int ph_lo, ph_hi, qrep, pad; };
typedef const __attribute__((address_space(4))) Args* KArgs;
struct Frame {
    LAS unsigned char* lds; volatile LAS unsigned* MISC; unsigned* ctl; unsigned char* ws;
    int tid, lane, wave, G, gw, NGW;
};
#define IN_F(i) ((const float*)args->in[i])
constexpr size_t OUT_YP = 0, OUT_YS = OUT_YP + (size_t)NP * D, OUT_MRP = OUT_YS + (size_t)NS * D, OUT_MRS = OUT_MRP + (size_t)2 * NP * LAT, OUT_HSP = OUT_MRS + (size_t)2 * NS * LAT,
                 OUT_HSS = OUT_HSP + (size_t)2 * 8 * 4 * 128 * 128, OUT_GSP = OUT_HSS + (size_t)2 * 32 * 4 * 128 * 128, OUT_GSS = OUT_GSP + (size_t)2 * 8 * 4 * 128 * 256;
#define WSP(T, off) ((T*)(F.ws + (off)))

struct TJob { const float* W; const float* gain; bf16_t* WT; int ldw, scol, K, ncols, ldt, drow, dk0; };
__device__ __forceinline__ void transpose_item(const TJob& J, int item, LAS float* scr, int lane) {
    const int nblk = J.ncols / 64, kb = item / nblk, nb = item % nblk, k0 = 64 * kb, n0 = 64 * nb;
    const int r = lane >> 4, c4 = (lane & 15) * 4;
    const float* src = J.W + (size_t)(k0 + r) * J.ldw + J.scol + n0 + c4;
    f32x4 v[16];
#pragma unroll
    for (int i = 0; i < 16; ++i) v[i] = *(const f32x4*)(src + (size_t)(4 * i) * J.ldw);
    const int c = lane & 7;
    f32x4 g0 = (f32x4){1.f, 1.f, 1.f, 1.f}, g1 = g0;
    if (J.gain) { g0 = *(const f32x4*)(J.gain + k0 + 8 * c); g1 = *(const f32x4*)(J.gain + k0 + 8 * c + 4); }
#pragma unroll
    for (int i = 0; i < 16; ++i) *(LAS f32x4*)(scr + (4 * i + r) * 68 + c4) = v[i];
    asm volatile("s_waitcnt lgkmcnt(0)" ::: "memory");
#pragma unroll
    for (int j = 0; j < 8; ++j) { const int n = (lane >> 3) + 8 * j; const LAS float* s = scr + (8 * c) * 68 + n;
        u32x4 o; o.x = cvt_pk_bf16(s[0 * 68] * g0[0], s[1 * 68] * g0[1]); o.y = cvt_pk_bf16(s[2 * 68] * g0[2], s[3 * 68] * g0[3]); o.z = cvt_pk_bf16(s[4 * 68] * g1[0], s[5 * 68] * g1[1]); o.w = cvt_pk_bf16(s[6 * 68] * g1[2], s[7 * 68] * g1[3]);
        *(u32x4*)(J.WT + (size_t)(J.drow + n0 + n) * J.ldt + J.dk0 + k0 + 8 * c) = o; }
    asm volatile("s_waitcnt lgkmcnt(0)" ::: "memory");
}
__device__ __forceinline__ TJob get_job(const Frame& F, KArgs args, int j) {
    TJob J;
    if (j < 10) { const int e = j / 5, s = j % 5; const float* W = IN_F(9) + (size_t)e * 1024 * 2752; bf16_t* WT = WSP(bf16_t, WS_WINE) + (size_t)e * NE1 * 1024;
        const float* gn = IN_F(6) + (2 * e) * 1024;
        if (s == 0) J = TJob{W, gn, WT, 2752, 0, 1024, 2048, 1024, 0, 0};
        else if (s == 1) J = TJob{W, gn, WT, 2752, 2432, 1024, 256, 1024, 2048, 0};
        else if (s == 2) J = TJob{W, gn, WT, 2752, 2048, 1024, 384, 1024, 2304, 0};
        else if (s == 3) J = TJob{W, gn, WT, 2752, 2688, 1024, 64, 1024, 2688, 0};
        else J = TJob{IN_F(17) + (size_t)e * 1024 * 1024, nullptr, WSP(bf16_t, WS_WOUTE) + (size_t)e * 1024 * KOE, 1024, 0, 512, 1024, KOE, 0, 0};
    } else if (j < 14) { const int o = (j - 10) >> 1;
        if (((j - 10) & 1) == 0) J = TJob{IN_F(18) + (size_t)o * 1024 * 3088, IN_F(6) + (2 * o + 1) * 1024, WSP(bf16_t, WS_WINO) + (size_t)o * NO1 * 1024, 3088, 0, 1024, 3072, 1024, 0, 0};
        else J = TJob{IN_F(22) + (size_t)o * 1024 * 1024, nullptr, WSP(bf16_t, WS_WOUTO) + (size_t)o * 1024 * 1024, 1024, 0, 1024, 1024, 1024, 0, 0};
    } else { const int l = (j - 14) >> 1;
        if (((j - 14) & 1) == 0) J = TJob{IN_F(23) + (size_t)l * 1024 * FF, IN_F(7) + l * 1024, WSP(bf16_t, WS_WUP) + (size_t)l * FF * 1024, FF, 0, 1024, FF, 1024, 0, 0};
        else J = TJob{IN_F(24) + (size_t)l * FF * 1024, nullptr, WSP(bf16_t, WS_WDOWN) + (size_t)l * 1024 * FF, 1024, 0, FF, 1024, FF, 0, 0};
    }
    return J;
}
__device__ __forceinline__ void p0_prologue(Frame& F, KArgs args) {
#ifndef MK_PROBE_PART
#define MK_PROBE_PART 7
#endif
    const int part = args->qrep ? MK_PROBE_PART : 7;
    LAS float* scr = (LAS float*)(F.lds + F.wave * 17408);
    if (part & 1) for (int j = 0; j < 22; ++j) { const TJob J = get_job(F, args, j); const int nit = (J.K / 64) * (J.ncols / 64);
        for (int it = F.gw; it < nit; it += F.NGW) transpose_item(J, it, scr, F.lane); }
    __syncthreads();
    LAS float* sm = (LAS float*)(F.lds);
    if (part & 2) for (int it = blockIdx.x; it < 512; it += F.G) {
        const int kind = it >> 8, r = it & 255, e = r >> 7, h = (r >> 5) & 3, c8 = r & 31;
        __syncthreads();
        if (kind == 0) {
            for (int i = F.tid; i < 1024; i += 512) sm[i] = IN_F(15)[((size_t)((e * 4 + h) * 256 + c8 * 8 + (i >> 7))) * 128 + (i & 127)];
            __syncthreads();
            if (F.tid < 384) { const int k = F.tid; const f32x4* a = (const f32x4*)(IN_F(13) + (size_t)(e * 384 + k) * 768 + h * 192); float acc[8] = {};
#pragma unroll 8
                for (int n4 = 0; n4 < 32; ++n4) { const f32x4 av = a[n4];
#pragma unroll
                    for (int c = 0; c < 8; ++c) { const f32x4 bv = *(const LAS f32x4*)(sm + c * 128 + n4 * 4); acc[c] += (av[0] * bv[0] + av[1] * bv[1]) + (av[2] * bv[2] + av[3] * bv[3]); } }
                const float gq = IN_F(12)[e * 384 + k] * QSCALE; bf16_t* dst = WSP(bf16_t, WS_WQ2) + ((size_t)e * NQ2 + h * 256 + c8 * 8) * 384 + k;
#pragma unroll
                for (int c = 0; c < 8; ++c) dst[(size_t)c * 384] = (bf16_t)(cvt_pk_bf16(acc[c] * gq, 0.f) & 0xffffu); }
        } else {
            for (int i = F.tid; i < 1024; i += 512) sm[i] = IN_F(16)[((size_t)((e * 4 + h) * 256 + c8 * 8 + (i >> 7))) * 128 + (i & 127)];
            __syncthreads();
            for (int n = F.tid; n < 1024; n += 512) { const float* wo = IN_F(17) + ((size_t)e * 1024 + 512 + h * 128) * 1024 + n; float acc[8] = {};
#pragma unroll 16
                for (int v = 0; v < 128; ++v) { const float x = wo[(size_t)v * 1024];
#pragma unroll
                    for (int c = 0; c < 8; ++c) acc[c] += sm[c * 128 + v] * x; }
                u32x4 o; o.x = cvt_pk_bf16(acc[0], acc[1]); o.y = cvt_pk_bf16(acc[2], acc[3]); o.z = cvt_pk_bf16(acc[4], acc[5]); o.w = cvt_pk_bf16(acc[6], acc[7]);
                *(u32x4*)(WSP(bf16_t, WS_WOUTE) + ((size_t)e * 1024 + n) * KOE + 512 + h * 256 + c8 * 8) = o; }
        }
    }
    if (!(part & 4)) return;
    const int gt = blockIdx.x * 512 + F.tid, NT = F.G * 512;
    for (int idx = gt; idx < 2 * 256 * 384; idx += NT) {
        const int k = idx % 384, cc = (idx / 384) & 255, e = idx / (384 * 256), hh = cc >> 6, w6 = cc & 63, g = w6 >> 3, i = w6 & 7, sj = i < 4 ? 4 * g + i : 32 + 4 * g + (i - 4);
        const float v = IN_F(13)[(size_t)(e * 384 + k) * 768 + hh * 192 + 128 + sj] * IN_F(12)[e * 384 + k] * QSCALE;
        WSP(bf16_t, WS_WQ2)[((size_t)e * NQ2 + 1024 + cc) * 384 + k] = (bf16_t)(cvt_pk_bf16(v, 0.f) & 0xffffu); }
    for (int idx = gt; idx < 2 * 8 * 1024; idx += NT) {
        const int k = idx & 1023, jp = (idx >> 10) & 7, o = idx >> 13; const f32x4* ar = (const f32x4*)(IN_F(18) + (size_t)(o * 1024 + k) * 3088 + 3072);
        const f32x4 a0 = ar[0], a1 = ar[1], a2 = ar[2], a3 = ar[3]; const float gn = IN_F(6)[(2 * o + 1) * 1024 + k];
        const float av[16] = {a0[0], a0[1], a0[2], a0[3], a1[0], a1[1], a1[2], a1[3], a2[0], a2[1], a2[2], a2[3], a3[0], a3[1], a3[2], a3[3]};
#pragma unroll 4
        for (int j = jp * 64; j < jp * 64 + 64; ++j) { float s = 0.f;
#pragma unroll
            for (int r = 0; r < 16; ++r) s += av[r] * IN_F(19)[(size_t)(o * 16 + r) * 512 + j];
            WSP(bf16_t, WS_WINO)[((size_t)o * NO1 + 3072 + j) * 1024 + k] = (bf16_t)(cvt_pk_bf16(s * gn, 0.f) & 0xffffu); } }
    for (int idx = gt; idx < 2 * 64 * 128; idx += NT) {
        const int e = idx >> 13, r = idx & 8191; *(u32x4*)(WSP(bf16_t, WS_WINE) + ((size_t)e * NE1 + 2752) * 1024 + (size_t)r * 8) = (u32x4){0u, 0u, 0u, 0u}; }
    for (int idx = gt; idx < 512; idx += NT) {
        const float a = IN_F(10)[idx], b = IN_F(10)[512 + idx], mx = fmaxf(a, b), ea = __expf(a - mx), eb = __expf(b - mx);
        WSP(float, WS_LBS)[idx] = 0.f; WSP(float, WS_LBS)[512 + idx] = eb / (ea + eb); }
    for (int idx = gt; idx < 2056 * 32; idx += NT) {
        const int j = idx & 31, pi = idx >> 5; const double pos = (double)(pi < SEQ ? pi : PAST + (pi - SEQ));
        const double inv = exp2(-(double)j * (13.287712379549449 / 32.0)), ang = pos * inv, n = rint(ang * 0.15915494309189535), r = ang - n * 6.283185307179586;
        WSP(float, WS_ROPE)[(size_t)pi * 64 + j] = cosf((float)r); WSP(float, WS_ROPE)[(size_t)pi * 64 + 32 + j] = sinf((float)r); }
    for (int m = F.gw; m < NTOK; m += F.NGW) {
        const float* xr = m < NP ? IN_F(0) + (size_t)m * D : IN_F(1) + (size_t)(m - NP) * D; float s = 0.f;
#pragma unroll
        for (int j = 0; j < 4; ++j) { const f32x4 v = *(const f32x4*)(xr + j * 256 + F.lane * 4); s += (v[0] * v[0] + v[1] * v[1]) + (v[2] * v[2] + v[3] * v[3]);
            u32x2 w; w.x = cvt_pk_bf16(v[0], v[1]); w.y = cvt_pk_bf16(v[2], v[3]); *(u32x2*)(WSP(bf16_t, WS_XB) + (size_t)m * D + j * 256 + F.lane * 4) = w; }
        s = wave_sum(s);
        if (F.lane < 16) WSP(float, WS_SSQ)[(size_t)m * 16 + F.lane] = F.lane == 0 ? s : 0.f;
    }
}

__device__ __forceinline__ void finalize_rows(Frame& F, KArgs args, int e) {
    const float* CKV = WSP(float, WS_CKV); const float* KR = WSP(float, WS_KR); bf16_t* KVL = WSP(bf16_t, WS_KVL); const float* rope = WSP(float, WS_ROPE);
    int lane_ = F.lane; asm volatile("" : "+v"(lane_));
    const f32x4 w4 = *(const f32x4*)(IN_F(14) + e * 256 + lane_ * 4);
    for (int r = F.gw; r < NTOK; r += F.NGW) {
        const f32x4 v = *(const f32x4*)(CKV + (size_t)r * 256 + lane_ * 4);
        const float ss = wave_sum((v[0] * v[0] + v[1] * v[1]) + (v[2] * v[2] + v[3] * v[3])), rs = rsqrtf(ss * (1.f / 256.f) + EPS);
        const f32x4 o = v * rs * w4;
        float* od = r < NP ? (args->out + OUT_MRP) + ((size_t)e * NP + r) * LAT : (args->out + OUT_MRS) + ((size_t)e * NS + (r - NP)) * LAT;
        *(f32x4*)(od + lane_ * 4) = o;
        u32x2 w; w.x = cvt_pk_bf16(o[0], o[1]); w.y = cvt_pk_bf16(o[2], o[3]); *(u32x2*)(KVL + (size_t)r * LAT + lane_ * 4) = w;
        if (lane_ < 32) { const float x1 = KR[(size_t)r * 64 + lane_], x2 = KR[(size_t)r * 64 + 32 + lane_]; const float* rp = rope + (size_t)rope_idx(r) * 64;
            const float c = rp[lane_], sn = rp[32 + lane_], a = x1 * c - x2 * sn, b = x1 * sn + x2 * c;
            od[256 + lane_] = a; od[288 + lane_] = b;
            KVL[(size_t)r * LAT + 256 + lane_] = (bf16_t)(cvt_pk_bf16(a, 0.f) & 0xffffu); KVL[(size_t)r * LAT + 288 + lane_] = (bf16_t)(cvt_pk_bf16(b, 0.f) & 0xffffu); }
    }
}

constexpr int KP = 656, KT_BYTES = 64 * KP;
#define NEG_INF (-__builtin_inff())
__device__ __forceinline__ s16x4 tr_read(const LAS unsigned char* p) { return __builtin_amdgcn_ds_read_tr16_b64_v4i16((LAS s16x4*)p); }
__device__ __forceinline__ bf16x8 pack_frag(const f32x4 a, const f32x4 b) { u32x4 w; w.x = cvt_pk_bf16(a[0], a[1]); w.y = cvt_pk_bf16(a[2], a[3]); w.z = cvt_pk_bf16(b[0], b[1]); w.w = cvt_pk_bf16(b[2], b[3]); return __builtin_bit_cast(bf16x8, w); }
__device__ __forceinline__ bf16x8 join_frag(const s16x4 a, const s16x4 b) { return (bf16x8){a[0], a[1], a[2], a[3], b[0], b[1], b[2], b[3]}; }
template <int NKB, int NCB, bool MASK>
__device__ __forceinline__ void attn_tile(const LAS unsigned char* kt, int key0, int cbase, const bf16x8 (&qf)[10], f32x4 (&O)[NCB], float& m, float& l, int lane, int keyabs0, int limit) {
    const int fr = lane & 15, g = lane >> 4;
    f32x4 S[NKB];
#pragma unroll
    for (int kb = 0; kb < NKB; ++kb) { S[kb] = (f32x4){0.f, 0.f, 0.f, 0.f};
        const LAS unsigned char* kr = kt + (key0 + kb * 16 + fr) * KP + g * 16;
#pragma unroll
        for (int ds = 0; ds < 10; ++ds) S[kb] = __builtin_amdgcn_mfma_f32_16x16x32_bf16(*(const LAS bf16x8*)(kr + ds * 64), qf[ds], S[kb], 0, 0, 0);
        asm volatile("" ::: "memory"); }
    if constexpr (MASK) {
#pragma unroll
        for (int kb = 0; kb < NKB; ++kb)
#pragma unroll
            for (int i = 0; i < 4; ++i) if (keyabs0 + key0 + kb * 16 + 4 * g + i > limit) S[kb][i] = NEG_INF;
    }
    float mx = NEG_INF;
#pragma unroll
    for (int kb = 0; kb < NKB; ++kb) mx = fmaxf(fmaxf(mx, fmaxf(S[kb][0], S[kb][1])), fmaxf(S[kb][2], S[kb][3]));
    mx = fmaxf(mx, __shfl_xor(mx, 16)); mx = fmaxf(mx, __shfl_xor(mx, 32));
    const float mn = fmaxf(m, mx), mu = (mn == NEG_INF) ? 0.f : mn, alpha = fexp2(m - mu);
    float ls = 0.f;
#pragma unroll
    for (int kb = 0; kb < NKB; ++kb)
#pragma unroll
        for (int i = 0; i < 4; ++i) { const float p = fexp2(S[kb][i] - mu); S[kb][i] = p; ls += p; }
    l = l * alpha + ls; m = mn;
#pragma unroll
    for (int cb = 0; cb < NCB; ++cb) O[cb] = O[cb] * alpha;
#pragma unroll
    for (int p2 = 0; p2 < NKB / 2; ++p2) {
        const bf16x8 pf = pack_frag(S[2 * p2], S[2 * p2 + 1]);
        const LAS unsigned char* vr = kt + (key0 + 32 * p2 + 4 * g + (fr >> 2)) * KP + (cbase + 4 * (fr & 3)) * 2;
#pragma unroll
        for (int cb = 0; cb < NCB; ++cb) { const bf16x8 a = join_frag(tr_read(vr + cb * 32), tr_read(vr + cb * 32 + 16 * KP)); O[cb] = __builtin_amdgcn_mfma_f32_16x16x32_bf16(a, pf, O[cb], 0, 0, 0);
            if ((cb & 3) == 3) asm volatile("" ::: "memory"); }
    }
}
__device__ __forceinline__ void attn_prompt_unit(Frame& F, int b, int qb) {
    const bf16_t* KVL = WSP(bf16_t, WS_KVL); const bf16_t* QL = WSP(bf16_t, WS_QL); bf16_t* OA = WSP(bf16_t, WS_OA);
    int tid_ = F.tid; asm volatile("" : "+v"(tid_));
    const int w = F.wave, lane = tid_ & 63, fr = lane & 15, g = lane >> 4, h = w & 3, half = w >> 2;
    const int pos = 32 * qb + 16 * half + fr, row = b * SEQ + pos;
    bf16x8 qf[10];
#pragma unroll
    for (int ds = 0; ds < 10; ++ds) qf[ds] = *(const bf16x8*)(QL + (size_t)row * QL_LD + h * LAT + ds * 32 + g * 8);
    f32x4 O[16];
#pragma unroll
    for (int cb = 0; cb < 16; ++cb) O[cb] = (f32x4){0.f, 0.f, 0.f, 0.f};
    float m = NEG_INF, l = 0.f;
    const int ntiles = (qb >> 1) + 1;
    const u32x4* src = (const u32x4*)(KVL + (size_t)b * SEQ * LAT);
    u32x4 st[5];
#define PA_LOAD(kt) do { _Pragma("unroll") for (int i = 0; i < 5; ++i) st[i] = src[(size_t)(kt) * 2560 + tid_ + 512 * i]; } while (0)
#define PA_WRITE(buf) do { _Pragma("unroll") for (int i = 0; i < 5; ++i) { const int ch = tid_ + 512 * i, key = ch / 40, c16 = ch % 40; *(LAS u32x4*)(F.lds + (buf) * KT_BYTES + key * KP + c16 * 16) = st[i]; } } while (0)
    PA_LOAD(0); PA_WRITE(0); __syncthreads();
    for (int kt = 0; kt < ntiles; ++kt) {
        if (kt + 1 < ntiles) PA_LOAD(kt + 1);
        const LAS unsigned char* kb = F.lds + (kt & 1) * KT_BYTES;
        attn_tile<4, 16, true>(kb, 0, 0, qf, O, m, l, lane, 64 * kt, pos);
        if (kt + 1 < ntiles) PA_WRITE((kt + 1) & 1);
        __syncthreads();
    }
#undef PA_LOAD
#undef PA_WRITE
    l += __shfl_xor(l, 16); l += __shfl_xor(l, 32);
    const float inv = 1.f / l;
    bf16_t* dst = OA + (size_t)row * KOE + 512 + h * 256 + 4 * g;
#pragma unroll
    for (int cb = 0; cb < 16; ++cb) { const f32x4 o = O[cb] * inv; u32x2 wv; wv.x = cvt_pk_bf16(o[0], o[1]); wv.y = cvt_pk_bf16(o[2], o[3]); *(u32x2*)(dst + cb * 16) = wv; }
}
__device__ __forceinline__ void attn_decode_unit(Frame& F, KArgs args, int e, int bd, int sp) {
    const bf16_t* KVL = WSP(bf16_t, WS_KVL); const bf16_t* QL = WSP(bf16_t, WS_QL); float* PO = WSP(float, WS_PO); float* PML = WSP(float, WS_PML);
    const float* cache = IN_F(2) + (size_t)e * NPHYS * PAGE * LAT;
    int tid_ = F.tid; asm volatile("" : "+v"(tid_));
    const int w = F.wave, lane = tid_ & 63, fr = lane & 15, g = lane >> 4, rg = w & 1, kh = (w >> 1) & 1, ch = w >> 2;
    const int rr = 16 * rg + fr, td = rr >> 2, h = rr & 3, row = NP + bd * DSEQ + td;
    bf16x8 qf[10];
#pragma unroll
    for (int ds = 0; ds < 10; ++ds) qf[ds] = *(const bf16x8*)(QL + (size_t)row * QL_LD + h * LAT + ds * 32 + g * 8);
    f32x4 O[8];
#pragma unroll
    for (int cb = 0; cb < 8; ++cb) O[cb] = (f32x4){0.f, 0.f, 0.f, 0.f};
    float m = NEG_INF, l = 0.f;
    constexpr int PPS = NPAGES / NSPLIT, NT = 2 * PPS;
    f32x4 st[10];
#define DA_LOAD(t) do { const int pg = ((const int*)args->in[5])[bd * NPAGES + sp * PPS + ((t) >> 1)]; const f32x4* bp = (const f32x4*)(cache + ((size_t)pg * PAGE + ((t) & 1) * 64) * LAT); \
        _Pragma("unroll") for (int i = 0; i < 10; ++i) st[i] = __builtin_nontemporal_load(bp + tid_ + 512 * i); } while (0)
#define DA_WRITE(buf) do { _Pragma("unroll") for (int i = 0; i < 10; ++i) { const int idx = tid_ + 512 * i, key = idx / 80, d4 = idx % 80; u32x2 wv; wv.x = cvt_pk_bf16(st[i][0], st[i][1]); wv.y = cvt_pk_bf16(st[i][2], st[i][3]); \
        *(LAS u32x2*)(F.lds + (buf) * KT_BYTES + key * KP + d4 * 8) = wv; } } while (0)
    DA_LOAD(0); DA_WRITE(0); __syncthreads();
    for (int t = 0; t < NT; ++t) {
        if (t + 1 < NT) DA_LOAD(t + 1);
        attn_tile<2, 8, false>(F.lds + (t & 1) * KT_BYTES, 32 * kh, 128 * ch, qf, O, m, l, lane, 0, 0);
        if (t + 1 < NT) DA_WRITE((t + 1) & 1);
        __syncthreads();
    }
#undef DA_LOAD
#undef DA_WRITE
    if (sp == NSPLIT - 1) {
        for (int i = tid_; i < 320 + 24 * 41; i += 512) {
            if (i < 320) { const int key = i / 40, c16 = i % 40; *(LAS u32x4*)(F.lds + key * KP + c16 * 16) = *(const u32x4*)(KVL + (size_t)(NP + bd * DSEQ + key) * LAT + c16 * 8); }
            else { const int j = i - 320; *(LAS u32x4*)(F.lds + 8 * KP + j * 16) = (u32x4){0u, 0u, 0u, 0u}; }
        }
        __syncthreads();
        if (kh == 0) attn_tile<2, 8, true>(F.lds, 0, 128 * ch, qf, O, m, l, lane, PAST, PAST + td);
        __syncthreads();
    }
    l += __shfl_xor(l, 16); l += __shfl_xor(l, 32);
    const int se = sp * 2 + kh; const size_t pr = ((size_t)(bd * NSE + se) * 32 + rr);
#pragma unroll
    for (int cb = 0; cb < 8; ++cb) *(f32x4*)(PO + pr * 256 + 128 * ch + 16 * cb + 4 * g) = O[cb];
    if (ch == 0 && g == 0) { PML[pr * 2] = m; PML[pr * 2 + 1] = l; }
}
__device__ __forceinline__ void attn_decode_combine(Frame& F) {
    const float* PO = WSP(float, WS_PO); const float* PML = WSP(float, WS_PML); bf16_t* OA = WSP(bf16_t, WS_OA);
    for (int r = F.gw; r < 32 * 32; r += F.NGW) {
        const int bd = r >> 5, rr = r & 31, td = rr >> 2, h = rr & 3;
        float mm = NEG_INF, ll = 0.f;
        if (F.lane < NSE) { const size_t pr = ((size_t)(bd * NSE + F.lane) * 32 + rr); mm = PML[pr * 2]; ll = PML[pr * 2 + 1]; }
        float M = mm;
#pragma unroll
        for (int o = 1; o < 64; o <<= 1) M = fmaxf(M, __shfl_xor(M, o));
        const float wgt = (F.lane < NSE) ? fexp2(mm - M) : 0.f; const float L = wave_sum(wgt * ll);
        f32x4 acc = (f32x4){0.f, 0.f, 0.f, 0.f};
        for (int se = 0; se < NSE; ++se) { const float ws_ = __shfl(wgt, se); acc = acc + *(const f32x4*)(PO + ((size_t)(bd * NSE + se) * 32 + rr) * 256 + F.lane * 4) * ws_; }
        const float inv = 1.f / L; u32x2 wv; wv.x = cvt_pk_bf16(acc[0] * inv, acc[1] * inv); wv.y = cvt_pk_bf16(acc[2] * inv, acc[3] * inv);
        *(u32x2*)(OA + (size_t)(NP + bd * DSEQ + td) * KOE + 512 + h * 256 + F.lane * 4) = wv;
    }
}

template <int NV, int INIT, bool FULL>
__device__ __forceinline__ void scan_unit(Frame& F, const float* nw, const float* s0, float* sout, float* segH, float* segD, int nprev, int ldo, int row0, int T, int h) {
    constexpr int VD = 128 * NV, LDV = 4 * VD, PV = 2 * VD + 16, PQ = 272, PK = 144;
    constexpr int O_QT0 = 0, O_QH = 64 * PQ, O_KH = 2 * 64 * PQ, O_KLT = 3 * 64 * PQ, O_VT = O_KLT + 128 * PK, O_DEC = O_VT + 64 * PV, O_XS = O_DEC + 512, O_NRM = O_XS + 8192;
    constexpr size_t SEGSZ = (size_t)128 * VD;
    static_assert(O_NRM + 2048 <= RING_BYTES, "scan LDS");
    const bf16_t* Qh = WSP(bf16_t, WS_QH); const bf16_t* KK = WSP(bf16_t, WS_KK); const float* LOGF = WSP(float, WS_LOGF); const bf16_t* V = WSP(bf16_t, WS_V); const bf16_t* G = WSP(bf16_t, WS_G); bf16_t* OA = WSP(bf16_t, WS_OA);
    LAS unsigned char* lds = F.lds;
    int tid = F.tid; asm volatile("" : "+v"(tid));
    const int w = F.wave, lane = tid & 63, fr = lane & 15, g = lane >> 4;
    f32x4 S[8][NV];
#pragma unroll
    for (int kb = 0; kb < 8; ++kb)
#pragma unroll
        for (int nv = 0; nv < NV; ++nv) {
            if constexpr (INIT == 1) { const float* sp = s0 + (size_t)(16 * kb + 4 * g) * VD + (w * NV + nv) * 16 + fr;
                const float a0 = sp[0], a1 = sp[VD], a2 = sp[2 * VD], a3 = sp[3 * VD]; S[kb][nv] = (f32x4){a0, a1, a2, a3}; }
            else S[kb][nv] = (f32x4){0.f, 0.f, 0.f, 0.f};
        }
    if constexpr (INIT == 2) {
        for (int j = 0; j < nprev; ++j) {
            const f32x4* hp = (const f32x4*)(segH + (size_t)j * SEGSZ) + (size_t)w * (8 * NV) * 64 + lane; const float* dp = segD + j * 128 + 4 * g;
#pragma unroll
            for (int kb = 0; kb < 8; ++kb) { const f32x4 d4 = *(const f32x4*)(dp + 16 * kb);
#pragma unroll
                for (int nv = 0; nv < NV; ++nv) S[kb][nv] = S[kb][nv] * d4 + hp[(kb * NV + nv) * 64]; }
        }
    }
    f32x4 segsum = (f32x4){0.f, 0.f, 0.f, 0.f};
    for (int c0 = 0; c0 < T; c0 += 64) {
        {
            const int k4 = (tid & 31) * 4, ts = tid >> 5, t0 = 4 * ts;
            const size_t rbase = (size_t)(row0 + c0 + t0) * 512 + h * 128 + k4;
            f32x4 bl[4]; u32x2 qw[4], kw[4]; f32x4 run = (f32x4){0.f, 0.f, 0.f, 0.f};
#pragma unroll
            for (int i = 0; i < 4; ++i) { const bool ok = c0 + t0 + i < T; f32x4 lf = (f32x4){0.f, 0.f, 0.f, 0.f}; qw[i] = (u32x2){0u, 0u}; kw[i] = (u32x2){0u, 0u};
                if (ok) { lf = *(const f32x4*)(LOGF + rbase + (size_t)i * 512); if constexpr (FULL) qw[i] = *(const u32x2*)(Qh + rbase + (size_t)i * 512); kw[i] = *(const u32x2*)(KK + rbase + (size_t)i * 512); }
                run = run + lf; bl[i] = run; }
            *(LAS f32x4*)(lds + O_XS + (ts * 128 + k4) * 4) = run;
#pragma unroll
            for (int j = 0; j < 2 * NV; ++j) { const int chn = tid + 512 * j, s = chn / (VD / 8), cc = chn % (VD / 8); u32x4 val = (u32x4){0u, 0u, 0u, 0u};
                if (c0 + s < T) val = *(const u32x4*)(V + (size_t)(row0 + c0 + s) * LDV + h * VD + cc * 8);
                *(LAS u32x4*)(lds + O_VT + s * PV + cc * 16) = val; }
            __syncthreads();
            f32x4 pre = (f32x4){0.f, 0.f, 0.f, 0.f}, b31 = pre, bL = pre;
#pragma unroll
            for (int s = 0; s < 16; ++s) { const f32x4 x = *(const LAS f32x4*)(lds + O_XS + (s * 128 + k4) * 4); if (s < ts) pre = pre + x; if (s < 8) b31 = b31 + x; bL = bL + x; }
            f32x4 klv[4];
#pragma unroll
            for (int i = 0; i < 4; ++i) {
                const f32x4 b = pre + bl[i]; f32x4 k, eL;
                k[0] = bflo(kw[i].x); k[1] = bfhi(kw[i].x); k[2] = bflo(kw[i].y); k[3] = bfhi(kw[i].y);
#pragma unroll
                for (int c = 0; c < 4; ++c) eL[c] = fexp(bL[c] - b[c]);
                klv[i] = k * eL;
                if constexpr (FULL) {
                    f32x4 q, e0, em, ek;
                    q[0] = bflo(qw[i].x); q[1] = bfhi(qw[i].x); q[2] = bflo(qw[i].y); q[3] = bfhi(qw[i].y);
#pragma unroll
                    for (int c = 0; c < 4; ++c) { e0[c] = fexp(b[c]); em[c] = fexp(b[c] - b31[c]); ek[c] = fexp(b31[c] - b[c]); }
                    const f32x4 a0 = q * e0, a1 = q * em, a2 = k * ek;
                    const int ro = (t0 + i) * PQ + k4 * 2;
                    *(LAS u32x2*)(lds + O_QT0 + ro) = (u32x2){cvt_pk_bf16(a0[0], a0[1]), cvt_pk_bf16(a0[2], a0[3])};
                    *(LAS u32x2*)(lds + O_QH + ro) = (u32x2){cvt_pk_bf16(a1[0], a1[1]), cvt_pk_bf16(a1[2], a1[3])};
                    *(LAS u32x2*)(lds + O_KH + ro) = (u32x2){cvt_pk_bf16(a2[0], a2[1]), cvt_pk_bf16(a2[2], a2[3])};
                }
            }
#pragma unroll
            for (int c = 0; c < 4; ++c) *(LAS u32x2*)(lds + O_KLT + (k4 + c) * PK + t0 * 2) = (u32x2){cvt_pk_bf16(klv[0][c], klv[1][c]), cvt_pk_bf16(klv[2][c], klv[3][c])};
            if (ts == 0) { f32x4 d; d[0] = fexp(bL[0]); d[1] = fexp(bL[1]); d[2] = fexp(bL[2]); d[3] = fexp(bL[3]); *(LAS f32x4*)(lds + O_DEC + k4 * 4) = d; segsum = segsum + bL; }
            __syncthreads();
        }
        f32x4 Oo[4][NV];
        if constexpr (FULL) {
            bf16x8 sB[4][NV];
#pragma unroll
            for (int ks = 0; ks < 4; ++ks)
#pragma unroll
                for (int nv = 0; nv < NV; ++nv) sB[ks][nv] = pack_frag(S[2 * ks][nv], S[2 * ks + 1][nv]);
            bf16x8 vP[2][NV];
#pragma unroll
            for (int p = 0; p < 2; ++p)
#pragma unroll
                for (int nv = 0; nv < NV; ++nv) { const LAS unsigned char* a1 = lds + O_VT + (32 * p + 4 * g + (fr >> 2)) * PV + ((w * NV + nv) * 16 + 4 * (fr & 3)) * 2; vP[p][nv] = join_frag(tr_read(a1), tr_read(a1 + 16 * PV)); }
#pragma unroll
            for (int tb = 0; tb < 4; ++tb) {
                f32x4 X[4];
                {
                    bf16x8 bq[4];
#pragma unroll
                    for (int ks = 0; ks < 4; ++ks) bq[ks] = *(const LAS bf16x8*)(lds + O_QH + (16 * tb + fr) * PQ + ks * 64 + g * 16);
#pragma unroll
                    for (int sb = 0; sb < 4; ++sb) { X[sb] = (f32x4){0.f, 0.f, 0.f, 0.f};
                        if (sb <= tb) {
#pragma unroll
                            for (int ks = 0; ks < 4; ++ks) X[sb] = __builtin_amdgcn_mfma_f32_16x16x32_bf16(*(const LAS bf16x8*)(lds + O_KH + (16 * sb + fr) * PQ + ks * 64 + g * 16), bq[ks], X[sb], 0, 0, 0);
                            if (sb == tb) {
#pragma unroll
                                for (int i = 0; i < 4; ++i) if (4 * g + i > fr) X[sb][i] = 0.f; } } }
                }
#pragma unroll
                for (int nv = 0; nv < NV; ++nv) Oo[tb][nv] = (f32x4){0.f, 0.f, 0.f, 0.f};
#pragma unroll
                for (int p = 0; p < 2; ++p) if (p <= (tb >> 1)) {
                    const bf16x8 pf = pack_frag(X[2 * p], X[2 * p + 1]);
#pragma unroll
                    for (int nv = 0; nv < NV; ++nv) Oo[tb][nv] = __builtin_amdgcn_mfma_f32_16x16x32_bf16(pf, vP[p][nv], Oo[tb][nv], 0, 0, 0);
                }
#pragma unroll
                for (int ks = 0; ks < 4; ++ks) {
                    const LAS unsigned char* qa = lds + O_QT0 + (16 * tb + fr) * PQ + (32 * ks + 4 * g) * 2;
                    const u32x2 q0 = *(const LAS u32x2*)qa, q1 = *(const LAS u32x2*)(qa + 32);
                    const bf16x8 aq = __builtin_bit_cast(bf16x8, (u32x4){q0.x, q0.y, q1.x, q1.y});
#pragma unroll
                    for (int nv = 0; nv < NV; ++nv) Oo[tb][nv] = __builtin_amdgcn_mfma_f32_16x16x32_bf16(aq, sB[ks][nv], Oo[tb][nv], 0, 0, 0);
                }
                asm volatile("" ::: "memory");
            }
        }
        bf16x8 vN[2][NV];
#pragma unroll
        for (int p = 0; p < 2; ++p)
#pragma unroll
            for (int nv = 0; nv < NV; ++nv) { const LAS unsigned char* a2 = lds + O_VT + (32 * p + 8 * g + (fr >> 2)) * PV + ((w * NV + nv) * 16 + 4 * (fr & 3)) * 2; vN[p][nv] = join_frag(tr_read(a2), tr_read(a2 + 4 * PV)); }
#pragma unroll
        for (int kb = 0; kb < 8; ++kb) {
            const f32x4 d4 = *(const LAS f32x4*)(lds + O_DEC + (16 * kb + 4 * g) * 4);
#pragma unroll
            for (int nv = 0; nv < NV; ++nv) S[kb][nv] = S[kb][nv] * d4;
#pragma unroll
            for (int p = 0; p < 2; ++p) { const bf16x8 a = *(const LAS bf16x8*)(lds + O_KLT + (16 * kb + fr) * PK + p * 64 + g * 16);
#pragma unroll
                for (int nv = 0; nv < NV; ++nv) S[kb][nv] = __builtin_amdgcn_mfma_f32_16x16x32_bf16(a, vN[p][nv], S[kb][nv], 0, 0, 0); }
        }
        if constexpr (FULL) {
#pragma unroll
            for (int tb = 0; tb < 4; ++tb)
#pragma unroll
                for (int i = 0; i < 4; ++i) { float ss = 0.f;
#pragma unroll
                    for (int nv = 0; nv < NV; ++nv) ss += Oo[tb][nv][i] * Oo[tb][nv][i];
                    ss += __shfl_xor(ss, 1); ss += __shfl_xor(ss, 2); ss += __shfl_xor(ss, 4); ss += __shfl_xor(ss, 8);
                    if (fr == 0) ((LAS float*)(lds + O_NRM))[(16 * tb + 4 * g + i) * 8 + w] = ss; }
            __syncthreads();
#pragma unroll
            for (int tb = 0; tb < 4; ++tb)
#pragma unroll
                for (int i = 0; i < 4; ++i) { const int tl = 16 * tb + 4 * g + i; const LAS f32x4* np = (const LAS f32x4*)(lds + O_NRM + tl * 32); const f32x4 n0 = np[0], n1 = np[1];
                    const float rs = rsqrtf(((n0[0] + n0[1]) + (n0[2] + n0[3]) + (n1[0] + n1[1]) + (n1[2] + n1[3])) * (1.f / VD) + EPS);
                    if (c0 + tl < T) { int ri = row0 + c0 + tl; asm volatile("" : "+v"(ri)); const size_t r = (size_t)ri;
#pragma unroll
                        for (int nv = 0; nv < NV; ++nv) { const int v = (w * NV + nv) * 16 + fr; const float gt = bf2f(G[r * LDV + h * VD + v]);
                            OA[r * ldo + h * VD + v] = (bf16_t)(cvt_pk_bf16(Oo[tb][nv][i] * rs * nw[v] * gt, 0.f) & 0xffffu); } } }
        } else __syncthreads();
    }
    if constexpr (!FULL) {
        f32x4* hp = (f32x4*)segH + (size_t)w * (8 * NV) * 64 + lane;
#pragma unroll
        for (int kb = 0; kb < 8; ++kb)
#pragma unroll
            for (int nv = 0; nv < NV; ++nv) hp[(kb * NV + nv) * 64] = S[kb][nv];
        if ((tid >> 5) == 0) { f32x4 d; d[0] = fexp(segsum[0]); d[1] = fexp(segsum[1]); d[2] = fexp(segsum[2]); d[3] = fexp(segsum[3]); *(f32x4*)(segD + (tid & 31) * 4) = d; }
    } else if (sout) {
#pragma unroll
        for (int kb = 0; kb < 8; ++kb) {
            float* so = sout + (size_t)(16 * kb + 4 * g) * VD + w * NV * 16 + fr; asm volatile("" : "+v"(so));
#pragma unroll
            for (int nv = 0; nv < NV; ++nv)
#pragma unroll
                for (int i = 0; i < 4; ++i) so[i * VD + nv * 16] = S[kb][nv][i];
        }
    }
    __syncthreads();
}
constexpr int N_PHASES = 30;
__device__ __forceinline__ int queue_claim(Frame& F, unsigned* head) {
    __syncthreads();
    if (F.tid == 0) F.MISC[16] = __hip_atomic_fetch_add(head, 1u, __ATOMIC_RELAXED, __HIP_MEMORY_SCOPE_AGENT);
    __syncthreads();
    return (int)F.MISC[16];
}
__global__ void __launch_bounds__(512, 2) mega_fwd(Args args_byval) {
    KArgs args = (KArgs)__builtin_amdgcn_kernarg_segment_ptr(); (void)args_byval;
    extern __shared__ __attribute__((aligned(16))) unsigned char lds_raw[];
    Frame F;
    F.lds = (LAS unsigned char*)lds_raw; F.MISC = (volatile LAS unsigned*)(F.lds + MISC_OFF);
    F.tid = threadIdx.x; F.lane = F.tid & 63; F.wave = __builtin_amdgcn_readfirstlane(F.tid >> 6); F.G = gridDim.x; F.gw = blockIdx.x * 8 + F.wave; F.NGW = F.G * 8;
    F.ws = args->ws; F.ctl = (unsigned*)(args->ws + WS_CTL);
    for (int u = F.tid; u < (LDS_BYTES - MISC_OFF) / 4; u += 512) ((LAS unsigned*)(F.lds + MISC_OFF))[u] = 0u;
    __syncthreads();
    const int lo = args->ph_lo, hi = args->ph_hi;
    XcdBarrier bar; bar.bar = F.ctl + CW_BAR; bar.x = 0; bar.st = nullptr;
    if (hi - lo > 1) bar = xcd_barrier_post(F.ctl + CW_BAR, F.MISC + 8);
#ifdef MK_ONLY
#define INC(k, c) ((c) == MK_ONLY && lo <= (k) && (k) < hi)
#else
#define INC(k, c) (lo <= (k) && (k) < hi)
#endif
#define SEAM(k) do { if (hi > (k) + 1) xcd_barrier(bar); } while (0)

    const RowScale rsX{WSP(float, WS_SSQ), 16, 4, 1.f / 1024.f};
    const RowScale rsQ{WSP(float, WS_SSQCQ), 16, 3, 1.f / 384.f};
    const RowScale rsNone{nullptr, 0, 0, 0.f};

    if (INC(0, 0)) { asm volatile("" : "+s"(F.ws), "+s"(args)); p0_prologue(F, args); SEAM(0); }

    for (int l = 0; l < 4; ++l) {
        const int pb = 1 + 7 * l, eo = l >> 1;
        const float* resP = l == 0 ? IN_F(0) : WSP(float, WS_X); const float* resS = l == 0 ? IN_F(1) : WSP(float, WS_X) + (size_t)NP * D;
        if ((l & 1) == 0) {
            if (INC(pb, 1)) { asm volatile("" : "+s"(F.ws), "+s"(args));
                Gemm g{WSP(bf16_t, WS_XB), WSP(bf16_t, WS_WINE) + (size_t)eo * NE1 * 1024, 1024, 1024, NTOK, NE1, 1024}; StaticOrder S; S.init(NTOK, NE1, F.G, (int)blockIdx.x);
                EpiInEven E{WSP(bf16_t, WS_QH), WSP(bf16_t, WS_KK), WSP(float, WS_LOGF), WSP(bf16_t, WS_V), WSP(bf16_t, WS_G), WSP(float, WS_CKV), WSP(float, WS_KR), WSP(bf16_t, WS_CQ), WSP(float, WS_SSQCQ), WSP(float, WS_LBS) + eo * 512};
                gemm_phase<EpiInEven, true>(F.lds, g, S, E, rsX);
                SEAM(pb);
            }
            if (INC(pb + 1, 2)) { asm volatile("" : "+s"(F.ws), "+s"(args));
#ifndef MK_NOFIN
                finalize_rows(F, args, eo);
#endif
                Gemm g{WSP(bf16_t, WS_CQ), WSP(bf16_t, WS_WQ2) + (size_t)eo * NQ2 * 384, 384, 384, NTOK, NQ2, 384}; StaticOrder S; S.init(NTOK, NQ2, F.G, (int)blockIdx.x);
                EpiQ2 E{WSP(bf16_t, WS_QL), WSP(float, WS_ROPE)};
                gemm_phase<EpiQ2, true>(F.lds, g, S, E, rsQ);
                {
                    unsigned* head = F.ctl + CW_QUEUE + 64 * (l + 4 + 16 * args->qrep);
                    for (;;) { const int u = queue_claim(F, head); if (u >= 256) break; const int bh = u >> 3, seg = u & 7;
                        scan_unit<1, 0, false>(F, nullptr, nullptr, nullptr, WSP(float, WS_SEGH) + (size_t)(bh * 8 + seg) * 128 * 128, WSP(float, WS_SEGD) + (bh * 8 + seg) * 128, 0, KOE, (bh >> 2) * SEQ + seg * 256, 256, bh & 3); }
                }
                SEAM(pb + 1);
            }
            if (INC(pb + 2, 3)) { asm volatile("" : "+s"(F.ws), "+s"(args));
                unsigned* head = F.ctl + CW_QUEUE + 64 * (l + 16 * args->qrep);
                for (;;) {
                    const int u = queue_claim(F, head);
                    if (u >= 256 + 1024 + 128) break;
                    if (u < 256) { const int seg = 7 - (u >> 5), bh = u & 31;
                        scan_unit<1, 2, true>(F, IN_F(11) + eo * 128, nullptr, seg == 7 ? (args->out + OUT_HSP) + ((size_t)(eo * 32 + bh)) * 128 * 128 : nullptr,
                                              WSP(float, WS_SEGH) + (size_t)(bh * 8) * 128 * 128, WSP(float, WS_SEGD) + (bh * 8) * 128, seg, KOE, (bh >> 2) * SEQ + seg * 256, 256, bh & 3); }
                    else if (u < 256 + 1024) { const int j = u - 256, i = j >> 1;
                        if ((j & 1) == 0) attn_decode_unit(F, args, eo, i & 31, i >> 5);
                        else attn_prompt_unit(F, i & 7, 63 - (i >> 3)); }
                    else { const int j = u - 1280, bd = j >> 2, h = j & 3;
                        scan_unit<1, 1, true>(F, IN_F(11) + eo * 128, IN_F(3) + ((size_t)(eo * 32 + bd) * 4 + h) * 128 * 128, (args->out + OUT_HSS) + ((size_t)(eo * 32 + bd) * 4 + h) * 128 * 128, nullptr, nullptr, 0, KOE, NP + bd * DSEQ, DSEQ, h); }
                }
                SEAM(pb + 2);
            }
            if (INC(pb + 3, 4)) { asm volatile("" : "+s"(F.ws), "+s"(args)); attn_decode_combine(F); SEAM(pb + 3); }
            if (INC(pb + 4, 5)) { asm volatile("" : "+s"(F.ws), "+s"(args));
                Gemm g{WSP(bf16_t, WS_OA), WSP(bf16_t, WS_WOUTE) + (size_t)eo * 1024 * KOE, KOE, KOE, NTOK, 1024, KOE}; StaticOrder S; S.init(NTOK, 1024, F.G, (int)blockIdx.x);
                EpiOutRes E{resP, resS, WSP(float, WS_X), WSP(bf16_t, WS_XB), WSP(float, WS_SSQ)};
                gemm_phase<EpiOutRes, false>(F.lds, g, S, E, rsNone);
                SEAM(pb + 4);
            }
        } else {
            if (INC(pb, 6)) { asm volatile("" : "+s"(F.ws), "+s"(args));
                Gemm g{WSP(bf16_t, WS_XB), WSP(bf16_t, WS_WINO) + (size_t)eo * NO1 * 1024, 1024, 1024, NTOK, NO1, 1024}; StaticOrder S; S.init(NTOK, NO1, F.G, (int)blockIdx.x);
                EpiInOdd E{WSP(bf16_t, WS_QH), WSP(bf16_t, WS_KK), WSP(bf16_t, WS_V), WSP(bf16_t, WS_G), WSP(float, WS_LOGF), IN_F(20) + eo * 512};
                gemm_phase<EpiInOdd, true>(F.lds, g, S, E, rsX);
                SEAM(pb);
            }
            if (INC(pb + 1, 12)) { asm volatile("" : "+s"(F.ws), "+s"(args));
                unsigned* head = F.ctl + CW_QUEUE + 64 * (l + 4 + 16 * args->qrep);
                for (;;) { const int u = queue_claim(F, head); if (u >= 256) break; const int bh = u >> 3, seg = u & 7;
                    scan_unit<2, 0, false>(F, nullptr, nullptr, nullptr, WSP(float, WS_SEGH) + (size_t)(bh * 8 + seg) * 128 * 256, WSP(float, WS_SEGD) + (bh * 8 + seg) * 128, 0, 1024, (bh >> 2) * SEQ + seg * 256, 256, bh & 3); }
                SEAM(pb + 1);
            }
            if (INC(pb + 2, 7)) { asm volatile("" : "+s"(F.ws), "+s"(args));
                unsigned* head = F.ctl + CW_QUEUE + 64 * (l + 16 * args->qrep);
                for (;;) {
                    const int u = queue_claim(F, head);
                    if (u >= 256 + 128) break;
                    if (u < 256) { const int seg = 7 - (u >> 5), bh = u & 31;
                        scan_unit<2, 2, true>(F, IN_F(21) + eo * 256, nullptr, seg == 7 ? (args->out + OUT_GSP) + ((size_t)(eo * 32 + bh)) * 128 * 256 : nullptr,
                                              WSP(float, WS_SEGH) + (size_t)(bh * 8) * 128 * 256, WSP(float, WS_SEGD) + (bh * 8) * 128, seg, 1024, (bh >> 2) * SEQ + seg * 256, 256, bh & 3); }
                    else { const int j = u - 256, bd = j >> 2, h = j & 3;
                        scan_unit<2, 1, true>(F, IN_F(21) + eo * 256, IN_F(4) + ((size_t)(eo * 32 + bd) * 4 + h) * 128 * 256, (args->out + OUT_GSS) + ((size_t)(eo * 32 + bd) * 4 + h) * 128 * 256, nullptr, nullptr, 0, 1024, NP + bd * DSEQ, DSEQ, h); }
                }
                SEAM(pb + 2);
            }
            if (INC(pb + 4, 8)) { asm volatile("" : "+s"(F.ws), "+s"(args));
                Gemm g{WSP(bf16_t, WS_OA), WSP(bf16_t, WS_WOUTO) + (size_t)eo * 1024 * 1024, 1024, 1024, NTOK, 1024, 1024}; StaticOrder S; S.init(NTOK, 1024, F.G, (int)blockIdx.x);
                EpiOutRes E{resP, resS, WSP(float, WS_X), WSP(bf16_t, WS_XB), WSP(float, WS_SSQ)};
                gemm_phase<EpiOutRes, false>(F.lds, g, S, E, rsNone);
                SEAM(pb + 4);
            }
        }
        if (INC(pb + 5, 9)) { asm volatile("" : "+s"(F.ws), "+s"(args));
            Gemm g{WSP(bf16_t, WS_XB), WSP(bf16_t, WS_WUP) + (size_t)l * FF * 1024, 1024, 1024, NTOK, FF, 1024}; StaticOrder S; S.init(NTOK, FF, F.G, (int)blockIdx.x);
            EpiUp E{WSP(bf16_t, WS_FFB)};
            gemm_phase<EpiUp, true>(F.lds, g, S, E, rsX);
            SEAM(pb + 5);
        }
        if (INC(pb + 6, 10)) { asm volatile("" : "+s"(F.ws), "+s"(args));
            Gemm g{WSP(bf16_t, WS_FFB), WSP(bf16_t, WS_WDOWN) + (size_t)l * 1024 * FF, FF, FF, NTOK, 1024, FF}; StaticOrder S; S.init(NTOK, 1024, F.G, (int)blockIdx.x);
            EpiOutRes E{WSP(float, WS_X), WSP(float, WS_X) + (size_t)NP * D, WSP(float, WS_X), WSP(bf16_t, WS_XB), WSP(float, WS_SSQ)};
            gemm_phase<EpiOutRes, false>(F.lds, g, S, E, rsNone);
            SEAM(pb + 6);
        }
    }
    if (INC(29, 11)) { asm volatile("" : "+s"(F.ws), "+s"(args));
        const float* X = WSP(float, WS_X); const float* SSQ = WSP(float, WS_SSQ);
        for (int m = F.gw; m < NTOK; m += F.NGW) {
            const f32x4* sp = (const f32x4*)(SSQ + (size_t)m * 16); const f32x4 s0 = sp[0], s1 = sp[1], s2 = sp[2], s3 = sp[3];
            const float ss = ((s0[0] + s0[1]) + (s0[2] + s0[3])) + ((s1[0] + s1[1]) + (s1[2] + s1[3])) + ((s2[0] + s2[1]) + (s2[2] + s2[3])) + ((s3[0] + s3[1]) + (s3[2] + s3[3]));
            const float rs = rsqrtf(ss * (1.f / 1024.f) + EPS);
            float* od = m < NP ? (args->out + OUT_YP) + (size_t)m * D : (args->out + OUT_YS) + (size_t)(m - NP) * D;
#pragma unroll
            for (int j = 0; j < 4; ++j) { const int c = j * 256 + F.lane * 4; *(f32x4*)(od + c) = *(const f32x4*)(X + (size_t)m * D + c) * rs * *(const f32x4*)(IN_F(8) + c); }
        }
    }
#undef INC
#undef SEAM
}
#undef WSP
#undef IN_F
}

#ifndef MK_ONE_LAUNCH
#define MK_ONE_LAUNCH 0
#endif
static void mk_launch(void* const* d_in, void* d_out, void* d_ws, size_t ws_size, hipStream_t stream) {
    static int grid = 0;
    if (grid == 0) {
        int dev = 0, cus = 0, per_cu = 0;
        if (ws_size < mk::WS_END) { fprintf(stderr, "kernel_launch: workspace too small (%zu < %zu)\n", ws_size, (size_t)mk::WS_END); grid = -1; return; }
        if (hipGetDevice(&dev) != hipSuccess || hipDeviceGetAttribute(&cus, hipDeviceAttributeMultiprocessorCount, dev) != hipSuccess) { grid = -1; return; }
        if (hipFuncSetAttribute((const void*)mk::mega_fwd, hipFuncAttributeMaxDynamicSharedMemorySize, mk::LDS_BYTES) != hipSuccess) { fprintf(stderr, "kernel_launch: hipFuncSetAttribute failed\n"); grid = -1; return; }
        if (hipOccupancyMaxActiveBlocksPerMultiprocessor(&per_cu, (const void*)mk::mega_fwd, 512, mk::LDS_BYTES) != hipSuccess || per_cu < 1) { fprintf(stderr, "kernel_launch: occupancy query says %d blocks per CU\n", per_cu); }
        (void)hipGetLastError();
        grid = cus;
    }
    if (grid < 0) return;
    (void)hipMemsetAsync((char*)d_ws + mk::WS_CTL, 0, mk::CTL_BYTES, stream);
    mk::Args a{};
    for (int i = 0; i < 25; ++i) a.in[i] = d_in[i];
    a.out = (float*)d_out; a.ws = (unsigned char*)d_ws;
#if MK_ONE_LAUNCH
    a.ph_lo = 0; a.ph_hi = mk::N_PHASES;
    hipLaunchKernelGGL(mk::mega_fwd, dim3(grid), dim3(512), mk::LDS_BYTES, stream, a);
#else
    for (int p = 0; p < mk::N_PHASES; ++p) {
        int cls = p == 0 ? 0 : 11;
        if (p >= 1 && p < 29) { const int l = (p - 1) / 7, k = (p - 1) % 7; if ((l & 1) && k == 3) continue;
            static const int ce[7] = {1, 2, 3, 4, 5, 9, 10}, co[7] = {6, 12, 7, -1, 8, 9, 10}; cls = (l & 1) ? co[k] : ce[k]; }
        const int reps = 1 + ((MK_REPEAT >> cls) & 1);
        for (int r = 0; r < reps; ++r) { a.ph_lo = p; a.ph_hi = p + 1; a.qrep = r;
            hipLaunchKernelGGL(mk::mega_fwd, dim3(grid), dim3(512), mk::LDS_BYTES, stream, a); }
    }
#endif
}

extern "C" void kernel_launch(void* const* d_in, const int* in_sizes, int n_in, void* d_out, int out_size, void* d_ws, size_t ws_size, hipStream_t stream) {
    if (n_in != 25) { fprintf(stderr, "kernel_launch: unexpected n_in %d\n", n_in); return; }
    mk_launch(d_in, d_out, d_ws, ws_size, stream);
}
```

```cpp
#include <hip/hip_runtime.h>
#include <cstdio>
#include <cstdint>
#define MK_ONE_LAUNCH 1
#ifndef MK_REPEAT
#define MK_REPEAT 0
#endif
#define MK_PROBE_PART 7
namespace mk {
#define LAS __attribute__((address_space(3)))
typedef unsigned short bf16_t;
typedef short bf16x8 __attribute__((ext_vector_type(8)));
typedef short s16x4 __attribute__((ext_vector_type(4)));
typedef float f32x4 __attribute__((ext_vector_type(4)));
typedef unsigned u32x4 __attribute__((ext_vector_type(4)));
typedef unsigned u32x2 __attribute__((ext_vector_type(2)));

constexpr int D = 1024, NP = 16384, NS = 256, NTOK = NP + NS, SEQ = 2048, DSEQ = 8, PAST = 16384, PAGE = 128, NPAGES = 128, NPHYS = 5120;
constexpr int FF = 4096, LAT = 320, QL_LD = 1280, NE1 = 2816, NQ2 = 1280, KOE = 1536, NO1 = 3584;
constexpr int NSPLIT = 16, NSE = 2 * NSPLIT;
constexpr float EPS = 1e-6f;
constexpr float QSCALE = 0.07216878364870322f * 1.4426950408889634f;

constexpr size_t MiB = 1u << 20;
constexpr size_t WS_CTL = 0, CTL_BYTES = 2 * MiB;
constexpr size_t WS_WINE = 2 * MiB;
constexpr size_t WS_WQ2 = WS_WINE + 2ull * NE1 * 1024 * 2;
constexpr size_t WS_WOUTE = WS_WQ2 + 2ull * NQ2 * 384 * 2;
constexpr size_t WS_WINO = WS_WOUTE + 2ull * 1024 * KOE * 2;
constexpr size_t WS_WOUTO = WS_WINO + 2ull * NO1 * 1024 * 2;
constexpr size_t WS_WUP = WS_WOUTO + 2ull * 1024 * 1024 * 2;
constexpr size_t WS_WDOWN = WS_WUP + 4ull * FF * 1024 * 2;
constexpr size_t WS_LBS = WS_WDOWN + 4ull * FF * 1024 * 2;
constexpr size_t WS_ROPE = WS_LBS + 4096;
constexpr size_t WS_X = (WS_ROPE + 2056ull * 64 * 4 + 4095) & ~(size_t)4095;
constexpr size_t WS_XB = WS_X + (size_t)NTOK * D * 4;
constexpr size_t WS_SSQ = WS_XB + (size_t)NTOK * D * 2;
constexpr size_t WS_QH = WS_SSQ + (size_t)NTOK * 16 * 4;
constexpr size_t WS_KK = WS_QH + (size_t)NTOK * 512 * 2;
constexpr size_t WS_LOGF = WS_KK + (size_t)NTOK * 512 * 2;
constexpr size_t WS_V = WS_LOGF + (size_t)NTOK * 512 * 4;
constexpr size_t WS_G = WS_V + (size_t)NTOK * 1024 * 2;
constexpr size_t WS_CKV = WS_G + (size_t)NTOK * 1024 * 2;
constexpr size_t WS_KR = WS_CKV + (size_t)NTOK * 256 * 4;
constexpr size_t WS_CQ = WS_KR + (size_t)NTOK * 64 * 4;
constexpr size_t WS_SSQCQ = WS_CQ + (size_t)NTOK * 384 * 2;
constexpr size_t WS_KVL = WS_SSQCQ + (size_t)NTOK * 16 * 4;
constexpr size_t WS_QL = WS_KVL + (size_t)NTOK * LAT * 2;
constexpr size_t WS_OA = WS_QL + (size_t)NTOK * QL_LD * 2;
constexpr size_t WS_FFB = WS_OA + (size_t)NTOK * KOE * 2;
constexpr size_t WS_PO = WS_FFB + (size_t)NTOK * FF * 2;
constexpr size_t WS_PML = WS_PO + 32ull * NSE * 32 * 256 * 4;
constexpr size_t WS_SEGH = WS_PML + 32ull * NSE * 32 * 2 * 4;
constexpr size_t WS_SEGD = WS_SEGH + 32ull * 8 * 128 * 256 * 4;
constexpr size_t WS_PQ = WS_SEGD + 32ull * 8 * 128 * 4;
constexpr size_t WS_END = WS_PQ + 4ull * 256 * 1024 * 4;
constexpr int CW_BAR = 4096;
constexpr int CW_QUEUE = 16384;
constexpr int CW_DEP = 24576;

constexpr int RING_BYTES = 131072, PRO_BYTES = 8 * 17408  , SCL_OFF = PRO_BYTES  , MISC_OFF = SCL_OFF + 2048, LDS_BYTES = MISC_OFF + 2048;

__device__ __forceinline__ unsigned cvt_pk_bf16(float lo, float hi) { unsigned r; asm volatile("v_cvt_pk_bf16_f32 %0, %1, %2" : "=v"(r) : "v"(lo), "v"(hi)); return r; }
__device__ __forceinline__ float bf2f(bf16_t b) { return __uint_as_float(((unsigned)b) << 16); }
__device__ __forceinline__ float bflo(unsigned w) { return __uint_as_float(w << 16); }
__device__ __forceinline__ float bfhi(unsigned w) { return __uint_as_float(w & 0xffff0000u); }
__device__ __forceinline__ float fexp2(float x) { return __builtin_amdgcn_exp2f(x); }
__device__ __forceinline__ float fexp(float x) { return __builtin_amdgcn_exp2f(x * 1.4426950408889634f); }
__device__ __forceinline__ float frcp(float x) { return __builtin_amdgcn_rcpf(x); }
__device__ __forceinline__ float sigm(float x) { return frcp(1.f + fexp(-x)); }
__device__ __forceinline__ float wave_sum(float v) {
#pragma unroll
    for (int o = 1; o < 64; o <<= 1) v += __shfl_xor(v, o);
    return v;
}
__device__ __forceinline__ int rope_idx(int row) { return row < NP ? (row & (SEQ - 1)) : SEQ + ((row - NP) & (DSEQ - 1)); }


__device__ __forceinline__ void st_wt16(void* p, u32x4 v) { asm volatile("global_store_dwordx4 %0, %1, off sc1" :: "v"(p), "v"(v) : "memory"); }
__device__ __forceinline__ void st_wt8(void* p, u32x2 v) { asm volatile("global_store_dwordx2 %0, %1, off sc1" :: "v"(p), "v"(v) : "memory"); }
__device__ __forceinline__ void st_wt4(void* p, unsigned v) { asm volatile("global_store_dword %0, %1, off sc1" :: "v"(p), "v"(v) : "memory"); }
__device__ __forceinline__ void st_wt2(void* p, unsigned v) { asm volatile("global_store_short %0, %1, off sc1" :: "v"(p), "v"(v) : "memory"); }
template <bool WT> __device__ __forceinline__ void st16(void* p, u32x4 v) { if constexpr (WT) st_wt16(p, v); else *(u32x4*)p = v; }
template <bool WT> __device__ __forceinline__ void st16f(void* p, f32x4 v) { st16<WT>(p, __builtin_bit_cast(u32x4, v)); }

#define XB_TMO      128
#define XB_XCNT(j)  (256  + 64 * (j))
#define XB_XSUB(j)  (1280 + 64 * (j))
#define XB_XGEN(j)  (2304 + 64 * (j))
#define XB_TOP      3328
#define XB_TOPGEN   3392
#define XCD_BAR_WORDS 3456
#define XB_SPIN_CAP (1u << 18)
__device__ __forceinline__ unsigned xb_ld(unsigned* p)              { return __hip_atomic_load(p, __ATOMIC_RELAXED, __HIP_MEMORY_SCOPE_AGENT); }
__device__ __forceinline__ unsigned xb_add(unsigned* p, unsigned v) { return __hip_atomic_fetch_add(p, v, __ATOMIC_RELAXED, __HIP_MEMORY_SCOPE_AGENT); }
__device__ __forceinline__ unsigned xb_xcc_id() { return (unsigned)__builtin_amdgcn_s_getreg((3 << 11) | 20) & 0xFu; }
#define XB_SPIN(cond, bar) do { unsigned _sp = 0; while (cond) { __builtin_amdgcn_s_sleep(1); \
    if ((++_sp & 255u) == 0u) { if (xb_ld(&(bar)[XB_TMO])) break; if (_sp > XB_SPIN_CAP) { atomicAdd(&(bar)[XB_TMO], 1u); break; } } } } while (0)
struct XcdBarrier { unsigned* bar; unsigned x; volatile LAS unsigned* st; };
__device__ __forceinline__ XcdBarrier xcd_barrier_post(unsigned* bar, volatile LAS unsigned* st) {
    XcdBarrier b; b.bar = bar; b.x = xb_xcc_id(); b.st = st;
    if (threadIdx.x == 0) (void)xb_add(&bar[XB_XCNT(b.x)], 1u);
    return b;
}
__device__ __forceinline__ void xcd_barrier_complete(unsigned* bar, unsigned x, unsigned& nloc, unsigned& nx) {
    const unsigned G = gridDim.x * gridDim.y * gridDim.z;
    unsigned sum, cnt, mine, sp = 0u;
    for (;;) {
        sum = 0u; cnt = 0u; mine = 0u;
#pragma unroll
        for (unsigned j = 0; j < 16; ++j) { const unsigned c = xb_ld(&bar[XB_XCNT(j)]); sum += c; cnt += (c > 0u) ? 1u : 0u; mine = (j == x) ? c : mine; }
        if (sum == G) break;
        __builtin_amdgcn_s_sleep(1);
        if ((++sp & 255u) == 0u) { if (xb_ld(&bar[XB_TMO])) break; if (sp > XB_SPIN_CAP) { atomicAdd(&bar[XB_TMO], 1u); break; } }
    }
    nloc = mine > 0u ? mine : 1u; nx = cnt > 0u ? cnt : 1u;
}
__device__ __forceinline__ void xcd_barrier(const XcdBarrier& b) {
    asm volatile("s_waitcnt vmcnt(0)" ::: "memory");
    __syncthreads();
    if (threadIdx.x == 0) {
        unsigned* bar = b.bar;
        __builtin_amdgcn_s_waitcnt(0);
        unsigned nloc = b.st[0], nx = b.st[1];
        if (nloc == 0u) { xcd_barrier_complete(bar, b.x, nloc, nx); b.st[0] = nloc; b.st[1] = nx; }
        const unsigned old = xb_add(&bar[XB_XSUB(b.x)], 1u);
        const unsigned gen = old / nloc;
        if (old + 1u == (gen + 1u) * nloc) {
            __builtin_amdgcn_fence(__ATOMIC_RELEASE, "agent");
            asm volatile("s_waitcnt vmcnt(0)" ::: "memory");
            const unsigned og = xb_add(&bar[XB_TOP], 1u);
            const unsigned tg = og / nx;
            if (og + 1u == (tg + 1u) * nx) xb_add(&bar[XB_TOPGEN], 1u);
            else XB_SPIN(xb_ld(&bar[XB_TOPGEN]) == tg, bar);
            __builtin_amdgcn_fence(__ATOMIC_ACQUIRE, "agent");
            xb_add(&bar[XB_XGEN(b.x)], 1u);
            asm volatile("s_waitcnt vmcnt(0)" ::: "memory");
        } else {
            XB_SPIN(xb_ld(&bar[XB_XGEN(b.x)]) == gen, bar);
            __builtin_amdgcn_fence(__ATOMIC_ACQUIRE, "agent");
            asm volatile("s_waitcnt vmcnt(0)" ::: "memory");
        }
    }
    __syncthreads();
}


__device__ __forceinline__ void dep_publish(unsigned* cnt) {
    asm volatile("s_waitcnt vmcnt(0)" ::: "memory");
    __syncthreads();
    if (threadIdx.x == 0) { __builtin_amdgcn_fence(__ATOMIC_RELEASE, "agent"); asm volatile("s_waitcnt vmcnt(0)" ::: "memory"); (void)xb_add(cnt, 1u); }
}
__device__ __forceinline__ void dep_wait(unsigned* cnt, unsigned need, unsigned* tmo) {
    if (threadIdx.x == 0) { unsigned sp = 0;
        while (xb_ld(cnt) < need) { __builtin_amdgcn_s_sleep(127); __builtin_amdgcn_s_sleep(127);
            if ((++sp & 63u) == 0u) { if (xb_ld(tmo)) break; if (sp > (1u << 14)) { atomicAdd(tmo, 1u); break; } } }
        __builtin_amdgcn_fence(__ATOMIC_ACQUIRE, "agent"); asm volatile("s_waitcnt vmcnt(0)" ::: "memory"); }
    __syncthreads();
}

constexpr int BM = 256, BK = 64, HALF = 128, HTB = HALF * BK * 2, NXCD = 8, WGM = 8;
__host__ __device__ __forceinline__ int lds_byte(int r, int c) { const int st = (r >> 4) * 2 + (c >> 5), rr = r & 15, cc = c & 31, ob = rr * 64 + cc * 2; return st * 1024 + (ob ^ (((ob >> 9) & 1) << 5)); }
__host__ __device__ __forceinline__ void stage_rc(int b, int& R, int& C) { const int st = b / 1024, sb = b % 1024, swz = sb ^ (((sb >> 9) & 1) << 5); R = (st >> 1) * 16 + swz / 64; C = (st & 1) * 32 + (swz % 64) / 2; }
__host__ __device__ __forceinline__ int perm32(int rho) { const int n = rho >> 4, i = rho & 15; return 8 * (i >> 2) + 4 * n + (i & 3); }
struct Unit { int pm, pn, idx; };
struct Gemm { const bf16_t* A; const bf16_t* Bt; int lda, ldb, M, N, K; };
struct RowScale { const float* part; int stride, np4; float inv_n; unsigned* dep; unsigned need; unsigned* tmo; };
struct StaticOrder {
    int nM, nN, nwg, G, c;
    __device__ void init(int M, int N, int G_, int c_) { nM = M / BM; nN = N / BM; nwg = nM * nN; G = G_; c = c_; }
    __device__ bool next(int i, Unit& u) const {
        const long L = (long)i * G + c; if (L >= nwg) return false;
        int wgid = (int)L; { const int q = nwg / NXCD, r = nwg % NXCD, xcd = wgid % NXCD, off = wgid / NXCD; wgid = (xcd < r ? xcd * (q + 1) : r * (q + 1) + (xcd - r) * q) + off; }
        const int nig = WGM * nN, gid = wgid / nig, fm = gid * WGM, gsz = (nM - fm) < WGM ? (nM - fm) : WGM;
        u.pm = fm + ((wgid % nig) % gsz); u.pn = (wgid % nig) / gsz; u.idx = i; return true;
    }
};
template <bool SCALE>
__device__ __forceinline__ void rs_fill(LAS unsigned char* ldsbase, const RowScale& rs, const Unit& u, int tid) {
    if constexpr (SCALE) {
        if (rs.dep && u.pm == 64) dep_wait(rs.dep, rs.need, rs.tmo);
        if (tid < 256) {
            const f32x4* p = (const f32x4*)(rs.part + (size_t)(u.pm * BM + tid) * rs.stride); float s = 0.f;
            for (int j = 0; j < rs.np4; ++j) { const f32x4 v = p[j]; s += (v[0] + v[1]) + (v[2] + v[3]); }
            ((LAS float*)(ldsbase + SCL_OFF))[(u.idx & 1) * 256 + tid] = rsqrtf(s * rs.inv_n + EPS);
        }
    }
}
struct OneUnit { int pm, pn; __device__ bool next(int i, Unit& u) const { if (i) return false; u.pm = pm; u.pn = pn; u.idx = 0; return true; } };
template <class Epi, bool SCALE, class Sched = StaticOrder>
__device__ __forceinline__ void gemm_phase(LAS unsigned char* lds, const Gemm g, const Sched& S, const Epi& E, const RowScale rs) {
    int tid = threadIdx.x; asm volatile("" : "+v"(tid));
    const int wid = __builtin_amdgcn_readfirstlane(tid >> 6), lane = tid & 63, wr = wid >> 2, wc = wid & 3, fr = lane & 15, fq = lane >> 4;
    const int K = g.K, nt = K / BK;
    unsigned voffA[2], voffB[2];
#pragma unroll
    for (int i = 0; i < 2; ++i) { int R, C; stage_rc(tid * 16 + i * 8192, R, C); const int Rb = (R & ~31) + perm32(R & 31);
        voffA[i] = (unsigned)(R * g.lda + C) * 2u; voffB[i] = (unsigned)(Rb * g.ldb + C) * 2u; }
    const size_t kstep = (size_t)(BK * 2);
    const size_t hstepA = (size_t)HALF * g.lda * 2, hstepB = (size_t)HALF * g.ldb * 2;
    const size_t tstepA = 2 * hstepA, tstepB = 2 * hstepB;
    const unsigned ldsw = (unsigned)wid * 1024u;
    const int aoff = lds_byte(wr * 64 + fr, fq * 8), boff = lds_byte(wc * 32 + fr, fq * 8);
#define PG8_SA(b, h) (((b) * 2 + (h)) * HTB)
#define PG8_SB(b, h) ((4 + (b) * 2 + (h)) * HTB)
#define PG8_STAGE(bufoff, gbase, voff) do { _Pragma("unroll") for (int _i = 0; _i < 2; ++_i) \
        __builtin_amdgcn_global_load_lds((const unsigned*)((const char*)(gbase) + (voff)[_i]), (LAS unsigned*)(lds + (bufoff) + ldsw + _i * 8192), 16, 0, 0); } while (0)
#define PG8_LDA(dst, b, h) do { _Pragma("unroll") for (int m = 0; m < 4; ++m) _Pragma("unroll") for (int k = 0; k < 2; ++k) dst[m][k] = *(const LAS bf16x8*)(lds + PG8_SA(b, h) + aoff + m * 2048 + k * 1024); } while (0)
#define PG8_LDB(dst, b, h) do { _Pragma("unroll") for (int n = 0; n < 2; ++n) _Pragma("unroll") for (int k = 0; k < 2; ++k) dst[n][k] = *(const LAS bf16x8*)(lds + PG8_SB(b, h) + boff + n * 2048 + k * 1024); } while (0)
#define PG8_MMA(ai, bj, At, Bt) do { __builtin_amdgcn_s_setprio(1); _Pragma("unroll") for (int m = 0; m < 4; ++m) _Pragma("unroll") for (int n = 0; n < 2; ++n) _Pragma("unroll") for (int k = 0; k < 2; ++k) \
        acc[ai][bj][m][n] = __builtin_amdgcn_mfma_f32_16x16x32_bf16(Bt[n][k], At[m][k], acc[ai][bj][m][n], 0, 0, 0); __builtin_amdgcn_s_setprio(0); } while (0)
#define PG8_WAIT_V(n) asm volatile("s_waitcnt vmcnt(" #n ")" ::: "memory")
#define PG8_WAIT_L(n) asm volatile("s_waitcnt lgkmcnt(" #n ")" ::: "memory")
#define PG8_BAR __builtin_amdgcn_s_barrier()
#define PG8_SCHED __builtin_amdgcn_sched_barrier(0)
    Unit cur, nxt; int ui = 0;
    if (!S.next(0, cur)) return;
    f32x4 acc[2][2][4][2];
#pragma unroll
    for (int a = 0; a < 2; ++a)
#pragma unroll
        for (int b = 0; b < 2; ++b)
#pragma unroll
            for (int m = 0; m < 4; ++m)
#pragma unroll
                for (int n = 0; n < 2; ++n) acc[a][b][m][n] = (f32x4){0.f, 0.f, 0.f, 0.f};
    bf16x8 At[4][2], B0[2][2], B1[2][2];
    const char* cA = (const char*)g.A + (size_t)cur.pm * tstepA; const char* cB = (const char*)g.Bt + (size_t)cur.pn * tstepB;
    rs_fill<SCALE>(lds, rs, cur, tid);
    PG8_STAGE(PG8_SB(0, 0), cB, voffB); PG8_STAGE(PG8_SB(0, 1), cB + hstepB, voffB); PG8_STAGE(PG8_SA(0, 0), cA, voffA); PG8_STAGE(PG8_SA(0, 1), cA + hstepA, voffA);
    if (wr == 1) PG8_BAR;
    PG8_WAIT_V(2); PG8_BAR;
    PG8_STAGE(PG8_SB(1, 0), cB + kstep, voffB); PG8_STAGE(PG8_SA(1, 0), cA + kstep, voffA); PG8_STAGE(PG8_SB(1, 1), cB + hstepB + kstep, voffB);
    PG8_WAIT_V(6); PG8_BAR;
    for (;;) {
        const bool has_next = S.next(ui + 1, nxt);
        const char* nA = has_next ? (const char*)g.A + (size_t)nxt.pm * tstepA : cA; const char* nB = has_next ? (const char*)g.Bt + (size_t)nxt.pn * tstepB : cB;
#pragma unroll 1
        for (int t = 0; t < nt; t += 2) {
            const bool last = (t == nt - 2);
            const char* a1 = cA + (size_t)(t + 1) * kstep;
            const char* a2 = last ? nA : cA + (size_t)(t + 2) * kstep; const char* b2 = last ? nB : cB + (size_t)(t + 2) * kstep;
            const char* a3 = a2 + kstep; const char* b3 = b2 + kstep;
            if (last && has_next) rs_fill<SCALE>(lds, rs, nxt, tid);
            PG8_LDB(B0, 0, 0); PG8_LDB(B1, 0, 1); PG8_SCHED; PG8_LDA(At, 0, 0); PG8_STAGE(PG8_SA(1, 1), a1 + hstepA, voffA);
            PG8_WAIT_V(8); PG8_WAIT_L(0); PG8_BAR; PG8_MMA(0, 0, At, B0); PG8_MMA(0, 1, At, B1); PG8_BAR; PG8_SCHED;
            PG8_LDA(At, 0, 1); PG8_STAGE(PG8_SB(0, 0), b2, voffB); PG8_STAGE(PG8_SB(0, 1), b2 + hstepB, voffB); PG8_STAGE(PG8_SA(0, 0), a2, voffA);
            PG8_WAIT_V(8); PG8_WAIT_L(0); PG8_BAR; PG8_MMA(1, 0, At, B0); PG8_MMA(1, 1, At, B1); PG8_BAR; PG8_SCHED;
            PG8_LDB(B0, 1, 0); PG8_LDB(B1, 1, 1); PG8_SCHED; PG8_LDA(At, 1, 0); PG8_STAGE(PG8_SA(0, 1), a2 + hstepA, voffA);
            PG8_WAIT_V(8); PG8_WAIT_L(0); PG8_BAR; PG8_MMA(0, 0, At, B0); PG8_MMA(0, 1, At, B1); PG8_BAR; PG8_SCHED;
            PG8_LDA(At, 1, 1); PG8_STAGE(PG8_SB(1, 0), b3, voffB); PG8_STAGE(PG8_SB(1, 1), b3 + hstepB, voffB); PG8_STAGE(PG8_SA(1, 0), a3, voffA);
            PG8_WAIT_V(8); PG8_WAIT_L(0); PG8_BAR; PG8_MMA(1, 0, At, B0); PG8_MMA(1, 1, At, B1); PG8_BAR; PG8_SCHED;
        }
        if (wr == 0) PG8_BAR;
        { int fr_ = fr, fq_ = fq; asm volatile("" : "+v"(fr_), "+v"(fq_));
          E(acc, cur, wr, wc, fr_, fq_, (const LAS float*)(lds + SCL_OFF) + (cur.idx & 1) * 256); }
        if (!has_next) break;
#pragma unroll
        for (int a = 0; a < 2; ++a)
#pragma unroll
            for (int b = 0; b < 2; ++b)
#pragma unroll
                for (int m = 0; m < 4; ++m)
#pragma unroll
                    for (int n = 0; n < 2; ++n) acc[a][b][m][n] = (f32x4){0.f, 0.f, 0.f, 0.f};
        cur = nxt; cA = nA; cB = nB; ++ui;
        if (wr == 1) PG8_BAR;
    }
    PG8_WAIT_V(0);
    PG8_BAR;
#undef PG8_SA
#undef PG8_SB
#undef PG8_STAGE
#undef PG8_LDA
#undef PG8_LDB
#undef PG8_MMA
#undef PG8_WAIT_V
#undef PG8_WAIT_L
#undef PG8_BAR
#undef PG8_SCHED
}

#define EPI_ROWS_BEGIN  _Pragma("unroll") for (int ai = 0; ai < 2; ++ai) _Pragma("unroll") for (int m = 0; m < 4; ++m) { \
        const int rl = ai * HALF + wr * 64 + m * 16 + fr; const int row = u.pm * BM + rl; (void)row;
#define EPI_ROWS_END asm volatile("" ::: "memory"); }
template <bool WT = false> __device__ __forceinline__ void st_bf8(bf16_t* p, const f32x4 a, const f32x4 b) { u32x4 w; w.x = cvt_pk_bf16(a[0], a[1]); w.y = cvt_pk_bf16(a[2], a[3]); w.z = cvt_pk_bf16(b[0], b[1]); w.w = cvt_pk_bf16(b[2], b[3]); st16<WT>(p, w); }
__device__ __forceinline__ float sq8(const f32x4 a, const f32x4 b) { return (a[0] * a[0] + a[1] * a[1]) + (a[2] * a[2] + a[3] * a[3]) + (b[0] * b[0] + b[1] * b[1]) + (b[2] * b[2] + b[3] * b[3]); }
__device__ __forceinline__ float silu1(float x) { return x * frcp(1.f + fexp(-x)); }

struct EpiInEven {
    bf16_t* Qh; bf16_t* KK; float* LOGF; bf16_t* V; bf16_t* G; float* CKV; float* KR; bf16_t* CQ; float* SSQCQ; const float* lbs;
    __device__ __forceinline__ void operator()(const f32x4 (&acc)[2][2][4][2], const Unit& u, int wr, int wc, int fr, int fq, const LAS float* scl) const {
        const int pn = u.pn;
        EPI_ROWS_BEGIN
            const float s = scl[rl];
#pragma unroll
            for (int bj = 0; bj < 2; ++bj) {
                const int cl = bj * HALF + wc * 32 + 8 * fq;
                f32x4 a = acc[ai][bj][m][0] * s, b = acc[ai][bj][m][1] * s;
                if (pn < 2) {
#pragma unroll
                    for (int j = 0; j < 4; ++j) { a[j] = silu1(a[j]) * 0.08838834764831845f; b[j] = silu1(b[j]) * 0.08838834764831845f; }
                    st_bf8(Qh + (size_t)row * 512 + pn * 256 + cl, a, b);
                } else if (pn < 4) {
                    const int c = (pn - 2) * 256 + cl; const f32x4 l0 = *(const f32x4*)(lbs + c), l1 = *(const f32x4*)(lbs + c + 4);
                    f32x4 lf0, lf1, k0, k1;
#pragma unroll
                    for (int j = 0; j < 4; ++j) {
                        { const float z = a[j], lb = l0[j], sp = sigm(z), sn = sigm(-z); lf0[j] = __logf(fmaxf(lb + (1.f - lb) * sp, 1e-30f)); k0[j] = (1.f - lb) * sn; }
                        { const float z = b[j], lb = l1[j], sp = sigm(z), sn = sigm(-z); lf1[j] = __logf(fmaxf(lb + (1.f - lb) * sp, 1e-30f)); k1[j] = (1.f - lb) * sn; }
                    }
                    *(f32x4*)(LOGF + (size_t)row * 512 + c) = lf0; *(f32x4*)(LOGF + (size_t)row * 512 + c + 4) = lf1;
                    st_bf8(KK + (size_t)row * 512 + c, k0, k1);
                } else if (pn < 6) {
                    st_bf8(V + (size_t)row * 512 + (pn - 4) * 256 + cl, a, b);
                } else if (pn < 8) {
#pragma unroll
                    for (int j = 0; j < 4; ++j) { a[j] = silu1(a[j]); b[j] = silu1(b[j]); }
                    st_bf8(G + (size_t)row * 512 + (pn - 6) * 256 + cl, a, b);
                } else if (pn == 8) {
                    *(f32x4*)(CKV + (size_t)row * 256 + cl) = a; *(f32x4*)(CKV + (size_t)row * 256 + cl + 4) = b;
                } else if (pn == 9 || bj == 0) {
                    const int c = (pn - 9) * 256 + cl;
                    st_bf8(CQ + (size_t)row * 384 + c, a, b);
                    float ss = sq8(a, b); ss += __shfl_xor(ss, 16); ss += __shfl_xor(ss, 32);
                    if (fq == 0) SSQCQ[(size_t)row * 16 + (pn == 9 ? bj * 4 + wc : 8 + wc)] = ss;
                } else if (wc < 2) {
                    const int c = wc * 32 + 8 * fq;
                    *(f32x4*)(KR + (size_t)row * 64 + c) = a; *(f32x4*)(KR + (size_t)row * 64 + c + 4) = b;
                }
            }
        EPI_ROWS_END
    }
};
struct EpiQ2 {
    bf16_t* QL; const float* rope;
    __device__ __forceinline__ void operator()(const f32x4 (&acc)[2][2][4][2], const Unit& u, int wr, int wc, int fr, int fq, const LAS float* scl) const {
        const int pn = u.pn;
        if (pn < 4) {
            EPI_ROWS_BEGIN
                const float s = scl[rl]; bf16_t* dst = QL + (size_t)row * QL_LD + pn * LAT + wc * 32 + 8 * fq;
                st_bf8(dst, acc[ai][0][m][0] * s, acc[ai][0][m][1] * s); st_bf8(dst + HALF, acc[ai][1][m][0] * s, acc[ai][1][m][1] * s);
            EPI_ROWS_END
        } else {
            const int g = (wc & 1) * 4 + fq;
            EPI_ROWS_BEGIN
                const float s = scl[rl]; const float* rp = rope + rope_idx(row) * 64 + 4 * g;
                const f32x4 c = *(const f32x4*)rp, sn = *(const f32x4*)(rp + 32);
#pragma unroll
                for (int bj = 0; bj < 2; ++bj) {
                    const f32x4 a = acc[ai][bj][m][0] * s, b = acc[ai][bj][m][1] * s, o1 = a * c - b * sn, o2 = a * sn + b * c;
                    bf16_t* dst = QL + (size_t)row * QL_LD + (bj * 2 + (wc >> 1)) * LAT + 256 + 4 * g;
                    u32x2 w1, w2; w1.x = cvt_pk_bf16(o1[0], o1[1]); w1.y = cvt_pk_bf16(o1[2], o1[3]); w2.x = cvt_pk_bf16(o2[0], o2[1]); w2.y = cvt_pk_bf16(o2[2], o2[3]);
                    *(u32x2*)dst = w1; *(u32x2*)(dst + 32) = w2;
                }
            EPI_ROWS_END
        }
    }
};
template <bool WT> struct EpiOutRes {
    const float* resP; const float* resS; float* X; bf16_t* XB; float* SSQ;
    __device__ __forceinline__ void operator()(const f32x4 (&acc)[2][2][4][2], const Unit& u, int wr, int wc, int fr, int fq, const LAS float* scl) const {
        EPI_ROWS_BEGIN
            const float* rr = row < NP ? resP + (size_t)row * D : resS + (size_t)(row - NP) * D;
            float ss = 0.f;
#pragma unroll
            for (int bj = 0; bj < 2; ++bj) {
                const int c = u.pn * BM + bj * HALF + wc * 32 + 8 * fq;
                const f32x4 a = acc[ai][bj][m][0] + *(const f32x4*)(rr + c), b = acc[ai][bj][m][1] + *(const f32x4*)(rr + c + 4);
                st16f<WT>(X + (size_t)row * D + c, a); st16f<WT>(X + (size_t)row * D + c + 4, b);
                st_bf8<WT>(XB + (size_t)row * D + c, a, b);
                ss += sq8(a, b);
            }
            ss += __shfl_xor(ss, 16); ss += __shfl_xor(ss, 32);
            if (fq == 0) { if constexpr (WT) st_wt4(SSQ + (size_t)row * 16 + u.pn * 4 + wc, __float_as_uint(ss)); else SSQ[(size_t)row * 16 + u.pn * 4 + wc] = ss; }
        EPI_ROWS_END
    }
};
template <bool WT> struct EpiUp {
    bf16_t* FFB;
    __device__ __forceinline__ void operator()(const f32x4 (&acc)[2][2][4][2], const Unit& u, int wr, int wc, int fr, int fq, const LAS float* scl) const {
        EPI_ROWS_BEGIN
            const float s = scl[rl];
#pragma unroll
            for (int bj = 0; bj < 2; ++bj) {
                f32x4 a = acc[ai][bj][m][0] * s, b = acc[ai][bj][m][1] * s;
#pragma unroll
                for (int j = 0; j < 4; ++j) { const float x = fmaxf(a[j], 0.f), y = fmaxf(b[j], 0.f); a[j] = x * x; b[j] = y * y; }
                st_bf8<WT>(FFB + (size_t)row * FF + u.pn * BM + bj * HALF + wc * 32 + 8 * fq, a, b);
            }
        EPI_ROWS_END
    }
};
struct EpiPart {
    float* P;
    __device__ __forceinline__ void operator()(const f32x4 (&acc)[2][2][4][2], const Unit& u, int wr, int wc, int fr, int fq, const LAS float* scl) const {
        EPI_ROWS_BEGIN
#pragma unroll
            for (int bj = 0; bj < 2; ++bj) { float* d = P + (size_t)(row - NP) * D + u.pn * BM + bj * HALF + wc * 32 + 8 * fq; *(f32x4*)d = acc[ai][bj][m][0]; *(f32x4*)(d + 4) = acc[ai][bj][m][1]; }
        EPI_ROWS_END
    }
};
struct EpiInOdd {
    bf16_t* Qh; bf16_t* KK; bf16_t* V; bf16_t* G; float* LOGF; const float* ba;
    __device__ __forceinline__ void operator()(const f32x4 (&acc)[2][2][4][2], const Unit& u, int wr, int wc, int fr, int fq, const LAS float* scl) const {
        const int pn = u.pn;
        EPI_ROWS_BEGIN
            const float s = scl[rl];
#pragma unroll
            for (int bj = 0; bj < 2; ++bj) {
                const int cl = bj * HALF + wc * 32 + 8 * fq;
                f32x4 a = acc[ai][bj][m][0] * s, b = acc[ai][bj][m][1] * s;
                if (pn < 2) { a = a * 0.08838834764831845f; b = b * 0.08838834764831845f; st_bf8(Qh + (size_t)row * 512 + pn * 256 + cl, a, b); }
                else if (pn < 4) st_bf8(KK + (size_t)row * 512 + (pn - 2) * 256 + cl, a, b);
                else if (pn < 8) st_bf8(V + (size_t)row * 1024 + (pn - 4) * 256 + cl, a, b);
                else if (pn < 12) {
#pragma unroll
                    for (int j = 0; j < 4; ++j) { a[j] = silu1(a[j]); b[j] = silu1(b[j]); }
                    st_bf8(G + (size_t)row * 1024 + (pn - 8) * 256 + cl, a, b);
                } else {
                    const int c = (pn - 12) * 256 + cl; const f32x4 b0 = *(const f32x4*)(ba + c), b1 = *(const f32x4*)(ba + c + 4);
                    f32x4 l0, l1;
#pragma unroll
                    for (int j = 0; j < 4; ++j) {
                        { const float x = a[j] + b0[j]; l0[j] = (fminf(x, 0.f) - __logf(1.f + fexp(-fabsf(x)))) * 0.0625f; }
                        { const float x = b[j] + b1[j]; l1[j] = (fminf(x, 0.f) - __logf(1.f + fexp(-fabsf(x)))) * 0.0625f; }
                    }
                    *(f32x4*)(LOGF + (size_t)row * 512 + c) = l0; *(f32x4*)(LOGF + (size_t)row * 512 + c + 4) = l1;
                }
            }
        EPI_ROWS_END
    }
};
struct Args { const void* in[25]; float* out; unsigned char* ws; int ph_lo, ph_hi, qrep, pad; };
typedef const __attribute__((address_space(4))) Args* KArgs;
struct Frame {
    LAS unsigned char* lds; volatile LAS unsigned* MISC; unsigned* ctl; unsigned char* ws;
    int wave, G, gw, NGW;
    __device__ __forceinline__ int tid_() const { int t = (int)threadIdx.x; asm volatile("" : "+v"(t)); return t; }
};
#define IN_F(i) ((const float*)args->in[i])
constexpr size_t OUT_YP = 0, OUT_YS = OUT_YP + (size_t)NP * D, OUT_MRP = OUT_YS + (size_t)NS * D, OUT_MRS = OUT_MRP + (size_t)2 * NP * LAT, OUT_HSP = OUT_MRS + (size_t)2 * NS * LAT,
                 OUT_HSS = OUT_HSP + (size_t)2 * 8 * 4 * 128 * 128, OUT_GSP = OUT_HSS + (size_t)2 * 32 * 4 * 128 * 128, OUT_GSS = OUT_GSP + (size_t)2 * 8 * 4 * 128 * 256;
#define WSP(T, off) ((T*)(F.ws + (off)))

struct TJob { const float* W; const float* gain; bf16_t* WT; int ldw, scol, K, ncols, ldt, drow, dk0; };
__device__ __forceinline__ void transpose_item(const TJob& J, int item, LAS float* scr, int lane) {
    const int nblk = J.ncols / 64, kb = item / nblk, nb = item % nblk, k0 = 64 * kb, n0 = 64 * nb;
    const int r = lane >> 4, c4 = (lane & 15) * 4;
    const float* src = J.W + (size_t)(k0 + r) * J.ldw + J.scol + n0 + c4;
    f32x4 v[16];
#pragma unroll
    for (int i = 0; i < 16; ++i) v[i] = *(const f32x4*)(src + (size_t)(4 * i) * J.ldw);
    const int c = lane & 7;
    f32x4 g0 = (f32x4){1.f, 1.f, 1.f, 1.f}, g1 = g0;
    if (J.gain) { g0 = *(const f32x4*)(J.gain + k0 + 8 * c); g1 = *(const f32x4*)(J.gain + k0 + 8 * c + 4); }
#pragma unroll
    for (int i = 0; i < 16; ++i) *(LAS f32x4*)(scr + (4 * i + r) * 68 + c4) = v[i];
    asm volatile("s_waitcnt lgkmcnt(0)" ::: "memory");
#pragma unroll
    for (int j = 0; j < 8; ++j) { const int n = (lane >> 3) + 8 * j; const LAS float* s = scr + (8 * c) * 68 + n;
        u32x4 o; o.x = cvt_pk_bf16(s[0 * 68] * g0[0], s[1 * 68] * g0[1]); o.y = cvt_pk_bf16(s[2 * 68] * g0[2], s[3 * 68] * g0[3]); o.z = cvt_pk_bf16(s[4 * 68] * g1[0], s[5 * 68] * g1[1]); o.w = cvt_pk_bf16(s[6 * 68] * g1[2], s[7 * 68] * g1[3]);
        *(u32x4*)(J.WT + (size_t)(J.drow + n0 + n) * J.ldt + J.dk0 + k0 + 8 * c) = o; }
    asm volatile("s_waitcnt lgkmcnt(0)" ::: "memory");
}
__device__ __forceinline__ TJob get_job(const Frame& F, KArgs args, int j) {
    TJob J;
    if (j < 10) { const int e = j / 5, s = j % 5; const float* W = IN_F(9) + (size_t)e * 1024 * 2752; bf16_t* WT = WSP(bf16_t, WS_WINE) + (size_t)e * NE1 * 1024;
        const float* gn = IN_F(6) + (2 * e) * 1024;
        if (s == 0) J = TJob{W, gn, WT, 2752, 0, 1024, 2048, 1024, 0, 0};
        else if (s == 1) J = TJob{W, gn, WT, 2752, 2432, 1024, 256, 1024, 2048, 0};
        else if (s == 2) J = TJob{W, gn, WT, 2752, 2048, 1024, 384, 1024, 2304, 0};
        else if (s == 3) J = TJob{W, gn, WT, 2752, 2688, 1024, 64, 1024, 2688, 0};
        else J = TJob{IN_F(17) + (size_t)e * 1024 * 1024, nullptr, WSP(bf16_t, WS_WOUTE) + (size_t)e * 1024 * KOE, 1024, 0, 512, 1024, KOE, 0, 0};
    } else if (j < 14) { const int o = (j - 10) >> 1;
        if (((j - 10) & 1) == 0) J = TJob{IN_F(18) + (size_t)o * 1024 * 3088, IN_F(6) + (2 * o + 1) * 1024, WSP(bf16_t, WS_WINO) + (size_t)o * NO1 * 1024, 3088, 0, 1024, 3072, 1024, 0, 0};
        else J = TJob{IN_F(22) + (size_t)o * 1024 * 1024, nullptr, WSP(bf16_t, WS_WOUTO) + (size_t)o * 1024 * 1024, 1024, 0, 1024, 1024, 1024, 0, 0};
    } else { const int l = (j - 14) >> 1;
        if (((j - 14) & 1) == 0) J = TJob{IN_F(23) + (size_t)l * 1024 * FF, IN_F(7) + l * 1024, WSP(bf16_t, WS_WUP) + (size_t)l * FF * 1024, FF, 0, 1024, FF, 1024, 0, 0};
        else J = TJob{IN_F(24) + (size_t)l * FF * 1024, nullptr, WSP(bf16_t, WS_WDOWN) + (size_t)l * 1024 * FF, 1024, 0, FF, 1024, FF, 0, 0};
    }
    return J;
}
__device__ __forceinline__ void p0_prologue(Frame& F, KArgs args) {
#ifndef MK_PROBE_PART
#define MK_PROBE_PART 7
#endif
    const int part = 7;
    LAS float* scr = (LAS float*)(F.lds + F.wave * 17408);
    if (part & 1) for (int j = 0; j < 22; ++j) { const TJob J = get_job(F, args, j); const int nit = (J.K / 64) * (J.ncols / 64);
        for (int it = F.gw; it < nit; it += F.NGW) transpose_item(J, it, scr, (F.tid_() & 63)); }
    __syncthreads();
    LAS float* sm = (LAS float*)(F.lds);
    if (part & 2) for (int it = blockIdx.x; it < 512; it += F.G) {
        const int kind = it >> 8, r = it & 255, e = r >> 7, h = (r >> 5) & 3, c8 = r & 31;
        __syncthreads();
        if (kind == 0) {
            for (int i = F.tid_(); i < 1024; i += 512) sm[i] = IN_F(15)[((size_t)((e * 4 + h) * 256 + c8 * 8 + (i >> 7))) * 128 + (i & 127)];
            __syncthreads();
            if (F.tid_() < 384) { const int k = F.tid_(); const f32x4* a = (const f32x4*)(IN_F(13) + (size_t)(e * 384 + k) * 768 + h * 192); float acc[8] = {};
#pragma unroll 8
                for (int n4 = 0; n4 < 32; ++n4) { const f32x4 av = a[n4];
#pragma unroll
                    for (int c = 0; c < 8; ++c) { const f32x4 bv = *(const LAS f32x4*)(sm + c * 128 + n4 * 4); acc[c] += (av[0] * bv[0] + av[1] * bv[1]) + (av[2] * bv[2] + av[3] * bv[3]); } }
                const float gq = IN_F(12)[e * 384 + k] * QSCALE; bf16_t* dst = WSP(bf16_t, WS_WQ2) + ((size_t)e * NQ2 + h * 256 + c8 * 8) * 384 + k;
#pragma unroll
                for (int c = 0; c < 8; ++c) dst[(size_t)c * 384] = (bf16_t)(cvt_pk_bf16(acc[c] * gq, 0.f) & 0xffffu); }
        } else {
            for (int i = F.tid_(); i < 1024; i += 512) sm[i] = IN_F(16)[((size_t)((e * 4 + h) * 256 + c8 * 8 + (i >> 7))) * 128 + (i & 127)];
            __syncthreads();
            for (int n = F.tid_(); n < 1024; n += 512) { const float* wo = IN_F(17) + ((size_t)e * 1024 + 512 + h * 128) * 1024 + n; float acc[8] = {};
#pragma unroll 16
                for (int v = 0; v < 128; ++v) { const float x = wo[(size_t)v * 1024];
#pragma unroll
                    for (int c = 0; c < 8; ++c) acc[c] += sm[c * 128 + v] * x; }
                u32x4 o; o.x = cvt_pk_bf16(acc[0], acc[1]); o.y = cvt_pk_bf16(acc[2], acc[3]); o.z = cvt_pk_bf16(acc[4], acc[5]); o.w = cvt_pk_bf16(acc[6], acc[7]);
                *(u32x4*)(WSP(bf16_t, WS_WOUTE) + ((size_t)e * 1024 + n) * KOE + 512 + h * 256 + c8 * 8) = o; }
        }
    }
    if (!(part & 4)) return;
    const int gt = blockIdx.x * 512 + F.tid_(), NT = F.G * 512;
    for (int idx = gt; idx < 2 * 256 * 384; idx += NT) {
        const int k = idx % 384, cc = (idx / 384) & 255, e = idx / (384 * 256), hh = cc >> 6, w6 = cc & 63, g = w6 >> 3, i = w6 & 7, sj = i < 4 ? 4 * g + i : 32 + 4 * g + (i - 4);
        const float v = IN_F(13)[(size_t)(e * 384 + k) * 768 + hh * 192 + 128 + sj] * IN_F(12)[e * 384 + k] * QSCALE;
        WSP(bf16_t, WS_WQ2)[((size_t)e * NQ2 + 1024 + cc) * 384 + k] = (bf16_t)(cvt_pk_bf16(v, 0.f) & 0xffffu); }
    for (int idx = gt; idx < 2 * 8 * 1024; idx += NT) {
        const int k = idx & 1023, jp = (idx >> 10) & 7, o = idx >> 13; const f32x4* ar = (const f32x4*)(IN_F(18) + (size_t)(o * 1024 + k) * 3088 + 3072);
        const f32x4 a0 = ar[0], a1 = ar[1], a2 = ar[2], a3 = ar[3]; const float gn = IN_F(6)[(2 * o + 1) * 1024 + k];
        const float av[16] = {a0[0], a0[1], a0[2], a0[3], a1[0], a1[1], a1[2], a1[3], a2[0], a2[1], a2[2], a2[3], a3[0], a3[1], a3[2], a3[3]};
#pragma unroll 4
        for (int j = jp * 64; j < jp * 64 + 64; ++j) { float s = 0.f;
#pragma unroll
            for (int r = 0; r < 16; ++r) s += av[r] * IN_F(19)[(size_t)(o * 16 + r) * 512 + j];
            WSP(bf16_t, WS_WINO)[((size_t)o * NO1 + 3072 + j) * 1024 + k] = (bf16_t)(cvt_pk_bf16(s * gn, 0.f) & 0xffffu); } }
    for (int idx = gt; idx < 2 * 64 * 128; idx += NT) {
        const int e = idx >> 13, r = idx & 8191; *(u32x4*)(WSP(bf16_t, WS_WINE) + ((size_t)e * NE1 + 2752) * 1024 + (size_t)r * 8) = (u32x4){0u, 0u, 0u, 0u}; }
    for (int idx = gt; idx < 512; idx += NT) {
        const float a = IN_F(10)[idx], b = IN_F(10)[512 + idx], mx = fmaxf(a, b), ea = __expf(a - mx), eb = __expf(b - mx);
        WSP(float, WS_LBS)[idx] = 0.f; WSP(float, WS_LBS)[512 + idx] = eb / (ea + eb); }
    for (int idx = gt; idx < 2056 * 32; idx += NT) {
        const int j = idx & 31, pi = idx >> 5; const double pos = (double)(pi < SEQ ? pi : PAST + (pi - SEQ));
        const double inv = exp2(-(double)j * (13.287712379549449 / 32.0)), ang = pos * inv, n = rint(ang * 0.15915494309189535), r = ang - n * 6.283185307179586;
        WSP(float, WS_ROPE)[(size_t)pi * 64 + j] = cosf((float)r); WSP(float, WS_ROPE)[(size_t)pi * 64 + 32 + j] = sinf((float)r); }
    for (int m = F.gw; m < NTOK; m += F.NGW) {
        const float* xr = m < NP ? IN_F(0) + (size_t)m * D : IN_F(1) + (size_t)(m - NP) * D; float s = 0.f;
#pragma unroll
        for (int j = 0; j < 4; ++j) { const f32x4 v = *(const f32x4*)(xr + j * 256 + (F.tid_() & 63) * 4); s += (v[0] * v[0] + v[1] * v[1]) + (v[2] * v[2] + v[3] * v[3]);
            u32x2 w; w.x = cvt_pk_bf16(v[0], v[1]); w.y = cvt_pk_bf16(v[2], v[3]); *(u32x2*)(WSP(bf16_t, WS_XB) + (size_t)m * D + j * 256 + (F.tid_() & 63) * 4) = w; }
        s = wave_sum(s);
        if ((F.tid_() & 63) < 16) WSP(float, WS_SSQ)[(size_t)m * 16 + (F.tid_() & 63)] = (F.tid_() & 63) == 0 ? s : 0.f;
    }
}

__device__ __forceinline__ void finalize_rows(Frame& F, KArgs args, int e) {
    const float* CKV = WSP(float, WS_CKV); const float* KR = WSP(float, WS_KR); bf16_t* KVL = WSP(bf16_t, WS_KVL); const float* rope = WSP(float, WS_ROPE);
    int lane_ = (F.tid_() & 63); asm volatile("" : "+v"(lane_));
    const f32x4 w4 = *(const f32x4*)(IN_F(14) + e * 256 + lane_ * 4);
    for (int r = F.gw; r < NTOK; r += F.NGW) {
        const f32x4 v = *(const f32x4*)(CKV + (size_t)r * 256 + lane_ * 4);
        const float ss = wave_sum((v[0] * v[0] + v[1] * v[1]) + (v[2] * v[2] + v[3] * v[3])), rs = rsqrtf(ss * (1.f / 256.f) + EPS);
        const f32x4 o = v * rs * w4;
        float* od = r < NP ? (args->out + OUT_MRP) + ((size_t)e * NP + r) * LAT : (args->out + OUT_MRS) + ((size_t)e * NS + (r - NP)) * LAT;
        *(f32x4*)(od + lane_ * 4) = o;
        u32x2 w; w.x = cvt_pk_bf16(o[0], o[1]); w.y = cvt_pk_bf16(o[2], o[3]); *(u32x2*)(KVL + (size_t)r * LAT + lane_ * 4) = w;
        if (lane_ < 32) { const float x1 = KR[(size_t)r * 64 + lane_], x2 = KR[(size_t)r * 64 + 32 + lane_]; const float* rp = rope + (size_t)rope_idx(r) * 64;
            const float c = rp[lane_], sn = rp[32 + lane_], a = x1 * c - x2 * sn, b = x1 * sn + x2 * c;
            od[256 + lane_] = a; od[288 + lane_] = b;
            KVL[(size_t)r * LAT + 256 + lane_] = (bf16_t)(cvt_pk_bf16(a, 0.f) & 0xffffu); KVL[(size_t)r * LAT + 288 + lane_] = (bf16_t)(cvt_pk_bf16(b, 0.f) & 0xffffu); }
    }
}


__device__ __forceinline__ void sample_fixup(Frame& F, int r0, int r1) {
    float* X = WSP(float, WS_X); bf16_t* XB = WSP(bf16_t, WS_XB); float* SSQ = WSP(float, WS_SSQ); const float* PQ = WSP(float, WS_PQ);
    const int lane = F.tid_() & 63;
    for (int r = r0 + F.wave; r < r1; r += 8) { float ss = 0.f;
#pragma unroll
        for (int j = 0; j < 4; ++j) { const int c = j * 256 + lane * 4; const size_t po = (size_t)(r - NP) * D + c;
            f32x4 v = *(const f32x4*)(X + (size_t)r * D + c);
#pragma unroll
            for (int q = 0; q < 4; ++q) v = v + *(const f32x4*)(PQ + (size_t)q * 256 * D + po);
            *(f32x4*)(X + (size_t)r * D + c) = v; u32x2 w; w.x = cvt_pk_bf16(v[0], v[1]); w.y = cvt_pk_bf16(v[2], v[3]); *(u32x2*)(XB + (size_t)r * D + c) = w;
            ss += (v[0] * v[0] + v[1] * v[1]) + (v[2] * v[2] + v[3] * v[3]); }
        ss = wave_sum(ss);
        if (lane < 16) SSQ[(size_t)r * 16 + lane] = lane == 0 ? ss : 0.f; }
}

constexpr int KP = 656, KT_BYTES = 64 * KP;
#define NEG_INF (-__builtin_inff())
__device__ __forceinline__ s16x4 tr_read(const LAS unsigned char* p) { return __builtin_amdgcn_ds_read_tr16_b64_v4i16((LAS s16x4*)p); }
__device__ __forceinline__ bf16x8 pack_frag(const f32x4 a, const f32x4 b) { u32x4 w; w.x = cvt_pk_bf16(a[0], a[1]); w.y = cvt_pk_bf16(a[2], a[3]); w.z = cvt_pk_bf16(b[0], b[1]); w.w = cvt_pk_bf16(b[2], b[3]); return __builtin_bit_cast(bf16x8, w); }
__device__ __forceinline__ bf16x8 join_frag(const s16x4 a, const s16x4 b) { return (bf16x8){a[0], a[1], a[2], a[3], b[0], b[1], b[2], b[3]}; }
template <int NKB, int NCB, bool MASK>
__device__ __forceinline__ void attn_tile(const LAS unsigned char* kt, int key0, int cbase, const bf16x8 (&qf)[10], f32x4 (&O)[NCB], float& m, float& l, int lane, int keyabs0, int limit) {
    const int fr = lane & 15, g = lane >> 4;
    f32x4 S[NKB];
#pragma unroll
    for (int kb = 0; kb < NKB; ++kb) { S[kb] = (f32x4){0.f, 0.f, 0.f, 0.f};
        const LAS unsigned char* kr = kt + (key0 + kb * 16 + fr) * KP + g * 16;
#pragma unroll
        for (int ds = 0; ds < 10; ++ds) S[kb] = __builtin_amdgcn_mfma_f32_16x16x32_bf16(*(const LAS bf16x8*)(kr + ds * 64), qf[ds], S[kb], 0, 0, 0);
        asm volatile("" ::: "memory"); }
    if constexpr (MASK) {
#pragma unroll
        for (int kb = 0; kb < NKB; ++kb)
#pragma unroll
            for (int i = 0; i < 4; ++i) if (keyabs0 + key0 + kb * 16 + 4 * g + i > limit) S[kb][i] = NEG_INF;
    }
    float mx = NEG_INF;
#pragma unroll
    for (int kb = 0; kb < NKB; ++kb) mx = fmaxf(fmaxf(mx, fmaxf(S[kb][0], S[kb][1])), fmaxf(S[kb][2], S[kb][3]));
    mx = fmaxf(mx, __shfl_xor(mx, 16)); mx = fmaxf(mx, __shfl_xor(mx, 32));
    const float mn = fmaxf(m, mx), mu = (mn == NEG_INF) ? 0.f : mn, alpha = fexp2(m - mu);
    float ls = 0.f;
#pragma unroll
    for (int kb = 0; kb < NKB; ++kb)
#pragma unroll
        for (int i = 0; i < 4; ++i) { const float p = fexp2(S[kb][i] - mu); S[kb][i] = p; ls += p; }
    l = l * alpha + ls; m = mn;
#pragma unroll
    for (int cb = 0; cb < NCB; ++cb) O[cb] = O[cb] * alpha;
#pragma unroll
    for (int p2 = 0; p2 < NKB / 2; ++p2) {
        const bf16x8 pf = pack_frag(S[2 * p2], S[2 * p2 + 1]);
        const LAS unsigned char* vr = kt + (key0 + 32 * p2 + 4 * g + (fr >> 2)) * KP + (cbase + 4 * (fr & 3)) * 2;
#pragma unroll
        for (int cb = 0; cb < NCB; ++cb) { const bf16x8 a = join_frag(tr_read(vr + cb * 32), tr_read(vr + cb * 32 + 16 * KP)); O[cb] = __builtin_amdgcn_mfma_f32_16x16x32_bf16(a, pf, O[cb], 0, 0, 0);
            if ((cb & 3) == 3) asm volatile("" ::: "memory"); }
    }
}
__device__ __forceinline__ void attn_prompt_unit(Frame& F, int b, int qb) {
    const bf16_t* KVL = WSP(bf16_t, WS_KVL); const bf16_t* QL = WSP(bf16_t, WS_QL); bf16_t* OA = WSP(bf16_t, WS_OA);
    int tid_ = F.tid_(); asm volatile("" : "+v"(tid_));
    const int w = F.wave, lane = tid_ & 63, fr = lane & 15, g = lane >> 4, h = w & 3, half = w >> 2;
    const int pos = 32 * qb + 16 * half + fr, row = b * SEQ + pos;
    bf16x8 qf[10];
#pragma unroll
    for (int ds = 0; ds < 10; ++ds) qf[ds] = *(const bf16x8*)(QL + (size_t)row * QL_LD + h * LAT + ds * 32 + g * 8);
    f32x4 O[16];
#pragma unroll
    for (int cb = 0; cb < 16; ++cb) O[cb] = (f32x4){0.f, 0.f, 0.f, 0.f};
    float m = NEG_INF, l = 0.f;
    const int ntiles = (qb >> 1) + 1;
    const u32x4* src = (const u32x4*)(KVL + (size_t)b * SEQ * LAT);
    u32x4 st[5];
#define PA_LOAD(kt) do { _Pragma("unroll") for (int i = 0; i < 5; ++i) st[i] = src[(size_t)(kt) * 2560 + tid_ + 512 * i]; } while (0)
#define PA_WRITE(buf) do { _Pragma("unroll") for (int i = 0; i < 5; ++i) { const int ch = tid_ + 512 * i, key = ch / 40, c16 = ch % 40; *(LAS u32x4*)(F.lds + (buf) * KT_BYTES + key * KP + c16 * 16) = st[i]; } } while (0)
    PA_LOAD(0); PA_WRITE(0); __syncthreads();
    for (int kt = 0; kt < ntiles; ++kt) {
        if (kt + 1 < ntiles) PA_LOAD(kt + 1);
        const LAS unsigned char* kb = F.lds + (kt & 1) * KT_BYTES;
        attn_tile<4, 16, true>(kb, 0, 0, qf, O, m, l, lane, 64 * kt, pos);
        if (kt + 1 < ntiles) PA_WRITE((kt + 1) & 1);
        __syncthreads();
    }
#undef PA_LOAD
#undef PA_WRITE
    l += __shfl_xor(l, 16); l += __shfl_xor(l, 32);
    const float inv = 1.f / l;
    bf16_t* dst = OA + (size_t)row * KOE + 512 + h * 256 + 4 * g;
#pragma unroll
    for (int cb = 0; cb < 16; ++cb) { const f32x4 o = O[cb] * inv; u32x2 wv; wv.x = cvt_pk_bf16(o[0], o[1]); wv.y = cvt_pk_bf16(o[2], o[3]); *(u32x2*)(dst + cb * 16) = wv; }
}
__device__ __forceinline__ void attn_decode_unit(Frame& F, KArgs args, int e, int bd, int sp) {
    const bf16_t* KVL = WSP(bf16_t, WS_KVL); const bf16_t* QL = WSP(bf16_t, WS_QL); float* PO = WSP(float, WS_PO); float* PML = WSP(float, WS_PML);
    const float* cache = IN_F(2) + (size_t)e * NPHYS * PAGE * LAT;
    int tid_ = F.tid_(); asm volatile("" : "+v"(tid_));
    const int w = F.wave, lane = tid_ & 63, fr = lane & 15, g = lane >> 4, rg = w & 1, kh = (w >> 1) & 1, ch = w >> 2;
    const int rr = 16 * rg + fr, td = rr >> 2, h = rr & 3, row = NP + bd * DSEQ + td;
    bf16x8 qf[10];
#pragma unroll
    for (int ds = 0; ds < 10; ++ds) qf[ds] = *(const bf16x8*)(QL + (size_t)row * QL_LD + h * LAT + ds * 32 + g * 8);
    f32x4 O[8];
#pragma unroll
    for (int cb = 0; cb < 8; ++cb) O[cb] = (f32x4){0.f, 0.f, 0.f, 0.f};
    float m = NEG_INF, l = 0.f;
    constexpr int PPS = NPAGES / NSPLIT, NT = 2 * PPS;
    f32x4 st[10];
#define DA_LOAD(t) do { const int pg = ((const int*)args->in[5])[bd * NPAGES + sp * PPS + ((t) >> 1)]; const f32x4* bp = (const f32x4*)(cache + ((size_t)pg * PAGE + ((t) & 1) * 64) * LAT); \
        _Pragma("unroll") for (int i = 0; i < 10; ++i) st[i] = __builtin_nontemporal_load(bp + tid_ + 512 * i); } while (0)
#define DA_WRITE(buf) do { _Pragma("unroll") for (int i = 0; i < 10; ++i) { const int idx = tid_ + 512 * i, key = idx / 80, d4 = idx % 80; u32x2 wv; wv.x = cvt_pk_bf16(st[i][0], st[i][1]); wv.y = cvt_pk_bf16(st[i][2], st[i][3]); \
        *(LAS u32x2*)(F.lds + (buf) * KT_BYTES + key * KP + d4 * 8) = wv; } } while (0)
    DA_LOAD(0); DA_WRITE(0); __syncthreads();
    for (int t = 0; t < NT; ++t) {
        if (t + 1 < NT) DA_LOAD(t + 1);
        attn_tile<2, 8, false>(F.lds + (t & 1) * KT_BYTES, 32 * kh, 128 * ch, qf, O, m, l, lane, 0, 0);
        if (t + 1 < NT) DA_WRITE((t + 1) & 1);
        __syncthreads();
    }
#undef DA_LOAD
#undef DA_WRITE
    if (sp == NSPLIT - 1) {
        for (int i = tid_; i < 320 + 24 * 41; i += 512) {
            if (i < 320) { const int key = i / 40, c16 = i % 40; *(LAS u32x4*)(F.lds + key * KP + c16 * 16) = *(const u32x4*)(KVL + (size_t)(NP + bd * DSEQ + key) * LAT + c16 * 8); }
            else { const int j = i - 320; *(LAS u32x4*)(F.lds + 8 * KP + j * 16) = (u32x4){0u, 0u, 0u, 0u}; }
        }
        __syncthreads();
        if (kh == 0) attn_tile<2, 8, true>(F.lds, 0, 128 * ch, qf, O, m, l, lane, PAST, PAST + td);
        __syncthreads();
    }
    l += __shfl_xor(l, 16); l += __shfl_xor(l, 32);
    const int se = sp * 2 + kh; const size_t pr = ((size_t)(bd * NSE + se) * 32 + rr);
#pragma unroll
    for (int cb = 0; cb < 8; ++cb) *(f32x4*)(PO + pr * 256 + 128 * ch + 16 * cb + 4 * g) = O[cb];
    if (ch == 0 && g == 0) { PML[pr * 2] = m; PML[pr * 2 + 1] = l; }
}
__device__ __forceinline__ void attn_decode_combine(Frame& F, int r0, int r1, int wstart, int wstride) {
    const float* PO = WSP(float, WS_PO); const float* PML = WSP(float, WS_PML); bf16_t* OA = WSP(bf16_t, WS_OA);
    for (int r = r0 + wstart; r < r1; r += wstride) {
        const int bd = r >> 5, rr = r & 31, td = rr >> 2, h = rr & 3;
        float mm = NEG_INF, ll = 0.f;
        if ((F.tid_() & 63) < NSE) { const size_t pr = ((size_t)(bd * NSE + (F.tid_() & 63)) * 32 + rr); mm = PML[pr * 2]; ll = PML[pr * 2 + 1]; }
        float M = mm;
#pragma unroll
        for (int o = 1; o < 64; o <<= 1) M = fmaxf(M, __shfl_xor(M, o));
        const float wgt = ((F.tid_() & 63) < NSE) ? fexp2(mm - M) : 0.f; const float L = wave_sum(wgt * ll);
        f32x4 acc = (f32x4){0.f, 0.f, 0.f, 0.f};
        for (int se = 0; se < NSE; ++se) { const float ws_ = __shfl(wgt, se); acc = acc + *(const f32x4*)(PO + ((size_t)(bd * NSE + se) * 32 + rr) * 256 + (F.tid_() & 63) * 4) * ws_; }
        const float inv = 1.f / L; u32x2 wv; wv.x = cvt_pk_bf16(acc[0] * inv, acc[1] * inv); wv.y = cvt_pk_bf16(acc[2] * inv, acc[3] * inv);
        *(u32x2*)(OA + (size_t)(NP + bd * DSEQ + td) * KOE + 512 + h * 256 + (F.tid_() & 63) * 4) = wv;
    }
}

template <int NV, int INIT, bool FULL>
__device__ __forceinline__ void scan_unit(Frame& F, const float* nw, const float* s0, float* sout, float* segH, float* segD, int nprev, int ldo, int row0, int T, int h) {
    constexpr int VD = 128 * NV, LDV = 4 * VD, PV = 2 * VD + 16, PQ = 272, PK = 144;
    constexpr int O_QT0 = 0, O_QH = 64 * PQ, O_KH = 2 * 64 * PQ, O_KLT = 3 * 64 * PQ, O_VT = O_KLT + 128 * PK, O_DEC = O_VT + 64 * PV, O_XS = O_DEC + 512, O_NRM = O_XS + 8192;
    constexpr size_t SEGSZ = (size_t)128 * VD;
    static_assert(O_NRM + 2048 <= RING_BYTES, "scan LDS");
    const bf16_t* Qh = WSP(bf16_t, WS_QH); const bf16_t* KK = WSP(bf16_t, WS_KK); const float* LOGF = WSP(float, WS_LOGF); const bf16_t* V = WSP(bf16_t, WS_V); const bf16_t* G = WSP(bf16_t, WS_G); bf16_t* OA = WSP(bf16_t, WS_OA);
    LAS unsigned char* lds = F.lds;
    int tid = F.tid_(); asm volatile("" : "+v"(tid));
    const int w = F.wave, lane = tid & 63, fr = lane & 15, g = lane >> 4;
    f32x4 S[8][NV];
#pragma unroll
    for (int kb = 0; kb < 8; ++kb)
#pragma unroll
        for (int nv = 0; nv < NV; ++nv) {
            if constexpr (INIT == 1) { const float* sp = s0 + (size_t)(16 * kb + 4 * g) * VD + (w * NV + nv) * 16 + fr;
                const float a0 = sp[0], a1 = sp[VD], a2 = sp[2 * VD], a3 = sp[3 * VD]; S[kb][nv] = (f32x4){a0, a1, a2, a3}; }
            else S[kb][nv] = (f32x4){0.f, 0.f, 0.f, 0.f};
        }
    if constexpr (INIT == 2) {
        for (int j = 0; j < nprev; ++j) {
            const f32x4* hp = (const f32x4*)(segH + (size_t)j * SEGSZ) + (size_t)w * (8 * NV) * 64 + lane; const float* dp = segD + j * 128 + 4 * g;
#pragma unroll
            for (int kb = 0; kb < 8; ++kb) { const f32x4 d4 = *(const f32x4*)(dp + 16 * kb);
#pragma unroll
                for (int nv = 0; nv < NV; ++nv) S[kb][nv] = S[kb][nv] * d4 + hp[(kb * NV + nv) * 64]; }
        }
    }
    f32x4 segsum = (f32x4){0.f, 0.f, 0.f, 0.f};
    for (int c0 = 0; c0 < T; c0 += 64) {
        {
            const int k4 = (tid & 31) * 4, ts = tid >> 5, t0 = 4 * ts;
            const size_t rbase = (size_t)(row0 + c0 + t0) * 512 + h * 128 + k4;
            f32x4 bl[4]; u32x2 qw[4], kw[4]; f32x4 run = (f32x4){0.f, 0.f, 0.f, 0.f};
#pragma unroll
            for (int i = 0; i < 4; ++i) { const bool ok = c0 + t0 + i < T; f32x4 lf = (f32x4){0.f, 0.f, 0.f, 0.f}; qw[i] = (u32x2){0u, 0u}; kw[i] = (u32x2){0u, 0u};
                if (ok) { lf = *(const f32x4*)(LOGF + rbase + (size_t)i * 512); if constexpr (FULL) qw[i] = *(const u32x2*)(Qh + rbase + (size_t)i * 512); kw[i] = *(const u32x2*)(KK + rbase + (size_t)i * 512); }
                run = run + lf; bl[i] = run; }
            *(LAS f32x4*)(lds + O_XS + (ts * 128 + k4) * 4) = run;
#pragma unroll
            for (int j = 0; j < 2 * NV; ++j) { const int chn = tid + 512 * j, s = chn / (VD / 8), cc = chn % (VD / 8); u32x4 val = (u32x4){0u, 0u, 0u, 0u};
                if (c0 + s < T) val = *(const u32x4*)(V + (size_t)(row0 + c0 + s) * LDV + h * VD + cc * 8);
                *(LAS u32x4*)(lds + O_VT + s * PV + cc * 16) = val; }
            __syncthreads();
            f32x4 pre = (f32x4){0.f, 0.f, 0.f, 0.f}, b31 = pre, bL = pre;
#pragma unroll
            for (int s = 0; s < 16; ++s) { const f32x4 x = *(const LAS f32x4*)(lds + O_XS + (s * 128 + k4) * 4); if (s < ts) pre = pre + x; if (s < 8) b31 = b31 + x; bL = bL + x; }
            f32x4 klv[4];
#pragma unroll
            for (int i = 0; i < 4; ++i) {
                const f32x4 b = pre + bl[i]; f32x4 k, eL;
                k[0] = bflo(kw[i].x); k[1] = bfhi(kw[i].x); k[2] = bflo(kw[i].y); k[3] = bfhi(kw[i].y);
#pragma unroll
                for (int c = 0; c < 4; ++c) eL[c] = fexp(bL[c] - b[c]);
                klv[i] = k * eL;
                if constexpr (FULL) {
                    f32x4 q, e0, em, ek;
                    q[0] = bflo(qw[i].x); q[1] = bfhi(qw[i].x); q[2] = bflo(qw[i].y); q[3] = bfhi(qw[i].y);
#pragma unroll
                    for (int c = 0; c < 4; ++c) { e0[c] = fexp(b[c]); em[c] = fexp(b[c] - b31[c]); ek[c] = fexp(b31[c] - b[c]); }
                    const f32x4 a0 = q * e0, a1 = q * em, a2 = k * ek;
                    const int ro = (t0 + i) * PQ + k4 * 2;
                    *(LAS u32x2*)(lds + O_QT0 + ro) = (u32x2){cvt_pk_bf16(a0[0], a0[1]), cvt_pk_bf16(a0[2], a0[3])};
                    *(LAS u32x2*)(lds + O_QH + ro) = (u32x2){cvt_pk_bf16(a1[0], a1[1]), cvt_pk_bf16(a1[2], a1[3])};
                    *(LAS u32x2*)(lds + O_KH + ro) = (u32x2){cvt_pk_bf16(a2[0], a2[1]), cvt_pk_bf16(a2[2], a2[3])};
                }
            }
#pragma unroll
            for (int c = 0; c < 4; ++c) *(LAS u32x2*)(lds + O_KLT + (k4 + c) * PK + t0 * 2) = (u32x2){cvt_pk_bf16(klv[0][c], klv[1][c]), cvt_pk_bf16(klv[2][c], klv[3][c])};
            if (ts == 0) { f32x4 d; d[0] = fexp(bL[0]); d[1] = fexp(bL[1]); d[2] = fexp(bL[2]); d[3] = fexp(bL[3]); *(LAS f32x4*)(lds + O_DEC + k4 * 4) = d; segsum = segsum + bL; }
            __syncthreads();
        }
        f32x4 Oo[4][NV];
        if constexpr (FULL) {
            bf16x8 sB[4][NV];
#pragma unroll
            for (int ks = 0; ks < 4; ++ks)
#pragma unroll
                for (int nv = 0; nv < NV; ++nv) sB[ks][nv] = pack_frag(S[2 * ks][nv], S[2 * ks + 1][nv]);
            bf16x8 vP[2][NV];
#pragma unroll
            for (int p = 0; p < 2; ++p)
#pragma unroll
                for (int nv = 0; nv < NV; ++nv) { const LAS unsigned char* a1 = lds + O_VT + (32 * p + 4 * g + (fr >> 2)) * PV + ((w * NV + nv) * 16 + 4 * (fr & 3)) * 2; vP[p][nv] = join_frag(tr_read(a1), tr_read(a1 + 16 * PV)); }
#pragma unroll
            for (int tb = 0; tb < 4; ++tb) {
                f32x4 X[4];
                {
                    bf16x8 bq[4];
#pragma unroll
                    for (int ks = 0; ks < 4; ++ks) bq[ks] = *(const LAS bf16x8*)(lds + O_QH + (16 * tb + fr) * PQ + ks * 64 + g * 16);
#pragma unroll
                    for (int sb = 0; sb < 4; ++sb) { X[sb] = (f32x4){0.f, 0.f, 0.f, 0.f};
                        if (sb <= tb) {
#pragma unroll
                            for (int ks = 0; ks < 4; ++ks) X[sb] = __builtin_amdgcn_mfma_f32_16x16x32_bf16(*(const LAS bf16x8*)(lds + O_KH + (16 * sb + fr) * PQ + ks * 64 + g * 16), bq[ks], X[sb], 0, 0, 0);
                            if (sb == tb) {
#pragma unroll
                                for (int i = 0; i < 4; ++i) if (4 * g + i > fr) X[sb][i] = 0.f; } } }
                }
#pragma unroll
                for (int nv = 0; nv < NV; ++nv) Oo[tb][nv] = (f32x4){0.f, 0.f, 0.f, 0.f};
#pragma unroll
                for (int p = 0; p < 2; ++p) if (p <= (tb >> 1)) {
                    const bf16x8 pf = pack_frag(X[2 * p], X[2 * p + 1]);
#pragma unroll
                    for (int nv = 0; nv < NV; ++nv) Oo[tb][nv] = __builtin_amdgcn_mfma_f32_16x16x32_bf16(pf, vP[p][nv], Oo[tb][nv], 0, 0, 0);
                }
#pragma unroll
                for (int ks = 0; ks < 4; ++ks) {
                    const LAS unsigned char* qa = lds + O_QT0 + (16 * tb + fr) * PQ + (32 * ks + 4 * g) * 2;
                    const u32x2 q0 = *(const LAS u32x2*)qa, q1 = *(const LAS u32x2*)(qa + 32);
                    const bf16x8 aq = __builtin_bit_cast(bf16x8, (u32x4){q0.x, q0.y, q1.x, q1.y});
#pragma unroll
                    for (int nv = 0; nv < NV; ++nv) Oo[tb][nv] = __builtin_amdgcn_mfma_f32_16x16x32_bf16(aq, sB[ks][nv], Oo[tb][nv], 0, 0, 0);
                }
                asm volatile("" ::: "memory");
            }
        }
        bf16x8 vN[2][NV];
#pragma unroll
        for (int p = 0; p < 2; ++p)
#pragma unroll
            for (int nv = 0; nv < NV; ++nv) { const LAS unsigned char* a2 = lds + O_VT + (32 * p + 8 * g + (fr >> 2)) * PV + ((w * NV + nv) * 16 + 4 * (fr & 3)) * 2; vN[p][nv] = join_frag(tr_read(a2), tr_read(a2 + 4 * PV)); }
#pragma unroll
        for (int kb = 0; kb < 8; ++kb) {
            const f32x4 d4 = *(const LAS f32x4*)(lds + O_DEC + (16 * kb + 4 * g) * 4);
#pragma unroll
            for (int nv = 0; nv < NV; ++nv) S[kb][nv] = S[kb][nv] * d4;
#pragma unroll
            for (int p = 0; p < 2; ++p) { const bf16x8 a = *(const LAS bf16x8*)(lds + O_KLT + (16 * kb + fr) * PK + p * 64 + g * 16);
#pragma unroll
                for (int nv = 0; nv < NV; ++nv) S[kb][nv] = __builtin_amdgcn_mfma_f32_16x16x32_bf16(a, vN[p][nv], S[kb][nv], 0, 0, 0); }
        }
        if constexpr (FULL) {
#pragma unroll
            for (int tb = 0; tb < 4; ++tb)
#pragma unroll
                for (int i = 0; i < 4; ++i) { float ss = 0.f;
#pragma unroll
                    for (int nv = 0; nv < NV; ++nv) ss += Oo[tb][nv][i] * Oo[tb][nv][i];
                    ss += __shfl_xor(ss, 1); ss += __shfl_xor(ss, 2); ss += __shfl_xor(ss, 4); ss += __shfl_xor(ss, 8);
                    if (fr == 0) ((LAS float*)(lds + O_NRM))[(16 * tb + 4 * g + i) * 8 + w] = ss; }
            __syncthreads();
#pragma unroll
            for (int tb = 0; tb < 4; ++tb)
#pragma unroll
                for (int i = 0; i < 4; ++i) { const int tl = 16 * tb + 4 * g + i; const LAS f32x4* np = (const LAS f32x4*)(lds + O_NRM + tl * 32); const f32x4 n0 = np[0], n1 = np[1];
                    const float rs = rsqrtf(((n0[0] + n0[1]) + (n0[2] + n0[3]) + (n1[0] + n1[1]) + (n1[2] + n1[3])) * (1.f / VD) + EPS);
                    if (c0 + tl < T) { int ri = row0 + c0 + tl; asm volatile("" : "+v"(ri)); const size_t r = (size_t)ri;
#pragma unroll
                        for (int nv = 0; nv < NV; ++nv) { const int v = (w * NV + nv) * 16 + fr; const float gt = bf2f(G[r * LDV + h * VD + v]);
                            const unsigned ov = cvt_pk_bf16(Oo[tb][nv][i] * rs * nw[v] * gt, 0.f);
                            OA[r * ldo + h * VD + v] = (bf16_t)(ov & 0xffffu); } } }
        } else __syncthreads();
    }
    if constexpr (!FULL) {
        f32x4* hp = (f32x4*)segH + (size_t)w * (8 * NV) * 64 + lane;
#pragma unroll
        for (int kb = 0; kb < 8; ++kb)
#pragma unroll
            for (int nv = 0; nv < NV; ++nv) hp[(kb * NV + nv) * 64] = S[kb][nv];
        if ((tid >> 5) == 0) { f32x4 d; d[0] = fexp(segsum[0]); d[1] = fexp(segsum[1]); d[2] = fexp(segsum[2]); d[3] = fexp(segsum[3]); *(f32x4*)(segD + (tid & 31) * 4) = d; }
    } else if (sout) {
#pragma unroll
        for (int kb = 0; kb < 8; ++kb) {
            float* so = sout + (size_t)(16 * kb + 4 * g) * VD + w * NV * 16 + fr; asm volatile("" : "+v"(so));
#pragma unroll
            for (int nv = 0; nv < NV; ++nv)
#pragma unroll
                for (int i = 0; i < 4; ++i) so[i * VD + nv * 16] = S[kb][nv][i];
        }
    }
    __syncthreads();
}
constexpr int N_PHASES = 30;
__device__ __forceinline__ int queue_claim(Frame& F, unsigned* head) {
    __syncthreads();
    if (F.tid_() == 0) F.MISC[16] = __hip_atomic_fetch_add(head, 1u, __ATOMIC_RELAXED, __HIP_MEMORY_SCOPE_AGENT);
    __syncthreads();
    return (int)F.MISC[16];
}
__device__ __forceinline__ bool phase_in(int k, int lo, int hi) { asm volatile("" : "+s"(k)); return lo <= k && k < hi; }
__global__ void __launch_bounds__(512, 2) mega_fwd(Args args_byval) {
    KArgs args = (KArgs)__builtin_amdgcn_kernarg_segment_ptr(); (void)args_byval;
    extern __shared__ __attribute__((aligned(16))) unsigned char lds_raw[];
    Frame F;
    F.lds = (LAS unsigned char*)lds_raw; F.MISC = (volatile LAS unsigned*)(F.lds + MISC_OFF);
    F.wave = __builtin_amdgcn_readfirstlane(F.tid_() >> 6); F.G = gridDim.x; F.gw = blockIdx.x * 8 + F.wave; F.NGW = F.G * 8;
    F.ws = args->ws; F.ctl = (unsigned*)(args->ws + WS_CTL);
    for (int u = F.tid_(); u < (LDS_BYTES - MISC_OFF) / 4; u += 512) ((LAS unsigned*)(F.lds + MISC_OFF))[u] = 0u;
    __syncthreads();
    const int lo = args->ph_lo, hi = args->ph_hi;
    XcdBarrier bar; bar.bar = F.ctl + CW_BAR; bar.x = 0; bar.st = nullptr;
    if (hi - lo > 1) bar = xcd_barrier_post(F.ctl + CW_BAR, F.MISC + 8);
#ifdef MK_ONLY
#define INC(k, c) ((c) == MK_ONLY && phase_in((k), lo, hi))
#else
#define INC(k, c) phase_in((k), lo, hi)
#endif
#define SEAM(k) do { if (hi > (k) + 1) xcd_barrier(bar); } while (0)

    const RowScale rsX{WSP(float, WS_SSQ), 16, 4, 1.f / 1024.f, nullptr, 0u, nullptr};
    const RowScale rsQ{WSP(float, WS_SSQCQ), 16, 3, 1.f / 384.f, nullptr, 0u, nullptr};
    const RowScale rsNone{nullptr, 0, 0, 0.f, nullptr, 0u, nullptr};

    if (INC(0, 0)) { asm volatile("" : "+s"(F.ws), "+s"(args)); p0_prologue(F, args); SEAM(0); }

    for (int l = 0; l < 4; ++l) {
        const int pb = 1 + 7 * l, eo = l >> 1;
        const float* resP = l == 0 ? IN_F(0) : WSP(float, WS_X); const float* resS = l == 0 ? IN_F(1) : WSP(float, WS_X) + (size_t)NP * D;
        unsigned* depl = F.ctl + CW_DEP + 64 * 4 * l; unsigned* tmo = F.ctl + CW_BAR + XB_TMO;
        const RowScale rsXd{WSP(float, WS_SSQ), 16, 4, 1.f / 1024.f, l > 0 ? depl : nullptr, 4u, tmo};
        if ((l & 1) == 0) {
            if (INC(pb, 1)) { asm volatile("" : "+s"(F.ws), "+s"(args));
                if (l > 0 && blockIdx.x < 4) { sample_fixup(F, NP + 64 * blockIdx.x, NP + 64 * blockIdx.x + 64); dep_publish(depl); }
                Gemm g{WSP(bf16_t, WS_XB), WSP(bf16_t, WS_WINE) + (size_t)eo * NE1 * 1024, 1024, 1024, NTOK, NE1, 1024}; StaticOrder S; S.init(NTOK, NE1, F.G, (int)blockIdx.x);
                EpiInEven E{WSP(bf16_t, WS_QH), WSP(bf16_t, WS_KK), WSP(float, WS_LOGF), WSP(bf16_t, WS_V), WSP(bf16_t, WS_G), WSP(float, WS_CKV), WSP(float, WS_KR), WSP(bf16_t, WS_CQ), WSP(float, WS_SSQCQ), WSP(float, WS_LBS) + eo * 512};
                gemm_phase<EpiInEven, true>(F.lds, g, S, E, rsXd);
                SEAM(pb);
            }
            if (INC(pb + 1, 2)) { asm volatile("" : "+s"(F.ws), "+s"(args));
                finalize_rows(F, args, eo);
                Gemm g{WSP(bf16_t, WS_CQ), WSP(bf16_t, WS_WQ2) + (size_t)eo * NQ2 * 384, 384, 384, NTOK, NQ2, 384}; StaticOrder S; S.init(NTOK, NQ2, F.G, (int)blockIdx.x);
                EpiQ2 E{WSP(bf16_t, WS_QL), WSP(float, WS_ROPE)};
                gemm_phase<EpiQ2, true>(F.lds, g, S, E, rsQ);
                {
                    unsigned* head = F.ctl + CW_QUEUE + 64 * (l + 4);
                    for (;;) { const int u = queue_claim(F, head); if (u >= 256) break; const int bh = u >> 3, seg = u & 7;
                        scan_unit<1, 0, false>(F, nullptr, nullptr, nullptr, WSP(float, WS_SEGH) + (size_t)(bh * 8 + seg) * 128 * 128, WSP(float, WS_SEGD) + (bh * 8 + seg) * 128, 0, KOE, (bh >> 2) * SEQ + seg * 256, 256, bh & 3); }
                }
                SEAM(pb + 1);
            }
            if (INC(pb + 2, 3)) { asm volatile("" : "+s"(F.ws), "+s"(args));
                unsigned* head = F.ctl + CW_QUEUE + 64 * l;
                for (;;) {
                    const int u = queue_claim(F, head);
                    if (u >= 256 + 1024 + 128) break;
                    if (u < 256) { const int seg = 7 - (u >> 5), bh = u & 31;
                        scan_unit<1, 2, true>(F, IN_F(11) + eo * 128, nullptr, seg == 7 ? (args->out + OUT_HSP) + ((size_t)(eo * 32 + bh)) * 128 * 128 : nullptr,
                                              WSP(float, WS_SEGH) + (size_t)(bh * 8) * 128 * 128, WSP(float, WS_SEGD) + (bh * 8) * 128, seg, KOE, (bh >> 2) * SEQ + seg * 256, 256, bh & 3); }
                    else if (u < 256 + 1024) { const int j = u - 256, i = j >> 1;
                        if ((j & 1) == 0) attn_decode_unit(F, args, eo, i & 31, i >> 5);
                        else attn_prompt_unit(F, i & 7, 63 - (i >> 3)); }
                    else { const int j = u - 1280, bd = j >> 2, h = j & 3;
                        scan_unit<1, 1, true>(F, IN_F(11) + eo * 128, IN_F(3) + ((size_t)(eo * 32 + bd) * 4 + h) * 128 * 128, (args->out + OUT_HSS) + ((size_t)(eo * 32 + bd) * 4 + h) * 128 * 128, nullptr, nullptr, 0, KOE, NP + bd * DSEQ, DSEQ, h); }
                }
                SEAM(pb + 2);
            }
            if (INC(pb + 3, 4)) { asm volatile("" : "+s"(F.ws), "+s"(args)); attn_decode_combine(F, 0, 1024, F.gw, F.NGW); SEAM(pb + 3); }
            if (INC(pb + 4, 5)) { asm volatile("" : "+s"(F.ws), "+s"(args));
                Gemm g{WSP(bf16_t, WS_OA), WSP(bf16_t, WS_WOUTE) + (size_t)eo * 1024 * KOE, KOE, KOE, NTOK, 1024, KOE}; StaticOrder S; S.init(NTOK, 1024, F.G, (int)blockIdx.x);
                EpiOutRes<false> E{resP, resS, WSP(float, WS_X), WSP(bf16_t, WS_XB), WSP(float, WS_SSQ)};
                gemm_phase<EpiOutRes<false>, false>(F.lds, g, S, E, rsNone);
                SEAM(pb + 4);
            }
        } else {
            if (INC(pb, 6)) { asm volatile("" : "+s"(F.ws), "+s"(args));
                if (blockIdx.x < 4) { sample_fixup(F, NP + 64 * blockIdx.x, NP + 64 * blockIdx.x + 64); dep_publish(depl); }
                Gemm g{WSP(bf16_t, WS_XB), WSP(bf16_t, WS_WINO) + (size_t)eo * NO1 * 1024, 1024, 1024, NTOK, NO1, 1024}; StaticOrder S; S.init(NTOK, NO1, F.G, (int)blockIdx.x);
                EpiInOdd E{WSP(bf16_t, WS_QH), WSP(bf16_t, WS_KK), WSP(bf16_t, WS_V), WSP(bf16_t, WS_G), WSP(float, WS_LOGF), IN_F(20) + eo * 512};
                gemm_phase<EpiInOdd, true>(F.lds, g, S, E, rsXd);
                SEAM(pb);
            }
            if (INC(pb + 1, 12)) { asm volatile("" : "+s"(F.ws), "+s"(args));
                unsigned* head = F.ctl + CW_QUEUE + 64 * (l + 4);
                for (;;) { const int u = queue_claim(F, head); if (u >= 256) break; const int bh = u >> 3, seg = u & 7;
                    scan_unit<2, 0, false>(F, nullptr, nullptr, nullptr, WSP(float, WS_SEGH) + (size_t)(bh * 8 + seg) * 128 * 256, WSP(float, WS_SEGD) + (bh * 8 + seg) * 128, 0, 1024, (bh >> 2) * SEQ + seg * 256, 256, bh & 3); }
                SEAM(pb + 1);
            }
            if (INC(pb + 2, 7)) { asm volatile("" : "+s"(F.ws), "+s"(args));
                unsigned* head = F.ctl + CW_QUEUE + 64 * l;
                for (;;) {
                    const int u = queue_claim(F, head);
                    if (u >= 256 + 128) break;
                    if (u < 256) { const int seg = 7 - (u >> 5), bh = u & 31;
                        scan_unit<2, 2, true>(F, IN_F(21) + eo * 256, nullptr, seg == 7 ? (args->out + OUT_GSP) + ((size_t)(eo * 32 + bh)) * 128 * 256 : nullptr,
                                              WSP(float, WS_SEGH) + (size_t)(bh * 8) * 128 * 256, WSP(float, WS_SEGD) + (bh * 8) * 128, seg, 1024, (bh >> 2) * SEQ + seg * 256, 256, bh & 3); }
                    else { const int j = u - 256, bd = j >> 2, h = j & 3;
                        scan_unit<2, 1, true>(F, IN_F(21) + eo * 256, IN_F(4) + ((size_t)(eo * 32 + bd) * 4 + h) * 128 * 256, (args->out + OUT_GSS) + ((size_t)(eo * 32 + bd) * 4 + h) * 128 * 256, nullptr, nullptr, 0, 1024, NP + bd * DSEQ, DSEQ, h); }
                }
                SEAM(pb + 2);
            }
            if (INC(pb + 4, 8)) { asm volatile("" : "+s"(F.ws), "+s"(args));
                Gemm g{WSP(bf16_t, WS_OA), WSP(bf16_t, WS_WOUTO) + (size_t)eo * 1024 * 1024, 1024, 1024, NTOK, 1024, 1024}; StaticOrder S; S.init(NTOK, 1024, F.G, (int)blockIdx.x);
                EpiOutRes<false> E{resP, resS, WSP(float, WS_X), WSP(bf16_t, WS_XB), WSP(float, WS_SSQ)};
                gemm_phase<EpiOutRes<false>, false>(F.lds, g, S, E, rsNone);
                SEAM(pb + 4);
            }
        }
        if (INC(pb + 5, 9)) { asm volatile("" : "+s"(F.ws), "+s"(args));
            Gemm g{WSP(bf16_t, WS_XB), WSP(bf16_t, WS_WUP) + (size_t)l * FF * 1024, 1024, 1024, NTOK, FF, 1024}; StaticOrder S; S.init(NTOK, FF, F.G, (int)blockIdx.x);
            EpiUp<false> E{WSP(bf16_t, WS_FFB)};
            gemm_phase<EpiUp<false>, true>(F.lds, g, S, E, rsX);
            SEAM(pb + 5);
        }
        if (INC(pb + 6, 10)) { asm volatile("" : "+s"(F.ws), "+s"(args));
            {
                Gemm g{WSP(bf16_t, WS_FFB), WSP(bf16_t, WS_WDOWN) + (size_t)l * 1024 * FF, FF, FF, NP, 1024, FF}; StaticOrder S; S.init(NP, 1024, F.G, (int)blockIdx.x);
                EpiOutRes<false> E{WSP(float, WS_X), WSP(float, WS_X) + (size_t)NP * D, WSP(float, WS_X), WSP(bf16_t, WS_XB), WSP(float, WS_SSQ)};
                gemm_phase<EpiOutRes<false>, false>(F.lds, g, S, E, rsNone);
            }
            if (blockIdx.x < 16) {
                const int kq = blockIdx.x & 3, pn = blockIdx.x >> 2;
                Gemm g{WSP(bf16_t, WS_FFB) + kq * 1024, WSP(bf16_t, WS_WDOWN) + (size_t)l * 1024 * FF + kq * 1024, FF, FF, NTOK, 1024, 1024}; OneUnit S{64, pn};
                EpiPart E{WSP(float, WS_PQ) + (size_t)kq * 256 * D};
                gemm_phase<EpiPart, false, OneUnit>(F.lds, g, S, E, rsNone);
            }
            SEAM(pb + 6);
        }
    }
    if (INC(29, 11)) { asm volatile("" : "+s"(F.ws), "+s"(args));
        const float* X = WSP(float, WS_X); const float* SSQ = WSP(float, WS_SSQ); const float* PQ = WSP(float, WS_PQ); const int lane = F.tid_() & 63;
        for (int m = F.gw; m < NTOK; m += F.NGW) {
            f32x4 v[4]; float ss = 0.f;
#pragma unroll
            for (int j = 0; j < 4; ++j) v[j] = *(const f32x4*)(X + (size_t)m * D + j * 256 + lane * 4);
            if (m < NP) { const f32x4* sp = (const f32x4*)(SSQ + (size_t)m * 16); const f32x4 s0 = sp[0], s1 = sp[1], s2 = sp[2], s3 = sp[3];
                ss = ((s0[0] + s0[1]) + (s0[2] + s0[3])) + ((s1[0] + s1[1]) + (s1[2] + s1[3])) + ((s2[0] + s2[1]) + (s2[2] + s2[3])) + ((s3[0] + s3[1]) + (s3[2] + s3[3])); }
            else {
#pragma unroll
                for (int j = 0; j < 4; ++j) {
#pragma unroll
                    for (int q = 0; q < 4; ++q) v[j] = v[j] + *(const f32x4*)(PQ + (size_t)q * 256 * D + (size_t)(m - NP) * D + j * 256 + lane * 4);
                    ss += (v[j][0] * v[j][0] + v[j][1] * v[j][1]) + (v[j][2] * v[j][2] + v[j][3] * v[j][3]); }
                ss = wave_sum(ss); }
            const float rs = rsqrtf(ss * (1.f / 1024.f) + EPS);
            float* od = m < NP ? (args->out + OUT_YP) + (size_t)m * D : (args->out + OUT_YS) + (size_t)(m - NP) * D;
#pragma unroll
            for (int j = 0; j < 4; ++j) { const int c = j * 256 + lane * 4; *(f32x4*)(od + c) = v[j] * rs * *(const f32x4*)(IN_F(8) + c); }
        }
    }
#undef INC
#undef SEAM
}
#undef WSP
#undef IN_F
}

#ifndef MK_ONE_LAUNCH
#define MK_ONE_LAUNCH 0
#endif
static void mk_launch(void* const* d_in, void* d_out, void* d_ws, size_t ws_size, hipStream_t stream) {
    static int grid = 0;
    if (grid == 0) {
        int dev = 0, cus = 0, per_cu = 0;
        if (ws_size < mk::WS_END) { fprintf(stderr, "kernel_launch: workspace too small (%zu < %zu)\n", ws_size, (size_t)mk::WS_END); grid = -1; return; }
        if (hipGetDevice(&dev) != hipSuccess || hipDeviceGetAttribute(&cus, hipDeviceAttributeMultiprocessorCount, dev) != hipSuccess) { grid = -1; return; }
        if (hipFuncSetAttribute((const void*)mk::mega_fwd, hipFuncAttributeMaxDynamicSharedMemorySize, mk::LDS_BYTES) != hipSuccess) { fprintf(stderr, "kernel_launch: hipFuncSetAttribute failed\n"); grid = -1; return; }
        if (hipOccupancyMaxActiveBlocksPerMultiprocessor(&per_cu, (const void*)mk::mega_fwd, 512, mk::LDS_BYTES) != hipSuccess || per_cu < 1) { fprintf(stderr, "kernel_launch: occupancy query says %d blocks per CU\n", per_cu); }
        (void)hipGetLastError();
        grid = cus;
    }
    if (grid < 0) return;
    (void)hipMemsetAsync((char*)d_ws + mk::WS_CTL, 0, mk::CTL_BYTES, stream);
    mk::Args a{};
    for (int i = 0; i < 25; ++i) a.in[i] = d_in[i];
    a.out = (float*)d_out; a.ws = (unsigned char*)d_ws;
#if MK_ONE_LAUNCH
    a.ph_lo = 0; a.ph_hi = mk::N_PHASES;
    hipLaunchKernelGGL(mk::mega_fwd, dim3(grid), dim3(512), mk::LDS_BYTES, stream, a);
#else
    for (int p = 0; p < mk::N_PHASES; ++p) {
        int cls = p == 0 ? 0 : 11;
        if (p >= 1 && p < 29) { const int l = (p - 1) / 7, k = (p - 1) % 7; if ((l & 1) && k == 3) continue;
            static const int ce[7] = {1, 2, 3, 4, 5, 9, 10}, co[7] = {6, 12, 7, -1, 8, 9, 10}; cls = (l & 1) ? co[k] : ce[k]; }
        const int reps = 1 + ((MK_REPEAT >> cls) & 1);
        for (int r = 0; r < reps; ++r) { a.ph_lo = p; a.ph_hi = p + 1; a.qrep = r;
            hipLaunchKernelGGL(mk::mega_fwd, dim3(grid), dim3(512), mk::LDS_BYTES, stream, a); }
    }
#endif
}

extern "C" void kernel_launch(void* const* d_in, const int* in_sizes, int n_in, void* d_out, int out_size, void* d_ws, size_t ws_size, hipStream_t stream) {
    if (n_in != 25) { fprintf(stderr, "kernel_launch: unexpected n_in %d\n", n_in); return; }
    mk_launch(d_in, d_out, d_ws, ws_size, stream);
}
```
